# Optimizing an MI355X kernel written in HIP

```python
import functools
import jax, jax.numpy as jnp
from jax import lax
import numpy as np

D_MODEL = 1024
BATCH = 2
SEQ = 8192
DEPTH = 2
DEC_BATCH = 32
DEC_SEQ = 16
PAST_LEN = 2048

CHUNK = 64
Q_BLOCK = 128
SB_HEADS = 8
SB_HEAD_DIM = 64
SB_WIDTH = SB_HEADS * SB_HEAD_DIM
HG_HEADS = 4
HG_HEAD_DIM = 128
HG_WIDTH = HG_HEADS * HG_HEAD_DIM
MIX_WIDTH = SB_WIDTH + HG_WIDTH
IN_COLS = 3 * SB_WIDTH + 4 * HG_WIDTH
SPLITS = [SB_WIDTH, 2 * SB_WIDTH, 3 * SB_WIDTH, 3 * SB_WIDTH + HG_WIDTH,
          3 * SB_WIDTH + 2 * HG_WIDTH, 3 * SB_WIDTH + 3 * HG_WIDTH]
N_MEM = 256
MEM_HEADS = 4
MEM_HEAD_DIM = 128
MEM_WIDTH = MEM_HEADS * MEM_HEAD_DIM
D_FF = 4 * D_MODEL
EPS = 1e-6

kernel_name = 'hybrid_sb_hgrn2_stream_encoder'


def rmsnorm(x, gain):
    x32 = x.astype(jnp.float32)
    y = x32 * lax.rsqrt(jnp.mean(x32 * x32, axis=-1, keepdims=True) + EPS)
    return (y * gain.astype(jnp.float32)).astype(x.dtype)


def stick_breaking(q, k, v, q_pos, k_pos):
    z = jnp.einsum('bqhd,bkhd->bhqk', q.astype(jnp.float32), k.astype(jnp.float32)) * (SB_HEAD_DIM ** -0.5)
    mask = (k_pos[None, :] < q_pos[:, None])[None, None]
    log_keep = jnp.where(mask, -jax.nn.softplus(z), 0.0)
    rev = lax.cumsum(log_keep, axis=3, reverse=True)
    excl = jnp.concatenate([rev[..., 1:], jnp.zeros_like(rev[..., :1])], axis=-1)
    a = jnp.where(mask, jnp.exp(jax.nn.log_sigmoid(z) + excl), 0.0)
    return jnp.einsum('bhqk,bkhd->bqhd', a, v.astype(jnp.float32))


def sb_prompt(q, k, v):
    b, t, h, d = q.shape
    nb = t // Q_BLOCK
    pos = jnp.arange(t, dtype=jnp.int32)
    qb = q.reshape(b, nb, Q_BLOCK, h, d).transpose(1, 0, 2, 3, 4)
    pb = pos.reshape(nb, Q_BLOCK)
    out = lax.map(lambda a: stick_breaking(a[0], k, v, a[1], pos), (qb, pb))
    return out.transpose(1, 0, 2, 3, 4).reshape(b, t, h, d)


def sb_sample(past_k, past_v, q, k, v):
    p = past_k.shape[1]
    t = q.shape[1]
    k_all = jnp.concatenate([past_k.astype(k.dtype), k], axis=1)
    v_all = jnp.concatenate([past_v.astype(v.dtype), v], axis=1)
    q_pos = p + jnp.arange(t, dtype=jnp.int32)
    k_pos = jnp.arange(p + t, dtype=jnp.int32)
    return stick_breaking(q, k_all, v_all, q_pos, k_pos)


def hgrn2_chunked(q, k, v, log_f, s0):
    b, t, h, dk = q.shape
    dv = v.shape[-1]
    ln = min(CHUNK, t)
    nc = t // ln

    def to_chunks(a):
        return a.astype(jnp.float32).reshape(b, nc, ln, h, a.shape[-1]).transpose(1, 0, 2, 3, 4)

    tri = jnp.tril(jnp.ones((ln, ln), dtype=bool))[None, :, :, None, None]

    def step(s, inp):
        qc, kc, vc, gc = inp
        cum = jnp.cumsum(gc, axis=1)
        o_inter = jnp.einsum('blhk,bhkv->blhv', qc * jnp.exp(cum), s)
        diff = cum[:, :, None] - cum[:, None, :]
        decay = jnp.exp(jnp.where(tri, diff, -jnp.inf))
        scores = jnp.einsum('bthk,bshk,btshk->bths', qc, kc, decay)
        o_intra = jnp.einsum('bths,bshv->bthv', scores, vc)
        last = cum[:, -1]
        s_new = jnp.exp(last)[..., None] * s + jnp.einsum(
            'bshk,bshv->bhkv', kc * jnp.exp(last[:, None] - cum), vc)
        return s_new, o_inter + o_intra

    s_fin, o = lax.scan(step, s0.astype(jnp.float32),
                        (to_chunks(q), to_chunks(k), to_chunks(v), to_chunks(log_f)))
    o = o.transpose(1, 0, 2, 3, 4).reshape(b, t, h, dv)
    return o, s_fin


def memory_kv(mem, gain, w_mk, w_mv):
    b = mem.shape[0]
    h = rmsnorm(mem, gain)
    mk = (h @ w_mk).reshape(b, N_MEM, MEM_HEADS, MEM_HEAD_DIM)
    mv = (h @ w_mv).reshape(b, N_MEM, MEM_HEADS, MEM_HEAD_DIM)
    return mk, mv


def layer_forward(x, sb_fn, s0, mem_k, mem_v, lb, norm_mix, w_in, sb_gain, hg_gain, w_out,
                  norm_mem_q, w_mq, w_mo, norm_ffn, w_ffn1, w_ffn2):
    bx, t, _ = x.shape
    h = rmsnorm(x, norm_mix)
    proj = h @ w_in
    q_sb, k_sb, v_sb, q_hg, f_hg, i_hg, g_hg = jnp.split(proj, SPLITS, axis=-1)
    q_sb = q_sb.reshape(bx, t, SB_HEADS, SB_HEAD_DIM)
    k_sb = k_sb.reshape(bx, t, SB_HEADS, SB_HEAD_DIM)
    v_sb = v_sb.reshape(bx, t, SB_HEADS, SB_HEAD_DIM)
    o_sb = rmsnorm(sb_fn(q_sb, k_sb, v_sb).reshape(bx, t, SB_WIDTH), sb_gain)
    z = f_hg.astype(jnp.float32).reshape(bx, t, HG_HEADS, HG_HEAD_DIM)
    lb_h = lb.reshape(HG_HEADS, HG_HEAD_DIM)
    log_f = jnp.logaddexp(jnp.log(lb_h), jnp.log1p(-lb_h) + jax.nn.log_sigmoid(z))
    k_hg = (1.0 - lb_h) * jax.nn.sigmoid(-z)
    q_hg = q_hg.astype(jnp.float32).reshape(bx, t, HG_HEADS, HG_HEAD_DIM) * (HG_HEAD_DIM ** -0.5)
    i_hg = i_hg.reshape(bx, t, HG_HEADS, HG_HEAD_DIM)
    o_hg, s_new = hgrn2_chunked(q_hg, k_hg, i_hg, log_f, s0)
    gate = jax.nn.silu(g_hg.astype(jnp.float32).reshape(bx, t, HG_HEADS, HG_HEAD_DIM))
    o_hg = (rmsnorm(o_hg, hg_gain) * gate).reshape(bx, t, HG_WIDTH)
    mix = jnp.concatenate([o_sb.astype(x.dtype), o_hg.astype(x.dtype)], axis=-1)
    x = x + mix @ w_out
    h = rmsnorm(x, norm_mem_q)
    qm = (h @ w_mq).reshape(bx, t, MEM_HEADS, MEM_HEAD_DIM)
    sc = jnp.einsum('bqhd,bmhd->bhqm', qm.astype(jnp.float32), mem_k.astype(jnp.float32)) * (MEM_HEAD_DIM ** -0.5)
    p = jax.nn.softmax(sc, axis=-1)
    om = jnp.einsum('bhqm,bmhd->bqhd', p, mem_v.astype(jnp.float32)).reshape(bx, t, MEM_WIDTH)
    x = x + om.astype(x.dtype) @ w_mo
    h = rmsnorm(x, norm_ffn)
    x = x + jnp.square(jax.nn.relu(h @ w_ffn1)) @ w_ffn2
    return x, k_sb, v_sb, s_new


def setup_inputs(seed: int = 0) -> dict:
    key = jax.random.key(seed)
    ks = jax.random.split(key, 24)

    def nrm(k, shape, scale):
        return jax.random.normal(k, shape, jnp.float32) * scale

    def gain(k, shape):
        return 1.0 + 0.02 * jax.random.normal(k, shape, jnp.float32)

    return {
        'x_prompt': nrm(ks[0], (BATCH, SEQ, D_MODEL), 1.0),
        'x_sample': nrm(ks[1], (DEC_BATCH, DEC_SEQ, D_MODEL), 1.0),
        'mem_prompt': nrm(ks[2], (BATCH, N_MEM, D_MODEL), 1.0),
        'cache_sb_k': nrm(ks[3], (DEPTH, DEC_BATCH, PAST_LEN, SB_HEADS, SB_HEAD_DIM), 1.0),
        'cache_sb_v': nrm(ks[4], (DEPTH, DEC_BATCH, PAST_LEN, SB_HEADS, SB_HEAD_DIM), 1.0),
        'state_hgrn': nrm(ks[5], (DEPTH, DEC_BATCH, HG_HEADS, HG_HEAD_DIM, HG_HEAD_DIM), 0.3),
        'cache_mem_k': nrm(ks[6], (DEPTH, DEC_BATCH, N_MEM, MEM_HEADS, MEM_HEAD_DIM), 1.0),
        'cache_mem_v': nrm(ks[7], (DEPTH, DEC_BATCH, N_MEM, MEM_HEADS, MEM_HEAD_DIM), 1.0),
        'lb_logits': nrm(ks[8], (DEPTH, HG_WIDTH), 0.5),
        'norm_mix': gain(ks[9], (DEPTH, D_MODEL)),
        'w_in': nrm(ks[10], (DEPTH, D_MODEL, IN_COLS), D_MODEL ** -0.5),
        'sb_gain': gain(ks[11], (DEPTH, SB_WIDTH)),
        'hg_gain': gain(ks[12], (DEPTH, HG_HEADS, HG_HEAD_DIM)),
        'w_out': nrm(ks[13], (DEPTH, MIX_WIDTH, D_MODEL), MIX_WIDTH ** -0.5),
        'norm_mem_q': gain(ks[14], (DEPTH, D_MODEL)),
        'norm_mem_kv': gain(ks[15], (DEPTH, D_MODEL)),
        'w_mq': nrm(ks[16], (DEPTH, D_MODEL, MEM_WIDTH), D_MODEL ** -0.5),
        'w_mk': nrm(ks[17], (DEPTH, D_MODEL, MEM_WIDTH), D_MODEL ** -0.5),
        'w_mv': nrm(ks[18], (DEPTH, D_MODEL, MEM_WIDTH), D_MODEL ** -0.5),
        'w_mo': nrm(ks[19], (DEPTH, MEM_WIDTH, D_MODEL), MEM_WIDTH ** -0.5),
        'norm_ffn': gain(ks[20], (DEPTH, D_MODEL)),
        'w_ffn1': nrm(ks[21], (DEPTH, D_MODEL, D_FF), D_MODEL ** -0.5),
        'w_ffn2': nrm(ks[22], (DEPTH, D_FF, D_MODEL), D_FF ** -0.5),
        'norm_final': gain(ks[23], (D_MODEL,)),
    }


def reference(x_prompt, x_sample, mem_prompt, cache_sb_k, cache_sb_v, state_hgrn, cache_mem_k, cache_mem_v,
              lb_logits, norm_mix, w_in, sb_gain, hg_gain, w_out, norm_mem_q, norm_mem_kv, w_mq, w_mk, w_mv,
              w_mo, norm_ffn, w_ffn1, w_ffn2, norm_final):
    lb_all = jnp.cumsum(jax.nn.softmax(lb_logits.astype(jnp.float32), axis=0), axis=0)
    lb_all = lb_all - lb_all[:1]
    xp = x_prompt
    xs = x_sample
    kp_l, vp_l, sp_l, mkp_l, mvp_l, ks_l, vs_l, ss_l = [], [], [], [], [], [], [], []
    for l in range(DEPTH):
        shared = (lb_all[l], norm_mix[l], w_in[l], sb_gain[l], hg_gain[l], w_out[l],
                  norm_mem_q[l], w_mq[l], w_mo[l], norm_ffn[l], w_ffn1[l], w_ffn2[l])
        mk_p, mv_p = memory_kv(mem_prompt, norm_mem_kv[l], w_mk[l], w_mv[l])
        s0_p = jnp.zeros((xp.shape[0], HG_HEADS, HG_HEAD_DIM, HG_HEAD_DIM), jnp.float32)
        xp, kp, vp, sp = layer_forward(xp, sb_prompt, s0_p, mk_p, mv_p, *shared)
        xs, kn, vn, sn = layer_forward(xs, functools.partial(sb_sample, cache_sb_k[l], cache_sb_v[l]),
                                       state_hgrn[l], cache_mem_k[l], cache_mem_v[l], *shared)
        kp_l.append(kp); vp_l.append(vp); sp_l.append(sp); mkp_l.append(mk_p); mvp_l.append(mv_p)
        ks_l.append(kn); vs_l.append(vn); ss_l.append(sn)
    y_prompt = rmsnorm(xp, norm_final)
    y_sample = rmsnorm(xs, norm_final)
    return (y_prompt, y_sample, jnp.stack(kp_l), jnp.stack(vp_l), jnp.stack(sp_l), jnp.stack(mkp_l),
            jnp.stack(mvp_l), jnp.stack(ks_l), jnp.stack(vs_l), jnp.stack(ss_l))
```

```cpp
#include <hip/hip_runtime.h>
#include <hip/hip_cooperative_groups.h>
#include <cstdio>
#include <cstdint>
namespace cg = cooperative_groups;
namespace pg8 {
#define PG8_LAS __attribute__((address_space(3)))
typedef unsigned short bf16_t;
typedef short bf16x8 __attribute__((ext_vector_type(8)));
typedef float f32x4 __attribute__((ext_vector_type(4)));
typedef unsigned u32x4 __attribute__((ext_vector_type(4)));
constexpr int BM = 256, BK = 64, HALF = 128, HTB = HALF * BK * 2  , STAGE_BYTES = 8 * HTB, NXCD = 8, WGM = 8;

__host__ __device__ __forceinline__ int lds_byte(int r, int c) { const int st = (r >> 4) * 2 + (c >> 5), rr = r & 15, cc = c & 31, ob = rr * 64 + cc * 2; return st * 1024 + (ob ^ (((ob >> 9) & 1) << 5)); }
__host__ __device__ __forceinline__ void stage_rc(int b, int& R, int& C) { const int st = b / 1024, sb = b % 1024, swz = sb ^ (((sb >> 9) & 1) << 5); R = (st >> 1) * 16 + swz / 64; C = (st & 1) * 32 + (swz % 64) / 2; }
__host__ __device__ __forceinline__ int perm32(int rho) { const int n = rho >> 4, i = rho & 15; return 8 * (i >> 2) + 4 * n + (i & 3); }

struct Unit { int pm, pn, ks; };
struct Gemm { const bf16_t* A; const bf16_t* Bt; int M, N, K, ld; };

struct StaticOrder {
    int nM, nN, nwg, G, c;
    __host__ __device__ void init(int M, int N, int G_, int c_) { nM = M / BM; nN = N / BM; nwg = nM * nN; G = G_; c = c_; }
    __host__ __device__ bool next(int i, Unit& u) const {
        const long L = (long)i * G + c; if (L >= nwg) return false;
        int wgid = (int)L; { const int q = nwg / NXCD, r = nwg % NXCD, xcd = wgid % NXCD, off = wgid / NXCD; wgid = (xcd < r ? xcd * (q + 1) : r * (q + 1) + (xcd - r) * q) + off; }
        const int nig = WGM * nN, gid = wgid / nig, fm = gid * WGM, gsz = (nM - fm) < WGM ? (nM - fm) : WGM;
        u.pm = fm + ((wgid % nig) % gsz); u.pn = (wgid % nig) / gsz; u.ks = 0; return true;
    }
    __device__ __forceinline__ void a_ready(const Unit&) const {}
    __device__ __forceinline__ void done(const Unit&) const {}
};
struct SplitOrder {
    int nN, nS, nwg, G, c, pm0;
    __host__ __device__ void init(int nMs, int N, int nS_, int G_, int c_, int pm0_) { nN = N / BM; nS = nS_; nwg = nMs * nN * nS; G = G_; c = c_; pm0 = pm0_; }
    __host__ __device__ bool next(int i, Unit& u) const { const long L = (long)i * G + c; if (L >= nwg) return false; const int t = (int)L / nS; u.ks = (int)L % nS; u.pn = t % nN; u.pm = pm0 + t / nN; return true; }
    __device__ __forceinline__ void a_ready(const Unit&) const {}
    __device__ __forceinline__ void done(const Unit&) const {}
};
__device__ __forceinline__ unsigned cvt_pk_bf16(float lo, float hi) { unsigned r; asm volatile("v_cvt_pk_bf16_f32 %0, %1, %2" : "=v"(r) : "v"(lo), "v"(hi)); return r; }
typedef float f32x2 __attribute__((ext_vector_type(2)));
typedef unsigned u32x2 __attribute__((ext_vector_type(2)));
constexpr int NPROMPT = 16384;
constexpr size_t O_YP = 0, O_YS = 16777216, O_KP = 17301504, O_VP = 34078720, O_HP = 50855936, O_MKP = 51118080, O_MVP = 51642368,
                 O_KS = 52166656, O_VS = 52690944, O_HS = 53215232;
__device__ __forceinline__ float row_rstd(const float* ssq, int row) {
    const f32x4* p = (const f32x4*)(ssq + (size_t)row * 16);
    const f32x4 a = p[0], b = p[1], c = p[2], d = p[3];
    const float s = (((a[0] + a[1]) + (a[2] + a[3])) + ((b[0] + b[1]) + (b[2] + b[3]))) + (((c[0] + c[1]) + (c[2] + c[3])) + ((d[0] + d[1]) + (d[2] + d[3])));
    return rsqrtf(s * (1.0f / 1024.0f) + 1e-6f);
}
struct EpiF32 {
    static constexpr bool PERM = true, AFTER_DRAIN = false;
    int mode; const float* rstd; float* proj; float* outp; int l; bf16_t* vt; bf16_t* kb;
    __device__ __forceinline__ void operator()(const f32x4 (&acc)[2][2][4][2], const Unit& u, int wr, int wc, int fr_, int fq_) const {
        int tq = threadIdx.x; asm volatile("" : "+v"(tq)); const int fr = tq & 15, fq = (tq >> 4) & 3;
        float* base; int pitch, colt, rsub = 0; const int pn = u.pn;
        if (mode == 0) {
            if (pn >= 2 && pn < 6) { const size_t isv = pn >= 4 ? 1 : 0; colt = (pn & 1) * 256; pitch = 512;
                if (u.pm < 64) base = outp + (O_KP + isv * (O_VP - O_KP) + (size_t)l * NPROMPT * 512);
                else { base = outp + (O_KS + isv * (O_VS - O_KS) + (size_t)l * 262144); rsub = NPROMPT; } }
            else { base = proj; pitch = 3584; colt = pn * 256; }
        } else { const size_t sel = (size_t)(pn >> 1); base = outp + (O_MKP + (sel & 1) * (O_MVP - O_MKP) + (sel >> 1) * 262144); pitch = 512; colt = (pn & 1) * 256; }
        const int col0 = colt + wc * 32 + 8 * fq, rowb = u.pm * BM + wr * 64 + fr;
        float rs[2][4];
#pragma unroll
        for (int ai = 0; ai < 2; ++ai)
#pragma unroll
            for (int m = 0; m < 4; ++m) rs[ai][m] = rstd[rowb + ai * HALF + m * 16];
#pragma unroll
        for (int ai = 0; ai < 2; ++ai)
#pragma unroll
            for (int m = 0; m < 4; ++m) { const int row = rowb + ai * HALF + m * 16;
                float* rp = base + (size_t)(row - rsub) * pitch + col0;
#pragma unroll
                for (int bj = 0; bj < 2; ++bj)
#pragma unroll
                    for (int n = 0; n < 2; ++n) *(f32x4*)(rp + bj * HALF + n * 4) = acc[ai][bj][m][n] * rs[ai][m]; }
        if (mode == 0 && pn >= 2 && pn < 4 && u.pm < 64) {
#pragma unroll
            for (int ai = 0; ai < 2; ++ai)
#pragma unroll
                for (int m = 0; m < 4; ++m) { const int row = rowb + ai * HALF + m * 16, t = row & 8191;
#pragma unroll
                    for (int bj = 0; bj < 2; ++bj) { const f32x4 v0 = acc[ai][bj][m][0] * rs[ai][m], v1 = acc[ai][bj][m][1] * rs[ai][m]; const int c = col0 + bj * HALF, hh = c >> 6, d0 = c & 63;
                        u32x4 w; w.x = cvt_pk_bf16(v0[0], v0[1]); w.y = cvt_pk_bf16(v0[2], v0[3]); w.z = cvt_pk_bf16(v1[0], v1[1]); w.w = cvt_pk_bf16(v1[2], v1[3]);
                        *(u32x4*)(kb + ((((size_t)((row >> 13) * 8 + hh) * 256 + (t >> 5)) * 8 + (d0 >> 3)) * 32 + (t & 31)) * 8) = w; } }
        }
        if (mode == 0 && pn >= 4 && pn < 6 && u.pm < 64) {
            const int qi = fr & 3;
#pragma unroll
            for (int ai = 0; ai < 2; ++ai)
#pragma unroll
                for (int m = 0; m < 4; ++m) { const int row = rowb + ai * HALF + m * 16, t0 = (row & 8191) & ~3; const size_t tb = ((size_t)(row >> 13) * 8 * 2048 * 64 + (size_t)(t0 >> 2) * 64) * 4;
#pragma unroll
                    for (int bj = 0; bj < 2; ++bj)
#pragma unroll
                        for (int n = 0; n < 2; ++n) { const f32x4 v = acc[ai][bj][m][n] * rs[ai][m]; const int c = col0 + bj * HALF + n * 4;
                            const unsigned p01 = cvt_pk_bf16(v[0], v[1]), p23 = cvt_pk_bf16(v[2], v[3]);
                            const unsigned snd1 = (qi & 2) ? p01 : p23, kep1 = (qi & 2) ? p23 : p01, rcv1 = (unsigned)__shfl_xor((int)snd1, 2);
                            const unsigned q0 = (qi & 2) ? rcv1 : kep1, q2 = (qi & 2) ? kep1 : rcv1;
                            const unsigned los = (q0 & 0xffffu) | (q2 << 16), his = (q0 >> 16) | (q2 & 0xffff0000u);
                            const unsigned rcv2 = (unsigned)__shfl_xor((int)((qi & 1) ? los : his), 1), mine = (qi & 1) ? his : los;
                            u32x2 w;
                            if (qi & 1) { w.x = (rcv2 & 0xffffu) | (mine << 16); w.y = (rcv2 >> 16) | (mine & 0xffff0000u); }
                            else { w.x = (mine & 0xffffu) | (rcv2 << 16); w.y = (mine >> 16) | (rcv2 & 0xffff0000u); }
                            const int cc = c + (qi & 2) + (qi & 1), hh = cc >> 6, dd = cc & 63;
                            *(u32x2*)(vt + tb + ((size_t)hh * 2048 * 64 + dd) * 4) = w; } }
        }
    }
};
struct EpiResid {
    static constexpr bool PERM = true, AFTER_DRAIN = false;
    const float* bp; const float* bs; float* X; bf16_t* XB; float* ssq;
    __device__ __forceinline__ void operator()(const f32x4 (&acc)[2][2][4][2], const Unit& u, int wr, int wc, int fr_, int fq_) const {
        int tq = threadIdx.x; asm volatile("" : "+v"(tq)); const int fr = tq & 15, fq = (tq >> 4) & 3;
        const int col0 = u.pn * BM + wc * 32 + 8 * fq;
#pragma unroll
        for (int ai = 0; ai < 2; ++ai) {
            f32x4 res[4][2][2];
#pragma unroll
            for (int m = 0; m < 4; ++m) { const int row = u.pm * BM + ai * HALF + wr * 64 + m * 16 + fr;
                const float* br = (row < NPROMPT ? bp + (size_t)row * 1024 : bs + (size_t)(row - NPROMPT) * 1024) + col0;
#pragma unroll
                for (int bj = 0; bj < 2; ++bj) { res[m][bj][0] = *(const f32x4*)(br + bj * HALF); res[m][bj][1] = *(const f32x4*)(br + bj * HALF + 4); } }
            asm volatile("" ::: "memory");
#pragma unroll
            for (int m = 0; m < 4; ++m) { const int row = u.pm * BM + ai * HALF + wr * 64 + m * 16 + fr;
                float* xr = X + (size_t)row * 1024 + col0; bf16_t* xb = XB + (size_t)row * 1024 + col0; float ss = 0.f;
#pragma unroll
                for (int bj = 0; bj < 2; ++bj) { const f32x4 v0 = acc[ai][bj][m][0] + res[m][bj][0], v1 = acc[ai][bj][m][1] + res[m][bj][1];
                    *(f32x4*)(xr + bj * HALF) = v0; *(f32x4*)(xr + bj * HALF + 4) = v1;
                    ss += ((v0[0] * v0[0] + v0[1] * v0[1]) + (v0[2] * v0[2] + v0[3] * v0[3])) + ((v1[0] * v1[0] + v1[1] * v1[1]) + (v1[2] * v1[2] + v1[3] * v1[3]));
                    u32x4 w; w.x = cvt_pk_bf16(v0[0], v0[1]); w.y = cvt_pk_bf16(v0[2], v0[3]); w.z = cvt_pk_bf16(v1[0], v1[1]); w.w = cvt_pk_bf16(v1[2], v1[3]); *(u32x4*)(xb + bj * HALF) = w; }
                ss += __shfl_xor(ss, 16); ss += __shfl_xor(ss, 32);
                if (fq == 0) ssq[(size_t)row * 16 + u.pn * 4 + wc] = ss; }
            asm volatile("" ::: "memory"); }
    }
};
struct EpiBf16S {
    static constexpr bool PERM = true, AFTER_DRAIN = false;
    bf16_t* O; int ldc; const float* rstd; float scale; int act;
    __device__ __forceinline__ void operator()(const f32x4 (&acc)[2][2][4][2], const Unit& u, int wr, int wc, int fr_, int fq_) const {
        int tq = threadIdx.x; asm volatile("" : "+v"(tq)); const int fr = tq & 15, fq = (tq >> 4) & 3;
        const int col0 = u.pn * BM + wc * 32 + 8 * fq, rowb = u.pm * BM + wr * 64 + fr;
        float rs[2][4];
#pragma unroll
        for (int ai = 0; ai < 2; ++ai)
#pragma unroll
            for (int m = 0; m < 4; ++m) rs[ai][m] = rstd[rowb + ai * HALF + m * 16];
#pragma unroll
        for (int ai = 0; ai < 2; ++ai)
#pragma unroll
            for (int m = 0; m < 4; ++m) { const int row = rowb + ai * HALF + m * 16; const float r1 = rs[ai][m];
                bf16_t* rowp = O + (size_t)row * ldc + col0;
#pragma unroll
                for (int bj = 0; bj < 2; ++bj) { f32x4 v0 = acc[ai][bj][m][0] * r1, v1 = acc[ai][bj][m][1] * r1;
                    if (act == 1) { v0 = __builtin_elementwise_max(v0, (f32x4){0.f, 0.f, 0.f, 0.f}); v1 = __builtin_elementwise_max(v1, (f32x4){0.f, 0.f, 0.f, 0.f}); v0 = v0 * v0; v1 = v1 * v1; }
                    v0 = v0 * scale; v1 = v1 * scale;
                    u32x4 w; w.x = cvt_pk_bf16(v0[0], v0[1]); w.y = cvt_pk_bf16(v0[2], v0[3]); w.z = cvt_pk_bf16(v1[0], v1[1]); w.w = cvt_pk_bf16(v1[2], v1[3]);
                    *(u32x4*)(rowp + bj * HALF) = w; } }
    }
};
struct EpiPart {
    static constexpr bool PERM = true, AFTER_DRAIN = false;
    float* part;
    __device__ __forceinline__ void operator()(const f32x4 (&acc)[2][2][4][2], const Unit& u, int wr, int wc, int fr_, int fq_) const {
        int tq = threadIdx.x; asm volatile("" : "+v"(tq)); const int fr = tq & 15, fq = (tq >> 4) & 3;
        const int col0 = u.pn * BM + wc * 32 + 8 * fq;
#pragma unroll
        for (int ai = 0; ai < 2; ++ai)
#pragma unroll
            for (int m = 0; m < 4; ++m) { const int row = (u.pm - 64) * BM + ai * HALF + wr * 64 + m * 16 + fr;
                float* rp = part + ((size_t)u.ks * 512 + row) * 1024 + col0;
#pragma unroll
                for (int bj = 0; bj < 2; ++bj)
#pragma unroll
                    for (int n = 0; n < 2; ++n) *(f32x4*)(rp + bj * HALF + n * 4) = acc[ai][bj][m][n];
                asm volatile("" ::: "memory"); }
    }
};
template <class Epi, class Sched, bool ALIGN_EPI = false, bool SP2 = false>
__device__ __forceinline__ void gemm_phase(PG8_LAS unsigned char* lds, const Gemm g, const Sched& S, const Epi& E) {
    int tid_ = threadIdx.x; asm volatile("" : "+v"(tid_));
    const int tid = tid_, wid = __builtin_amdgcn_readfirstlane(tid >> 6), lane = tid & 63, wr = wid >> 2, wc = wid & 3, fr = lane & 15, fq = lane >> 4;
    const int K = g.ld ? g.ld : g.K, nt = g.K / BK;
    unsigned voffA[2], voffB[2];
#pragma unroll
    for (int i = 0; i < 2; ++i) { int R, C; stage_rc(tid * 16 + i * 8192, R, C); const int Rb = Epi::PERM ? ((R & ~31) + perm32(R & 31)) : R;
        voffA[i] = (unsigned)(R * K + C) * 2u; voffB[i] = (unsigned)(Rb * K + C) * 2u; }
    const size_t kstep = (size_t)(BK * 2);
    const size_t hstep = (size_t)HALF * K * 2;
    const size_t tstep = 2 * hstep;
    const unsigned ldsw = (unsigned)wid * 1024u;
    const int aoff = lds_byte(wr * 64 + fr, fq * 8), boff = lds_byte(wc * 32 + fr, fq * 8);
#define PG8_SA(b, h) (((b) * 2 + (h)) * HTB)
#define PG8_SB(b, h) ((4 + (b) * 2 + (h)) * HTB)
#define PG8_STAGE(bufoff, gbase, voff) do { _Pragma("unroll") for (int _i = 0; _i < 2; ++_i) \
        __builtin_amdgcn_global_load_lds((const unsigned*)((const char*)(gbase) + (voff)[_i]), (PG8_LAS unsigned*)(lds + (bufoff) + ldsw + _i * 8192), 16, 0, 0); } while (0)
#define PG8_LDA(dst, b, h) do { _Pragma("unroll") for (int m = 0; m < 4; ++m) _Pragma("unroll") for (int k = 0; k < 2; ++k) dst[m][k] = *(const PG8_LAS bf16x8*)(lds + PG8_SA(b, h) + aoff + m * 2048 + k * 1024); } while (0)
#define PG8_LDB(dst, b, h) do { _Pragma("unroll") for (int n = 0; n < 2; ++n) _Pragma("unroll") for (int k = 0; k < 2; ++k) dst[n][k] = *(const PG8_LAS bf16x8*)(lds + PG8_SB(b, h) + boff + n * 2048 + k * 1024); } while (0)
#define PG8_MMA(ai, bj, At, Bt) do { __builtin_amdgcn_s_setprio(1); _Pragma("unroll") for (int m = 0; m < 4; ++m) _Pragma("unroll") for (int n = 0; n < 2; ++n) _Pragma("unroll") for (int k = 0; k < 2; ++k) \
        acc[ai][bj][m][n] = __builtin_amdgcn_mfma_f32_16x16x32_bf16(Bt[n][k], At[m][k], acc[ai][bj][m][n], 0, 0, 0); __builtin_amdgcn_s_setprio(0); } while (0)
#define PG8_WAIT_V(n) asm volatile("s_waitcnt vmcnt(" #n ")" ::: "memory")
#define PG8_WAIT_L(n) asm volatile("s_waitcnt lgkmcnt(" #n ")" ::: "memory")
#define PG8_BAR __builtin_amdgcn_s_barrier()
#define PG8_SCHED __builtin_amdgcn_sched_barrier(0)
    Unit cur, nxt; int ui = 0;
    if (!S.next(0, cur)) return;
    f32x4 acc[2][2][4][2];
#pragma unroll
    for (int a = 0; a < 2; ++a)
#pragma unroll
        for (int b = 0; b < 2; ++b)
#pragma unroll
            for (int m = 0; m < 4; ++m)
#pragma unroll
                for (int n = 0; n < 2; ++n) acc[a][b][m][n] = (f32x4){0.f, 0.f, 0.f, 0.f};
    bf16x8 At[4][2], B0[2][2], B1[2][2];
    const size_t sstep = (size_t)g.K * 2;
    const char* cA = (const char*)g.A + (size_t)cur.pm * tstep + (size_t)cur.ks * sstep; const char* cB = (const char*)g.Bt + (size_t)cur.pn * tstep + (size_t)cur.ks * sstep;
    S.a_ready(cur);
    if constexpr (SP2) {
        PG8_STAGE(PG8_SB(0, 0), cB, voffB); PG8_STAGE(PG8_SB(0, 1), cB + hstep, voffB); PG8_STAGE(PG8_SA(0, 0), cA, voffA); PG8_STAGE(PG8_SA(0, 1), cA + hstep, voffA);
        if (wr == 1) PG8_BAR;
        PG8_WAIT_V(2); PG8_BAR;
        PG8_STAGE(PG8_SB(1, 0), cB + kstep, voffB); PG8_STAGE(PG8_SA(1, 0), cA + kstep, voffA); PG8_STAGE(PG8_SB(1, 1), cB + hstep + kstep, voffB);
        PG8_WAIT_V(6); PG8_BAR;
    } else {
        PG8_STAGE(PG8_SB(0, 0), cB, voffB); PG8_STAGE(PG8_SA(0, 0), cA, voffA); PG8_STAGE(PG8_SB(0, 1), cB + hstep, voffB); PG8_STAGE(PG8_SA(0, 1), cA + hstep, voffA);
        if (wr == 1) PG8_BAR;
        PG8_WAIT_V(4); PG8_BAR;
        PG8_STAGE(PG8_SB(1, 0), cB + kstep, voffB); PG8_STAGE(PG8_SA(1, 0), cA + kstep, voffA); PG8_STAGE(PG8_SB(1, 1), cB + hstep + kstep, voffB);
        PG8_WAIT_V(6); PG8_BAR;
    }
    for (;;) {
        const bool has_next = S.next(ui + 1, nxt);
        const char* nA = has_next ? (const char*)g.A + (size_t)nxt.pm * tstep + (size_t)nxt.ks * sstep : cA; const char* nB = has_next ? (const char*)g.Bt + (size_t)nxt.pn * tstep + (size_t)nxt.ks * sstep : cB;
        for (int t = 0; t < nt; t += 2) {
            const bool last = (t == nt - 2);
            const char* a1 = cA + (size_t)(t + 1) * kstep;
            const char* a2 = last ? nA : cA + (size_t)(t + 2) * kstep; const char* b2 = last ? nB : cB + (size_t)(t + 2) * kstep;
            const char* a3 = a2 + kstep; const char* b3 = b2 + kstep;
            if (last && has_next) S.a_ready(nxt);
            if constexpr (SP2) {
            PG8_LDB(B0, 0, 0); PG8_LDB(B1, 0, 1); PG8_SCHED; PG8_LDA(At, 0, 0); PG8_STAGE(PG8_SA(1, 1), a1 + hstep, voffA);
            PG8_WAIT_V(8); PG8_WAIT_L(0); PG8_BAR; PG8_MMA(0, 0, At, B0); PG8_MMA(0, 1, At, B1); PG8_BAR; PG8_SCHED;
            PG8_LDA(At, 0, 1); PG8_STAGE(PG8_SB(0, 0), b2, voffB); PG8_STAGE(PG8_SB(0, 1), b2 + hstep, voffB); PG8_STAGE(PG8_SA(0, 0), a2, voffA);
            PG8_WAIT_V(8); PG8_WAIT_L(0); PG8_BAR; PG8_MMA(1, 0, At, B0); PG8_MMA(1, 1, At, B1); PG8_BAR; PG8_SCHED;
            PG8_LDB(B0, 1, 0); PG8_LDB(B1, 1, 1); PG8_SCHED; PG8_LDA(At, 1, 0); PG8_STAGE(PG8_SA(0, 1), a2 + hstep, voffA);
            PG8_WAIT_V(8); PG8_WAIT_L(0); PG8_BAR; PG8_MMA(0, 0, At, B0); PG8_MMA(0, 1, At, B1); PG8_BAR; PG8_SCHED;
            PG8_LDA(At, 1, 1); PG8_STAGE(PG8_SB(1, 0), b3, voffB); PG8_STAGE(PG8_SB(1, 1), b3 + hstep, voffB); PG8_STAGE(PG8_SA(1, 0), a3, voffA);
            PG8_WAIT_V(8); PG8_WAIT_L(0); PG8_BAR; PG8_MMA(1, 0, At, B0); PG8_MMA(1, 1, At, B1); PG8_BAR; PG8_SCHED;
            } else {
            PG8_LDB(B0, 0, 0); PG8_SCHED; PG8_LDA(At, 0, 0); PG8_STAGE(PG8_SA(1, 1), a1 + hstep, voffA);
            PG8_WAIT_L(8); PG8_BAR; PG8_WAIT_L(0); PG8_MMA(0, 0, At, B0); PG8_BAR; PG8_SCHED;
            PG8_LDB(B1, 0, 1); PG8_STAGE(PG8_SB(0, 0), b2, voffB);
            PG8_BAR; PG8_WAIT_L(0); PG8_MMA(0, 1, At, B1); PG8_BAR;
            PG8_LDA(At, 0, 1); PG8_STAGE(PG8_SA(0, 0), a2, voffA);
            PG8_BAR; PG8_WAIT_L(0); PG8_MMA(1, 0, At, B0); PG8_BAR; PG8_SCHED;
            PG8_STAGE(PG8_SB(0, 1), b2 + hstep, voffB);
            PG8_WAIT_V(6); PG8_BAR; PG8_MMA(1, 1, At, B1); PG8_BAR;
            PG8_LDB(B0, 1, 0); PG8_SCHED; PG8_LDA(At, 1, 0); PG8_STAGE(PG8_SA(0, 1), a2 + hstep, voffA);
            PG8_WAIT_L(8); PG8_BAR; PG8_WAIT_L(0); PG8_MMA(0, 0, At, B0); PG8_BAR; PG8_SCHED;
            PG8_LDB(B1, 1, 1); PG8_STAGE(PG8_SB(1, 0), b3, voffB);
            PG8_BAR; PG8_WAIT_L(0); PG8_MMA(0, 1, At, B1); PG8_BAR;
            PG8_LDA(At, 1, 1); PG8_STAGE(PG8_SA(1, 0), a3, voffA);
            PG8_BAR; PG8_WAIT_L(0); PG8_MMA(1, 0, At, B0); PG8_BAR; PG8_SCHED;
            PG8_STAGE(PG8_SB(1, 1), b3 + hstep, voffB);
            PG8_WAIT_V(6); PG8_BAR; PG8_MMA(1, 1, At, B1); PG8_BAR;
            }
        }
        if constexpr (ALIGN_EPI) { if (wr == 0) PG8_BAR; }
        if constexpr (!Epi::AFTER_DRAIN) { E(acc, cur, wr, wc, fr, fq); S.done(cur); }
        if (!has_next) break;
#pragma unroll
        for (int a = 0; a < 2; ++a)
#pragma unroll
            for (int b = 0; b < 2; ++b)
#pragma unroll
                for (int m = 0; m < 4; ++m)
#pragma unroll
                    for (int n = 0; n < 2; ++n) acc[a][b][m][n] = (f32x4){0.f, 0.f, 0.f, 0.f};
        cur = nxt; cA = nA; cB = nB; ++ui;
        if constexpr (ALIGN_EPI) { if (wr == 1) PG8_BAR; }
    }
    PG8_WAIT_V(0);
    if constexpr (!ALIGN_EPI) { if (wr == 0) PG8_BAR; }
    PG8_BAR;
    if constexpr (Epi::AFTER_DRAIN) { E.fused(acc, cur, wr, wc, fr, fq, lds, wid, lane); S.done(cur); }
#undef PG8_SA
#undef PG8_SB
#undef PG8_STAGE
#undef PG8_LDA
#undef PG8_LDB
#undef PG8_MMA
#undef PG8_WAIT_V
#undef PG8_WAIT_L
#undef PG8_BAR
#undef PG8_SCHED
}
}
using namespace pg8;
#define LAS __attribute__((address_space(3)))
typedef LAS unsigned char* ldsp;
typedef float f32x16 __attribute__((ext_vector_type(16)));
#define LDS_WAIT() asm volatile("s_waitcnt lgkmcnt(0)" ::: "memory")

constexpr int M_ALL = 16896;
constexpr int PLD = 3584;
constexpr size_t MiB = 1u << 20;
constexpr size_t WS_W0 = 2 * MiB, WS_WL = 32 * MiB;
constexpr size_t W_IN = 0, W_OUT = 7 * MiB, W_MQ = 9 * MiB, W_MO = 10 * MiB, W_1 = 11 * MiB, W_2 = 19 * MiB;
constexpr size_t WS_WMKV = 66 * MiB;
constexpr size_t WS_XB = 80 * MiB, WS_X = 128 * MiB, WS_SSQ = 196 * MiB, WS_MEMB = 198 * MiB, WS_MEMSSQ = 199 * MiB, WS_RSTD = 199 * MiB + 65536, WS_MEMRSTD = 199 * MiB + 196608;
constexpr size_t WS_PROJ = 256 * MiB, WS_OSB = 512 * MiB, WS_MIX = 560 * MiB, WS_DS = 608 * MiB, WS_DD = 672 * MiB;
constexpr size_t WS_QM = 688 * MiB, WS_OM = 720 * MiB, WS_H = 768 * MiB, WS_PART = 904 * MiB, WS_VT = 940 * MiB, WS_KB = 960 * MiB;
constexpr int LDS_BYTES = 147456;
constexpr size_t WS_BAR = 65536;
constexpr size_t WS_CTR = 65536 + 16384;
constexpr int LDS_BARST = 131072 + 1024;

__device__ __forceinline__ float wave_sum(float v) {
#pragma unroll
    for (int o = 1; o < 64; o <<= 1) v += __shfl_xor(v, o);
    return v;
}
typedef float f32x2_t __attribute__((ext_vector_type(2))); typedef __bf16 bf16x2_t __attribute__((ext_vector_type(2)));
__device__ __forceinline__ unsigned pk2(float lo, float hi) { const f32x2_t v = {lo, hi}; const bf16x2_t b = __builtin_convertvector(v, bf16x2_t); return __builtin_bit_cast(unsigned, b); }
__device__ __forceinline__ unsigned f2bf(float f) { return pk2(f, f) & 0xffffu; }
__device__ __forceinline__ bf16x8 pack8(float a, float b, float c, float d, float e, float f, float g, float h) { return __builtin_bit_cast(bf16x8, (u32x4){pk2(a, b), pk2(c, d), pk2(e, f), pk2(g, h)}); }
__device__ __forceinline__ float fexp(float x) { return __builtin_amdgcn_exp2f(x * 1.4426950408889634f); }
__device__ __forceinline__ float flog(float x) { return __builtin_amdgcn_logf(x) * 0.6931471805599453f; }
__device__ __forceinline__ int crow(int i, int hi) { return (i & 3) + 8 * (i >> 2) + 4 * hi; }
#define MFMA32(a, b, c) __builtin_amdgcn_mfma_f32_32x32x16_bf16((a), (b), (c), 0, 0, 0)
#define MFMA16(a, b, c) __builtin_amdgcn_mfma_f32_16x16x32_bf16((a), (b), (c), 0, 0, 0)

__device__ __forceinline__ void transpose_item(const float* W, int K, int N, bf16_t* WT, int row_off, const float* gain, LAS float* scr, int item, int lane) {
    const int nblk = N / 32, kb = item / nblk, nb = item % nblk, k0 = 64 * kb, n0 = 32 * nb;
    float wv[32], gv[32];
#pragma unroll
    for (int i = 0; i < 32; ++i) { const int kk = 2 * i + (lane >> 5); wv[i] = W[(size_t)(k0 + kk) * N + n0 + (lane & 31)]; gv[i] = gain ? gain[k0 + kk] : 1.f; }
#pragma unroll
    for (int i = 0; i < 32; ++i) { const int kk = 2 * i + (lane >> 5); scr[kk * 33 + (lane & 31)] = wv[i] * gv[i]; }
    LDS_WAIT(); asm volatile("" ::: "memory");
    const int c = lane & 7;
#pragma unroll
    for (int j = 0; j < 4; ++j) { const int n = (lane >> 3) + 8 * j; const LAS float* s = scr + (8 * c) * 33 + n;
        u32x4 o; o.x = pk2(s[0 * 33], s[1 * 33]); o.y = pk2(s[2 * 33], s[3 * 33]); o.z = pk2(s[4 * 33], s[5 * 33]); o.w = pk2(s[6 * 33], s[7 * 33]);
        *(u32x4*)(WT + (size_t)(row_off + n0 + n) * K + k0 + 8 * c) = o; }
    LDS_WAIT(); asm volatile("" ::: "memory");
}
__device__ __forceinline__ void row_prep2(const float* srcA, bf16_t* dstA, float* sqA, float* rsA, const float* srcB, bf16_t* dstB, float* sqB, float* rsB, bool hasB, int lane) {
    const f32x4* xa = (const f32x4*)srcA + lane; const f32x4* xb = (const f32x4*)srcB + lane; f32x4 va[4], vb[4]; float sa = 0.f, sb = 0.f;
#pragma unroll
    for (int j = 0; j < 4; ++j) { va[j] = xa[64 * j]; vb[j] = xb[64 * j]; }
#pragma unroll
    for (int j = 0; j < 4; ++j) { sa += (va[j][0] * va[j][0] + va[j][1] * va[j][1]) + (va[j][2] * va[j][2] + va[j][3] * va[j][3]); sb += (vb[j][0] * vb[j][0] + vb[j][1] * vb[j][1]) + (vb[j][2] * vb[j][2] + vb[j][3] * vb[j][3]); }
    sa = wave_sum(sa); sb = wave_sum(sb);
    u32x2* oa = (u32x2*)dstA + lane; u32x2* ob = (u32x2*)dstB + lane;
#pragma unroll
    for (int j = 0; j < 4; ++j) { u32x2 w; w.x = pk2(va[j][0], va[j][1]); w.y = pk2(va[j][2], va[j][3]); oa[64 * j] = w;
        if (hasB) { u32x2 w2; w2.x = pk2(vb[j][0], vb[j][1]); w2.y = pk2(vb[j][2], vb[j][3]); ob[64 * j] = w2; } }
    if (lane < 16) { sqA[lane] = lane == 0 ? sa : 0.f; if (hasB) sqB[lane] = lane == 0 ? sb : 0.f; }
    if (lane == 0) { *rsA = rsqrtf(sa * (1.0f / 1024.0f) + 1e-6f); if (hasB) *rsB = rsqrtf(sb * (1.0f / 1024.0f) + 1e-6f); }
}
template <bool SAMPLE> __device__ __forceinline__ void sb_item(int item, int layer, const float* PROJ, const float* KP, const float* VP, const float* KS, const float* VS,
                                        const float* CK, const float* CV, const bf16_t* VT, const bf16_t* KB, float* OSB, int lane) {
    const int r32 = lane & 31, hi = lane >> 5;
    int qrow, qpos, ptop, split, h, qmin; bool qvalid; const float *kA, *vA, *kB, *vB;
    const bf16_t* VTh = VT; const bf16_t* KBh = KB;
    if (!SAMPLE) { const int b = item >> 11, rem = item & 2047, qt = rem & 255; h = rem >> 8; VTh = VT + ((size_t)(b * 8 + h) * 2048 * 64 + r32) * 4; KBh = KB + ((size_t)(b * 8 + h) * 256 * 8 * 32 + hi * 32 + r32) * 8;
        qrow = b * 8192 + qt * 32 + r32; qpos = qt * 32 + r32; qvalid = true; ptop = qt * 32; split = 1 << 30; qmin = qt * 32;
        kA = KP + (size_t)(b * 8192) * 512 + h * 64; vA = VP + (size_t)(b * 8192) * 512 + h * 64; kB = kA; vB = vA;
    } else { const int it = item - 4096, s = it >> 3; h = it & 7;
        qrow = NPROMPT + s * 16 + (r32 & 15); qpos = 2048 + (r32 & 15); qvalid = r32 < 16; ptop = 2032; split = 2048; qmin = 2048;
        kA = CK + (size_t)((layer * 32 + s) * 2048) * 512 + h * 64; vA = CV + (size_t)((layer * 32 + s) * 2048) * 512 + h * 64;
        kB = KS + ((long)(s * 16) - 2048) * 512 + h * 64; vB = VS + ((long)(s * 16) - 2048) * 512 + h * 64; }
    bf16x8 qh[4];
    { const float* qp = PROJ + (size_t)qrow * PLD + h * 64 + 8 * hi;
#pragma unroll
      for (int ds = 0; ds < 4; ++ds) { const f32x4 a = *(const f32x4*)(qp + 16 * ds) * 0.125f, b = *(const f32x4*)(qp + 16 * ds + 4) * 0.125f; qh[ds] = pack8(a[0], a[1], a[2], a[3], b[0], b[1], b[2], b[3]); } }
    f32x16 oacc[2];
#pragma unroll
    for (int i = 0; i < 16; ++i) { oacc[0][i] = 0.f; oacc[1][i] = 0.f; }
    float carry = 0.f;
    f32x4 kraw[8]; float vraw[2][2][8]; u32x2 vpk[2][2][2]; bf16x8 kq[4];
#define SB_LOAD_TILE(P0) do { if (SAMPLE) { const int pr_ = (P0) + r32, prc_ = pr_ < 0 ? 0 : pr_; const float* kp_ = (prc_ >= split ? kB : kA) + (long)prc_ * 512 + 8 * hi; \
        _Pragma("unroll") for (int ds = 0; ds < 4; ++ds) { kraw[2 * ds] = *(const f32x4*)(kp_ + 16 * ds); kraw[2 * ds + 1] = *(const f32x4*)(kp_ + 16 * ds + 4); } } \
        else { const int pq_ = (P0) < 0 ? 0 : (P0); _Pragma("unroll") for (int ds = 0; ds < 4; ++ds) kq[ds] = *(const bf16x8*)(KBh + ((size_t)(pq_ >> 5) * 8 + 2 * ds) * 32 * 8); } \
        if (SAMPLE) { _Pragma("unroll") for (int t = 0; t < 2; ++t) _Pragma("unroll") for (int j = 0; j < 8; ++j) { const int pk_ = (P0) + 16 * t + 8 * (j >> 2) + 4 * hi + (j & 3), pkc_ = pk_ < 0 ? 0 : pk_; \
            const float* vp_ = (pkc_ >= split ? vB : vA) + (long)pkc_ * 512 + r32; vraw[t][0][j] = vp_[0]; vraw[t][1][j] = vp_[32]; } } \
        else { const int pc_ = (P0) < 0 ? 0 : (P0); _Pragma("unroll") for (int t = 0; t < 2; ++t) _Pragma("unroll") for (int dt = 0; dt < 2; ++dt) { const bf16_t* vq_ = VTh + ((size_t)((pc_ >> 2) + 4 * t + hi) * 64 + dt * 32) * 4; \
            vpk[t][dt][0] = *(const u32x2*)vq_; vpk[t][dt][1] = *(const u32x2*)(vq_ + 2 * 64 * 4); } } } while (0)
    SB_LOAD_TILE(ptop);
    for (int p0 = ptop; p0 > -32; p0 -= 32) {
        bf16x8 kf[4], va[2][2];
#pragma unroll
        for (int ds = 0; ds < 4; ++ds) { if (SAMPLE) kf[ds] = pack8(kraw[2 * ds][0], kraw[2 * ds][1], kraw[2 * ds][2], kraw[2 * ds][3], kraw[2 * ds + 1][0], kraw[2 * ds + 1][1], kraw[2 * ds + 1][2], kraw[2 * ds + 1][3]); else kf[ds] = kq[ds]; }
#pragma unroll
        for (int t = 0; t < 2; ++t)
#pragma unroll
            for (int dt = 0; dt < 2; ++dt) { if (SAMPLE) va[t][dt] = pack8(vraw[t][dt][0], vraw[t][dt][1], vraw[t][dt][2], vraw[t][dt][3], vraw[t][dt][4], vraw[t][dt][5], vraw[t][dt][6], vraw[t][dt][7]);
                else va[t][dt] = __builtin_bit_cast(bf16x8, (u32x4){vpk[t][dt][0].x, vpk[t][dt][0].y, vpk[t][dt][1].x, vpk[t][dt][1].y}); }
        SB_LOAD_TILE(p0 - 32);
        asm volatile("" ::: "memory");
        f32x16 acc;
#pragma unroll
        for (int i = 0; i < 16; ++i) acc[i] = 0.f;
#pragma unroll
        for (int ds = 0; ds < 4; ++ds) acc = MFMA32(kf[ds], qh[ds], acc);
        float L[16], ls[16];
        if (p0 >= 0 && p0 + 32 <= qmin) {
#pragma unroll
            for (int i = 0; i < 16; ++i) { const float z = acc[i]; const float sp = fmaxf(z, 0.f) + flog(1.f + fexp(-fabsf(z))); L[i] = -sp; ls[i] = z - sp; }
        } else {
#pragma unroll
            for (int i = 0; i < 16; ++i) { const int kpos = p0 + crow(i, hi); const bool valid = (kpos < qpos) && (kpos >= 0); const float z = acc[i];
                const float sp = fmaxf(z, 0.f) + flog(1.f + fexp(-fabsf(z)));
                L[i] = valid ? -sp : 0.f; ls[i] = valid ? (z - sp) : -1e30f; }
        }
        float G[4], PG[4], T[4];
#pragma unroll
        for (int g = 0; g < 4; ++g) { G[g] = (L[4 * g] + L[4 * g + 1]) + (L[4 * g + 2] + L[4 * g + 3]); PG[g] = __shfl_xor(G[g], 32); T[g] = G[g] + PG[g]; }
        float A[4]; A[3] = 0.f; A[2] = T[3]; A[1] = T[3] + T[2]; A[0] = A[1] + T[1];
        float P[16];
#pragma unroll
        for (int g = 0; g < 4; ++g) { const float e3 = carry + A[g] + (hi == 0 ? PG[g] : 0.f), e2 = e3 + L[4 * g + 3], e1 = e2 + L[4 * g + 2], e0 = e1 + L[4 * g + 1];
            P[4 * g + 3] = fexp(ls[4 * g + 3] + e3); P[4 * g + 2] = fexp(ls[4 * g + 2] + e2); P[4 * g + 1] = fexp(ls[4 * g + 1] + e1); P[4 * g] = fexp(ls[4 * g] + e0); }
        carry += (T[0] + T[1]) + (T[2] + T[3]);
#pragma unroll
        for (int t = 0; t < 2; ++t) { const bf16x8 pb = pack8(P[8 * t], P[8 * t + 1], P[8 * t + 2], P[8 * t + 3], P[8 * t + 4], P[8 * t + 5], P[8 * t + 6], P[8 * t + 7]);
            oacc[0] = MFMA32(va[t][0], pb, oacc[0]); oacc[1] = MFMA32(va[t][1], pb, oacc[1]); }
        if (__all(carry < -110.0f)) break;
    }
    if (qvalid) { float* op = OSB + (size_t)qrow * 512 + h * 64 + 4 * hi;
#pragma unroll
        for (int dt = 0; dt < 2; ++dt)
#pragma unroll
            for (int g = 0; g < 4; ++g) *(f32x4*)(op + dt * 32 + 8 * g) = (f32x4){oacc[dt][4 * g], oacc[dt][4 * g + 1], oacc[dt][4 * g + 2], oacc[dt][4 * g + 3]}; }
}

__device__ __forceinline__ void hg_load(const float* PROJ, int row0, int tvalid, int h, int tg, int k, int coff, float (&zr)[16]) {
#pragma unroll
    for (int j = 0; j < 16; ++j) { const int t = 16 * tg + j, tc = t < tvalid ? t : 0; zr[j] = PROJ[(size_t)(row0 + tc) * PLD + coff + h * 128 + k]; }
}
__device__ __forceinline__ void hg_prep(const float (&zr)[16], const float (&qr)[16], int tvalid, float lbv, int tg, float (&loc)[16], float (&kk)[16], float (&qv)[16]) {
    float run = 0.f;
#pragma unroll
    for (int j = 0; j < 16; ++j) { const int t = 16 * tg + j; const bool ok = t < tvalid; const float z = ok ? zr[j] : 0.f, q = ok ? qr[j] : 0.f;
        const float ez = fexp(-fabsf(z)), inv = __builtin_amdgcn_rcpf(1.f + ez);
        const float sig = z >= 0.f ? inv : ez * inv, nsig = z >= 0.f ? ez * inv : inv;
        float lf = (lbv > 0.f) ? flog(lbv + (1.f - lbv) * sig) : (fminf(z, 0.f) - flog(1.f + ez));
        if (!ok) lf = 0.f;
        run += lf; loc[j] = run; kk[j] = ok ? (1.f - lbv) * nsig : 0.f; qv[j] = q * 0.08838834764831845f; }
}
__device__ __forceinline__ void hg_h1(ldsp lds, const float* PROJ, const float (&zr)[16], int row0, int tvalid, int h, float lbv, float* dsOut, float* ddOut, const float* s0, int tid, int lane, int wave) {
    const int tg = tid >> 7, k = tid & 127;
    float loc[16], kk[16], qv[16], iv[16];
#pragma unroll
    for (int j = 0; j < 16; ++j) { const int ta = 16 * tg + j, tc = ta < tvalid ? ta : 0; const float x = PROJ[(size_t)(row0 + tc) * PLD + 2560 + h * 128 + k]; iv[j] = ta < tvalid ? x : 0.f; }
    hg_prep(zr, zr, tvalid, lbv, tg, loc, kk, qv);
    LAS float* TOT = (LAS float*)lds; LAS float* DK = (LAS float*)(lds + 2048);
    TOT[tg * 128 + k] = loc[15];
    __syncthreads();
    const float t0 = TOT[k], t1 = TOT[128 + k], t2 = TOT[256 + k], t3 = TOT[384 + k];
    const float r1 = t0, r2 = r1 + t1, r3 = r2 + t2, r4 = r3 + t3;
    const float rtg = tg == 0 ? 0.f : (tg == 1 ? r1 : (tg == 2 ? r2 : r3));
    { unsigned w[8];
#pragma unroll
      for (int jj = 0; jj < 8; ++jj) w[jj] = pk2(kk[2 * jj] * fexp(r4 - rtg - loc[2 * jj]), kk[2 * jj + 1] * fexp(r4 - rtg - loc[2 * jj + 1]));
      *(LAS u32x4*)(lds + 4096 + k * 144 + tg * 32) = (u32x4){w[0], w[1], w[2], w[3]}; *(LAS u32x4*)(lds + 4096 + k * 144 + tg * 32 + 16) = (u32x4){w[4], w[5], w[6], w[7]};
#pragma unroll
      for (int jj = 0; jj < 8; ++jj) w[jj] = pk2(iv[2 * jj], iv[2 * jj + 1]);
      *(LAS u32x4*)(lds + 22528 + k * 144 + tg * 32) = (u32x4){w[0], w[1], w[2], w[3]}; *(LAS u32x4*)(lds + 22528 + k * 144 + tg * 32 + 16) = (u32x4){w[4], w[5], w[6], w[7]}; }
    if (tg == 0) { const float dk = fexp(r4); DK[k] = dk; if (ddOut) ddOut[k] = dk; }
    __syncthreads();
    const int r32 = lane & 31, hi = lane >> 5, km = wave & 3, vn0 = (wave >> 2) * 2;
#pragma unroll
    for (int vv = 0; vv < 2; ++vv) { f32x16 acc;
#pragma unroll
        for (int i = 0; i < 16; ++i) acc[i] = 0.f;
#pragma unroll
        for (int ks = 0; ks < 4; ++ks) { const bf16x8 a = *(LAS bf16x8*)(lds + 4096 + (32 * km + r32) * 144 + ks * 32 + hi * 16);
            const bf16x8 b = *(LAS bf16x8*)(lds + 22528 + (32 * (vn0 + vv) + r32) * 144 + ks * 32 + hi * 16); acc = MFMA32(a, b, acc); }
        const int v = 32 * (vn0 + vv) + r32;
#pragma unroll
        for (int i = 0; i < 16; ++i) { const int kr = 32 * km + crow(i, hi); float val = acc[i]; if (s0) val += DK[kr] * s0[kr * 128 + v]; dsOut[kr * 128 + v] = val; } }
    __syncthreads();
}
__device__ __forceinline__ void hg_h3(ldsp lds, const float* PROJ, const float (&zr)[16], int row0, int tvalid, int h, float lbv, const float* Ssrc, const float* hgain, bf16_t* MIX, int tid, int lane, int wave) {
    constexpr int QE = 2048, KE = 19456, ST = 62976, IV = 97792, PM = 116224, OST = 19456;
    const int tg = tid >> 7, k = tid & 127;
    float loc[16], kk[16], qv[16];
    f32x4 gv[4], gav[4];
    float qr[16]; hg_load(PROJ, row0, tvalid, h, tg, k, 1536, qr);
    hg_prep(zr, qr, tvalid, lbv, tg, loc, kk, qv);
    LAS float* TOT = (LAS float*)lds;
    TOT[tg * 128 + k] = loc[15];
    for (int i = tid; i < 2304; i += 512) ((LAS unsigned*)(lds + PM))[i] = 0u;
#pragma unroll
    for (int jj = 0; jj < 16; ++jj) { const int kp = 2 * ((tid >> 7) + 4 * jj), v = tid & 127;
        *(LAS unsigned*)(lds + ST + v * 272 + kp * 2) = pk2(Ssrc[kp * 128 + v], Ssrc[(kp + 1) * 128 + v]); }
    { unsigned w[8];
#pragma unroll
      for (int jj = 0; jj < 8; ++jj) { const int ta = 16 * tg + 2 * jj, t0 = ta < tvalid ? ta : 0, t1 = (ta + 1) < tvalid ? ta + 1 : 0;
          const float x0 = PROJ[(size_t)(row0 + t0) * PLD + 2560 + h * 128 + k], x1 = PROJ[(size_t)(row0 + t1) * PLD + 2560 + h * 128 + k];
          w[jj] = pk2(ta < tvalid ? x0 : 0.f, (ta + 1) < tvalid ? x1 : 0.f); }
      *(LAS u32x4*)(lds + IV + k * 144 + tg * 32) = (u32x4){w[0], w[1], w[2], w[3]}; *(LAS u32x4*)(lds + IV + k * 144 + tg * 32 + 16) = (u32x4){w[4], w[5], w[6], w[7]}; }
    __syncthreads();
    { const int t = tid >> 3, v0 = (tid & 7) * 16; const int tc = t < tvalid ? t : 0; const float* gp = PROJ + (size_t)(row0 + tc) * PLD + 3072 + h * 128 + v0; const float* hg = hgain + h * 128 + v0;
#pragma unroll
      for (int c = 0; c < 4; ++c) { gv[c] = *(const f32x4*)(gp + 4 * c); gav[c] = *(const f32x4*)(hg + 4 * c); } }
    const float t0 = TOT[k], t1 = TOT[128 + k], t2 = TOT[256 + k];
    const float r1 = t0, r2 = r1 + t1, r3 = r2 + t2;
    const float rtg = tg == 0 ? 0.f : (tg == 1 ? r1 : (tg == 2 ? r2 : r3));
#pragma unroll
    for (int j = 0; j < 16; ++j) *(LAS unsigned short*)(lds + QE + (16 * tg + j) * 272 + k * 2) = (unsigned short)f2bf(qv[j] * fexp(loc[j]));
#pragma unroll
    for (int i = 0; i < 4; ++i) { if (i >= tg) { const float ri = i == 0 ? 0.f : (i == 1 ? r1 : (i == 2 ? r2 : r3)); const int rb = 8 * i * (i + 1);
#pragma unroll
        for (int j = 0; j < 16; ++j) *(LAS unsigned short*)(lds + KE + (rb + 16 * tg + j) * 272 + k * 2) = (unsigned short)f2bf(kk[j] * fexp(fminf(ri - rtg - loc[j], 80.f))); } }
    __syncthreads();
    { const int c16 = lane & 15, q4 = lane >> 4;
      for (int tix = wave; tix < 10; tix += 8) { const int i = tix < 1 ? 0 : (tix < 3 ? 1 : (tix < 6 ? 2 : 3)), j = tix - i * (i + 1) / 2, rb = 8 * i * (i + 1);
          f32x4 acc = {0.f, 0.f, 0.f, 0.f};
#pragma unroll
          for (int ks = 0; ks < 4; ++ks) { const bf16x8 a = *(LAS bf16x8*)(lds + QE + (16 * i + c16) * 272 + ks * 64 + q4 * 16);
              const bf16x8 b = *(LAS bf16x8*)(lds + KE + (rb + 16 * j + c16) * 272 + ks * 64 + q4 * 16); acc = MFMA16(a, b, acc); }
#pragma unroll
          for (int ii = 0; ii < 4; ++ii) { const int tl = 4 * q4 + ii; float pv = acc[ii]; if (i == j && c16 > tl) pv = 0.f;
              *(LAS unsigned short*)(lds + PM + (16 * i + tl) * 144 + (16 * j + c16) * 2) = (unsigned short)f2bf(pv); } } }
    __syncthreads();
#pragma unroll
    for (int j = 0; j < 16; ++j) *(LAS unsigned short*)(lds + QE + (16 * tg + j) * 272 + k * 2) = (unsigned short)f2bf(qv[j] * fexp(rtg + loc[j]));
    __syncthreads();
    { const int r32 = lane & 31, hi = lane >> 5, tm = wave & 1, vn = wave >> 1; f32x16 acc;
#pragma unroll
      for (int i = 0; i < 16; ++i) acc[i] = 0.f;
#pragma unroll
      for (int ks = 0; ks < 8; ++ks) { const bf16x8 a = *(LAS bf16x8*)(lds + QE + (32 * tm + r32) * 272 + ks * 32 + hi * 16);
          const bf16x8 b = *(LAS bf16x8*)(lds + ST + (32 * vn + r32) * 272 + ks * 32 + hi * 16); acc = MFMA32(a, b, acc); }
#pragma unroll
      for (int ks = 0; ks < 4; ++ks) { const bf16x8 a = *(LAS bf16x8*)(lds + PM + (32 * tm + r32) * 144 + ks * 32 + hi * 16);
          const bf16x8 b = *(LAS bf16x8*)(lds + IV + (32 * vn + r32) * 144 + ks * 32 + hi * 16); acc = MFMA32(a, b, acc); }
#pragma unroll
      for (int i = 0; i < 16; ++i) *(LAS float*)(lds + OST + (32 * tm + crow(i, hi)) * 528 + (32 * vn + r32) * 4) = acc[i]; }
    __syncthreads();
    { const int t = tid >> 3, v0 = (tid & 7) * 16; f32x4 o[4]; float ss = 0.f;
#pragma unroll
      for (int c = 0; c < 4; ++c) { o[c] = *(LAS f32x4*)(lds + OST + t * 528 + (v0 + 4 * c) * 4); ss += (o[c][0] * o[c][0] + o[c][1] * o[c][1]) + (o[c][2] * o[c][2] + o[c][3] * o[c][3]); }
      ss += __shfl_xor(ss, 1); ss += __shfl_xor(ss, 2); ss += __shfl_xor(ss, 4);
      const float rs = rsqrtf(ss * (1.0f / 128.0f) + 1e-6f);
      if (t < tvalid) { const size_t row = (size_t)(row0 + t); unsigned w[8];
#pragma unroll
          for (int c = 0; c < 4; ++c) { const f32x4 g = gv[c], ga = gav[c]; f32x4 r;
#pragma unroll
              for (int e = 0; e < 4; ++e) r[e] = o[c][e] * rs * ga[e] * (g[e] * __builtin_amdgcn_rcpf(1.f + fexp(-g[e])));
              w[2 * c] = pk2(r[0], r[1]); w[2 * c + 1] = pk2(r[2], r[3]); }
          bf16_t* mp = MIX + row * 1024 + 512 + h * 128 + v0;
          *(u32x4*)mp = (u32x4){w[0], w[1], w[2], w[3]}; *(u32x4*)(mp + 8) = (u32x4){w[4], w[5], w[6], w[7]}; } }
    __syncthreads();
}

__device__ __forceinline__ void xattn_item(ldsp lds, const bf16_t* QM, const float* Kg, const float* Vg, int row0, int tvalid, int hm, bf16_t* OM, int tid, int lane, int wave) {
    constexpr int KM = 0, QS = 69632, PMX = 87040, RMO = 120832, RSO = 121344, VT = 0;
#pragma unroll
    for (int jj = 0; jj < 8; ++jj) { const int cidx = tid + 512 * jj, m = cidx >> 4, dc = cidx & 15; const float* p = Kg + (size_t)m * 512 + dc * 8;
        const f32x4 a = *(const f32x4*)p, b = *(const f32x4*)(p + 4);
        *(LAS u32x4*)(lds + KM + m * 272 + dc * 16) = (u32x4){pk2(a[0], a[1]), pk2(a[2], a[3]), pk2(b[0], b[1]), pk2(b[2], b[3])}; }
#pragma unroll
    for (int jj = 0; jj < 2; ++jj) { const int cidx = tid + 512 * jj, t = cidx >> 4, dc = cidx & 15; u32x4 w = {0u, 0u, 0u, 0u};
        if (t < tvalid) w = *(const u32x4*)(QM + (size_t)(row0 + t) * 512 + hm * 128 + dc * 8);
        *(LAS u32x4*)(lds + QS + t * 272 + dc * 16) = w; }
    float vr0[32], vr1[32];
#pragma unroll
    for (int jj = 0; jj < 32; ++jj) { const int idx = tid + 512 * jj, d = idx & 127, mp = idx >> 7; vr0[jj] = Vg[(size_t)(2 * mp) * 512 + d]; vr1[jj] = Vg[(size_t)(2 * mp + 1) * 512 + d]; }
    __syncthreads();
    const int tgp = wave & 3, mh = wave >> 2, c16 = lane & 15, q4 = lane >> 4, tok = 16 * tgp + c16;
    LAS float* RM = (LAS float*)(lds + RMO); LAS float* RS = (LAS float*)(lds + RSO);
    f32x4 sacc[8];
    { bf16x8 bq[4];
#pragma unroll
      for (int ks = 0; ks < 4; ++ks) bq[ks] = *(LAS bf16x8*)(lds + QS + tok * 272 + ks * 64 + q4 * 16);
#pragma unroll
      for (int j = 0; j < 8; ++j) { f32x4 acc = {0.f, 0.f, 0.f, 0.f};
#pragma unroll
          for (int ks = 0; ks < 4; ++ks) { const bf16x8 a = *(LAS bf16x8*)(lds + KM + (128 * mh + 16 * j + c16) * 272 + ks * 64 + q4 * 16); acc = MFMA16(a, bq[ks], acc); }
          sacc[j] = acc; } }
    float mx = -3.0e38f;
#pragma unroll
    for (int j = 0; j < 8; ++j) mx = fmaxf(fmaxf(mx, fmaxf(sacc[j][0], sacc[j][1])), fmaxf(sacc[j][2], sacc[j][3]));
    mx = fmaxf(mx, __shfl_xor(mx, 16)); mx = fmaxf(mx, __shfl_xor(mx, 32));
    if (q4 == 0) RM[mh * 64 + tok] = mx;
    __syncthreads();
    { const float m = fmaxf(RM[tok], RM[64 + tok]); float sum = 0.f;
#pragma unroll
      for (int j = 0; j < 8; ++j) { const float p0 = fexp(sacc[j][0] - m), p1 = fexp(sacc[j][1] - m), p2 = fexp(sacc[j][2] - m), p3 = fexp(sacc[j][3] - m);
          sum += (p0 + p1) + (p2 + p3);
          *(LAS u32x2*)(lds + PMX + tok * 528 + (128 * mh + 16 * j + 4 * q4) * 2) = (u32x2){pk2(p0, p1), pk2(p2, p3)}; }
      sum += __shfl_xor(sum, 16); sum += __shfl_xor(sum, 32);
      if (q4 == 0) RS[mh * 64 + tok] = sum; }
    __syncthreads();
#pragma unroll
    for (int jj = 0; jj < 32; ++jj) { const int idx = tid + 512 * jj, d = idx & 127, mp = idx >> 7;
        *(LAS unsigned*)(lds + VT + d * 528 + mp * 4) = pk2(vr0[jj], vr1[jj]); }
    __syncthreads();
    { const int r32 = lane & 31, hi = lane >> 5, tm = wave & 1, dn = wave >> 1; f32x16 acc;
#pragma unroll
      for (int i = 0; i < 16; ++i) acc[i] = 0.f;
#pragma unroll
      for (int ks = 0; ks < 16; ++ks) { const bf16x8 a = *(LAS bf16x8*)(lds + PMX + (32 * tm + r32) * 528 + ks * 32 + hi * 16);
          const bf16x8 b = *(LAS bf16x8*)(lds + VT + (32 * dn + r32) * 528 + ks * 32 + hi * 16); acc = MFMA32(a, b, acc); }
#pragma unroll
      for (int i = 0; i < 16; ++i) { const int tk = 32 * tm + crow(i, hi); const float inv = __builtin_amdgcn_rcpf(RS[tk] + RS[64 + tk]);
          if (tk < tvalid) OM[(size_t)(row0 + tk) * 512 + hm * 128 + 32 * dn + r32] = (bf16_t)f2bf(acc[i] * inv); } }
    __syncthreads();
}
#define XB_TMO      128
#define XB_XCNT(j)  (256  + 64 * (j))
#define XB_XSUB(j)  (1280 + 64 * (j))
#define XB_XGEN(j)  (2304 + 64 * (j))
#define XB_TOP      3328
#define XB_TOPGEN   3392
#define XCD_BAR_WORDS 3456
#define XB_SPIN_CAP (1u << 18)

__device__ __forceinline__ unsigned xb_ld(unsigned* p)              { return __hip_atomic_load(p, __ATOMIC_RELAXED, __HIP_MEMORY_SCOPE_AGENT); }
__device__ __forceinline__ unsigned xb_add(unsigned* p, unsigned v) { return __hip_atomic_fetch_add(p, v, __ATOMIC_RELAXED, __HIP_MEMORY_SCOPE_AGENT); }
__device__ __forceinline__ unsigned xb_xcc_id() { return (unsigned)__builtin_amdgcn_s_getreg((3 << 11) | 20) & 0xFu; }
#define XB_SPIN(cond, bar) do { unsigned _sp = 0; while (cond) { __builtin_amdgcn_s_sleep(1); \
    if ((++_sp & 255u) == 0u) { if (xb_ld(&(bar)[XB_TMO])) break; if (_sp > XB_SPIN_CAP) { atomicAdd(&(bar)[XB_TMO], 1u); break; } } } } while (0)

struct XcdBarrier {
    unsigned* bar; unsigned x;
    volatile LAS unsigned* st;
};

__device__ __forceinline__ XcdBarrier xcd_barrier_post(unsigned* bar, volatile LAS unsigned* st) {
    XcdBarrier b; b.bar = bar; b.x = xb_xcc_id(); b.st = st;
    if (threadIdx.x == 0) (void)xb_add(&bar[XB_XCNT(b.x)], 1u);
    return b;
}
__device__ __forceinline__ void xcd_barrier_complete(unsigned* bar, unsigned x, unsigned& nloc, unsigned& nx) {
    const unsigned G = gridDim.x * gridDim.y * gridDim.z;
    unsigned sum, cnt, mine, sp = 0u;
    for (;;) {
        sum = 0u; cnt = 0u; mine = 0u;
#pragma unroll
        for (unsigned j = 0; j < 16; ++j) { const unsigned c = xb_ld(&bar[XB_XCNT(j)]); sum += c; cnt += (c > 0u) ? 1u : 0u; mine = (j == x) ? c : mine; }
        if (sum == G) break;
        __builtin_amdgcn_s_sleep(1);
        if ((++sp & 255u) == 0u) { if (xb_ld(&bar[XB_TMO])) break; if (sp > XB_SPIN_CAP) { atomicAdd(&bar[XB_TMO], 1u); break; } }
    }
    nloc = mine > 0u ? mine : 1u; nx = cnt > 0u ? cnt : 1u;
}

__device__ __forceinline__ void xcd_barrier(const XcdBarrier& b) {
    asm volatile("s_waitcnt vmcnt(0)" ::: "memory");
    __syncthreads();
    if (threadIdx.x == 0) {
        unsigned* bar = b.bar;
        __builtin_amdgcn_s_waitcnt(0);
        unsigned nloc = b.st[0], nx = b.st[1];
        if (nloc == 0u) { xcd_barrier_complete(bar, b.x, nloc, nx); b.st[0] = nloc; b.st[1] = nx; }
        const unsigned old = xb_add(&bar[XB_XSUB(b.x)], 1u);
        const unsigned gen = old / nloc;
        if (old + 1u == (gen + 1u) * nloc) {
            __builtin_amdgcn_fence(__ATOMIC_RELEASE, "agent");
            asm volatile("s_waitcnt vmcnt(0)" ::: "memory");
            const unsigned og = xb_add(&bar[XB_TOP], 1u);
            const unsigned tg = og / nx;
            if (og + 1u == (tg + 1u) * nx) xb_add(&bar[XB_TOPGEN], 1u);
            else XB_SPIN(xb_ld(&bar[XB_TOPGEN]) == tg, bar);
            __builtin_amdgcn_fence(__ATOMIC_ACQUIRE, "agent");
            xb_add(&bar[XB_XGEN(b.x)], 1u);
            asm volatile("s_waitcnt vmcnt(0)" ::: "memory");
        } else {
            XB_SPIN(xb_ld(&bar[XB_XGEN(b.x)]) == gen, bar);
            __builtin_amdgcn_fence(__ATOMIC_ACQUIRE, "agent");
            asm volatile("s_waitcnt vmcnt(0)" ::: "memory");
        }
    }
    __syncthreads();
}

__device__ __forceinline__ const float* gptr_(unsigned long long v) { return (const float*)(const __attribute__((address_space(1))) float*)v; }
#define GPTR(p) gptr_(p)
#define FPTR(p) ((const float*)(p))
#define OPQ(x) asm volatile("" : "+s"(x))
#define OPQP(T, x) do { unsigned long long xi_ = (unsigned long long)(x); asm volatile("" : "+s"(xi_)); x = (T*)(__attribute__((address_space(1))) T*)xi_; } while (0)
struct Args { const float* in[24]; float* out; unsigned char* ws; };
__global__ void __launch_bounds__(512, 2) mega_fwd(Args args) {
    extern __shared__ __attribute__((aligned(16))) unsigned char lds_raw[];
    cg::grid_group grid = cg::this_grid();
    ldsp lds = (ldsp)lds_raw;
    unsigned char* const ws = args.ws; float* const out = args.out;
#define WAVE_IDS int tid = threadIdx.x; asm volatile("" : "+v"(tid)); const int lane = tid & 63, wave = __builtin_amdgcn_readfirstlane(tid >> 6), G = gridDim.x, bid = blockIdx.x, gw = bid * 8 + wave, NGW = G * 8; (void)lane; (void)gw; (void)NGW

    {
        WAVE_IDS;
        if (bid == 0) for (int i = tid; i < XCD_BAR_WORDS; i += 512) ((unsigned*)(ws + WS_BAR))[i] = 0u;
        if (bid == 0 && tid < 8) ((unsigned*)(ws + WS_CTR))[tid] = 0u;
        if (tid < 2) ((LAS unsigned*)(lds + LDS_BARST))[tid] = 0u;
        if (bid == 0 && tid == 0) { const float** tab = (const float**)ws;
#pragma unroll
            for (int i = 0; i < 24; ++i) tab[i] = args.in[i]; }
        bf16_t* XB = (bf16_t*)(ws + WS_XB); float* SSQ = (float*)(ws + WS_SSQ); bf16_t* MEMB = (bf16_t*)(ws + WS_MEMB); float* MEMSSQ = (float*)(ws + WS_MEMSSQ); bf16_t* WMKV = (bf16_t*)(ws + WS_WMKV);
        LAS float* scr = (LAS float*)(lds + wave * 16384);
#define CONV_ITEM(PTR, L_, R_, WSB) do { const int l = (L_); int r = (R_); unsigned char* wl = (WSB) + WS_W0 + (size_t)l * WS_WL; bf16_t* wmkv = (bf16_t*)((WSB) + WS_WMKV); \
            if (r < 1792) { transpose_item(PTR(10) + (size_t)l * 1024 * 3584, 1024, 3584, (bf16_t*)(wl + W_IN), 0, PTR(9) + l * 1024, scr, r, lane); break; } r -= 1792; \
            if (r < 512)  { transpose_item(PTR(13) + (size_t)l * 1024 * 1024, 1024, 1024, (bf16_t*)(wl + W_OUT), 0, nullptr, scr, r, lane); break; } r -= 512; \
            if (r < 256)  { transpose_item(PTR(16) + (size_t)l * 1024 * 512, 1024, 512, (bf16_t*)(wl + W_MQ), 0, PTR(14) + l * 1024, scr, r, lane); break; } r -= 256; \
            if (r < 256)  { transpose_item(PTR(17) + (size_t)l * 1024 * 512, 1024, 512, wmkv + (size_t)l * 1024 * 1024, 0, PTR(15) + l * 1024, scr, r, lane); break; } r -= 256; \
            if (r < 256)  { transpose_item(PTR(18) + (size_t)l * 1024 * 512, 1024, 512, wmkv + (size_t)l * 1024 * 1024, 512, PTR(15) + l * 1024, scr, r, lane); break; } r -= 256; \
            if (r < 256)  { transpose_item(PTR(19) + (size_t)l * 512 * 1024, 512, 1024, (bf16_t*)(wl + W_MO), 0, nullptr, scr, r, lane); break; } r -= 256; \
            if (r < 2048) { transpose_item(PTR(21) + (size_t)l * 1024 * 4096, 1024, 4096, (bf16_t*)(wl + W_1), 0, PTR(20) + l * 1024, scr, r, lane); break; } r -= 2048; \
            transpose_item(PTR(22) + (size_t)l * 4096 * 1024, 4096, 1024, (bf16_t*)(wl + W_2), 0, nullptr, scr, r, lane); } while (0)
#define ARGP(i) args.in[i]
        const bool defer = (G == 256);
        for (int it = gw; it < (defer ? 3328 + 512 : 14848); it += NGW) {
            if (defer) { if (it < 3328) CONV_ITEM(ARGP, 0, it, ws); else CONV_ITEM(ARGP, 1, 2560 + (it - 3328), ws); }
            else { if (it < 7424) CONV_ITEM(ARGP, 0, it, ws); else CONV_ITEM(ARGP, 1, it - 7424, ws); } }
#undef ARGP
#define ROW_PTRS(m, S, D, Q, R) do { if ((m) < NPROMPT) { S = args.in[0] + (size_t)(m) * 1024; D = XB + (size_t)(m) * 1024; Q = SSQ + (size_t)(m) * 16; R = (float*)(ws + WS_RSTD) + (m); } \
            else if ((m) < M_ALL) { S = args.in[1] + (size_t)((m) - NPROMPT) * 1024; D = XB + (size_t)(m) * 1024; Q = SSQ + (size_t)(m) * 16; R = (float*)(ws + WS_RSTD) + (m); } \
            else { S = args.in[2] + (size_t)((m) - M_ALL) * 1024; D = MEMB + (size_t)((m) - M_ALL) * 1024; Q = MEMSSQ + (size_t)((m) - M_ALL) * 16; R = (float*)(ws + WS_MEMRSTD) + ((m) - M_ALL); } } while (0)
        for (int m0 = gw; m0 < M_ALL + 512; m0 += 2 * NGW) { const bool hasB = m0 + NGW < M_ALL + 512; const int m1 = hasB ? m0 + NGW : m0;
            const float *sA, *sB; bf16_t *dA, *dB; float *qA, *qB, *rA, *rB;
            ROW_PTRS(m0, sA, dA, qA, rA); ROW_PTRS(m1, sB, dB, qB, rB);
            row_prep2(sA, dA, qA, rA, sB, dB, qB, rB, hasB, lane); }
#undef ROW_PTRS
    }
    grid.sync();
    (void)xcd_barrier_post((unsigned*)(ws + WS_BAR), (volatile LAS unsigned*)(lds + LDS_BARST));
#define GRID_BAR() do { XcdBarrier b_; b_.bar = (unsigned*)(ws + WS_BAR); b_.x = xb_xcc_id(); b_.st = (volatile LAS unsigned*)(lds + LDS_BARST); xcd_barrier(b_); } while (0)

#pragma nounroll
    for (int l = 0; l < 2; ++l) {
#pragma nounroll
        for (int q = 0; q < (l == 0 ? 2 : 1); ++q) {
            WAVE_IDS; unsigned char* w_ = ws; float* o_ = out; int l_ = l; OPQP(unsigned char, w_); OPQP(float, o_); OPQ(l_);
            Gemm g; EpiF32 E;
            if (q == 0) { g = Gemm{(const bf16_t*)(w_ + WS_XB), (const bf16_t*)(w_ + WS_W0 + (size_t)l_ * WS_WL + W_IN), M_ALL, 3584, 1024};
                E = EpiF32{0, (const float*)(w_ + WS_RSTD), (float*)(w_ + WS_PROJ), o_, l_, (bf16_t*)(w_ + WS_VT), (bf16_t*)(w_ + WS_KB)}; }
            else { g = Gemm{(const bf16_t*)(w_ + WS_MEMB), (const bf16_t*)(w_ + WS_WMKV), 512, 2048, 1024};
                E = EpiF32{1, (const float*)(w_ + WS_MEMRSTD), nullptr, o_, l_, nullptr, nullptr}; }
            StaticOrder S; S.init(g.M, g.N, G, q == 0 ? bid : (bid + 16) % G);
            gemm_phase<EpiF32, StaticOrder, true, true>(lds, g, S, E);
        }
        if (l == 0 && gridDim.x == 256 && blockIdx.x >= 156 && blockIdx.x < 240) {
            WAVE_IDS; unsigned char* w_ = ws; OPQP(unsigned char, w_);
            const unsigned long long* tabc = (const unsigned long long*)w_; LAS float* scr = (LAS float*)(lds + wave * 16384);
#define TABP(i) FPTR(tabc[i])
            for (int j = (bid - 156) * 8 + wave; j < 4096; j += 84 * 8) CONV_ITEM(TABP, 0, 3328 + j, w_);
#undef TABP
        }
        GRID_BAR();
#pragma nounroll
        for (int ph = 0; ph < 3; ++ph) {
            WAVE_IDS; unsigned char* w_ = ws; float* o_ = out; int l_ = l; OPQP(unsigned char, w_); OPQP(float, o_); OPQ(l_);
            const unsigned long long* tab = (const unsigned long long*)w_;
            float* PROJ = (float*)(w_ + WS_PROJ); float* OSB = (float*)(w_ + WS_OSB); bf16_t* MIX = (bf16_t*)(w_ + WS_MIX); float* DS = (float*)(w_ + WS_DS); float* DD = (float*)(w_ + WS_DD);
            if (ph != 1) {
                const int nit = ph == 0 ? 1152 : 1024;
                const float* state_hgrn = GPTR(tab[5]); const float* lb_logits = GPTR(tab[8]); const float* hgain = GPTR(tab[12]) + l_ * 512;
#define HG_DECODE(IT, ROW0, TV, H) do { if ((IT) < 1024) { const int bh_ = (IT) >> 7; H = bh_ & 3; ROW0 = (bh_ >> 2) * 8192 + ((IT) & 127) * 64; TV = 64; } \
                    else { const int si_ = (IT) - 1024; H = si_ & 3; ROW0 = NPROMPT + 16 * (si_ >> 2); TV = 16; } } while (0)
#define HG_MAP(Q) (ph == 0 ? ((Q) < 128 ? 1024 + (Q) : (Q) - 128) : (Q))
                volatile LAS unsigned* LW = (volatile LAS unsigned*)(lds + LDS_BARST);
                unsigned* ctr = (unsigned*)(w_ + WS_CTR) + 2 * l_;
                unsigned nextq = 0; int cur;
                if (ph == 0) { if (tid == 0) LW[4] = atomicAdd(ctr, 1u); __syncthreads(); cur = (int)LW[4]; if (tid == 0) nextq = atomicAdd(ctr, 1u); }
                else cur = bid;
                while (cur < nit) {
                    const int it = HG_MAP(cur); int nxt;
                    if (ph == 0) { __syncthreads(); if (tid == 0) LW[4] = nextq; __syncthreads(); nxt = (int)LW[4]; if (tid == 0 && nxt < nit) nextq = atomicAdd(ctr, 1u); }
                    else nxt = cur + G;
                    int row0, tvalid, h; HG_DECODE(it, row0, tvalid, h);
                    float* dsOut; float* ddOut; const float* s0; const float* Ssrc;
                    if (it < 1024) { const int bh = it >> 7, c = it & 127; dsOut = DS + (size_t)(bh * 128 + c) * 16384; ddOut = DD + (size_t)(bh * 128 + c) * 128; s0 = nullptr; Ssrc = dsOut; }
                    else { const int si = it - 1024, s = si >> 2; s0 = state_hgrn + (size_t)((l_ * 32 + s) * 4 + h) * 16384; Ssrc = s0; dsOut = o_ + O_HS + (size_t)((l_ * 32 + s) * 4 + h) * 16384; ddOut = nullptr; }
                    int t2 = tid; asm volatile("" : "+v"(t2)); const int lane2 = t2 & 63, tg2 = t2 >> 7, k2 = t2 & 127;
                    const int ch = h * 128 + k2;
                    const float lbv = l_ == 0 ? 0.f : __builtin_amdgcn_rcpf(1.f + fexp(lb_logits[ch] - lb_logits[512 + ch]));
                    { float zc[16]; hg_load(PROJ, row0, tvalid, h, tg2, k2, 2048, zc);
                      if (ph == 0) hg_h1(lds, PROJ, zc, row0, tvalid, h, lbv, dsOut, ddOut, s0, t2, lane2, wave);
                      if (ph == 2 || it >= 1024) hg_h3(lds, PROJ, zc, row0, tvalid, h, lbv, Ssrc, hgain, MIX, t2, lane2, wave); }
                    cur = nxt;
                }
#undef HG_DECODE
#undef HG_MAP
                if (ph == 0) { unsigned char* w2 = ws; float* o2 = out; int l2 = l; OPQP(unsigned char, w2); OPQP(float, o2); OPQ(l2);
                    const unsigned long long* tab2 = (const unsigned long long*)w2; unsigned* ctr2 = (unsigned*)(w2 + WS_CTR) + 2 * l2 + 1;
                    unsigned wq = 0; if (lane == 0) wq = atomicAdd(ctr2, 1u); int w = __builtin_amdgcn_readfirstlane(wq);
                    while (w < 4352) { unsigned wn = 0; if (lane == 0) wn = atomicAdd(ctr2, 1u);
                        int lane2 = lane; asm volatile("" : "+v"(lane2));
                        if (w < 256) sb_item<true>(4096 + w, l2, (const float*)(w2 + WS_PROJ), o2 + O_KP + (size_t)l2 * NPROMPT * 512, o2 + O_VP + (size_t)l2 * NPROMPT * 512,
                                                    o2 + O_KS + (size_t)l2 * 262144, o2 + O_VS + (size_t)l2 * 262144, GPTR(tab2[3]), GPTR(tab2[4]), (const bf16_t*)(w2 + WS_VT), (const bf16_t*)(w2 + WS_KB), (float*)(w2 + WS_OSB), lane2);
                        else sb_item<false>(w - 256, l2, (const float*)(w2 + WS_PROJ), o2 + O_KP + (size_t)l2 * NPROMPT * 512, o2 + O_VP + (size_t)l2 * NPROMPT * 512,
                                                    o2 + O_KS + (size_t)l2 * 262144, o2 + O_VS + (size_t)l2 * 262144, GPTR(tab2[3]), GPTR(tab2[4]), (const bf16_t*)(w2 + WS_VT), (const bf16_t*)(w2 + WS_KB), (float*)(w2 + WS_OSB), lane2);
                        w = __builtin_amdgcn_readfirstlane(wn); } }
            } else {
                if (wave < 4) {
                    for (int e0 = bid * 256 + tid; e0 < 65536; e0 += G * 256) { const int e1 = e0 + 65536;
                        float* dsa = DS + (size_t)((e0 >> 14) * 128) * 16384 + (e0 & 16383); const float* dda = DD + (size_t)((e0 >> 14) * 128) * 128 + ((e0 & 16383) >> 7);
                        float* dsb = DS + (size_t)((e1 >> 14) * 128) * 16384 + (e1 & 16383); const float* ddb = DD + (size_t)((e1 >> 14) * 128) * 128 + ((e1 & 16383) >> 7);
                        float Sa = 0.f, Sb = 0.f;
                        for (int c = 0; c < 128; c += 16) { float xa[16], da[16], xb[16], db[16];
#pragma unroll
                            for (int u = 0; u < 16; ++u) { xa[u] = dsa[(size_t)(c + u) * 16384]; da[u] = dda[(c + u) * 128]; xb[u] = dsb[(size_t)(c + u) * 16384]; db[u] = ddb[(c + u) * 128]; }
#pragma unroll
                            for (int u = 0; u < 16; ++u) { dsa[(size_t)(c + u) * 16384] = Sa; Sa = da[u] * Sa + xa[u]; dsb[(size_t)(c + u) * 16384] = Sb; Sb = db[u] * Sb + xb[u]; } }
                        o_[O_HP + (size_t)l_ * 131072 + e0] = Sa; o_[O_HP + (size_t)l_ * 131072 + e1] = Sb; }
                } else {
                    const float* sbg = GPTR(tab[11]) + l_ * 512; const int NW4 = G * 4;
                    const f32x4 ga = *(const f32x4*)(sbg + lane * 8), gb = *(const f32x4*)(sbg + lane * 8 + 4);
                    int m = bid * 4 + (wave - 4); f32x4 a = {0.f, 0.f, 0.f, 0.f}, b = a;
                    if (m < M_ALL) { const f32x4* op = (const f32x4*)(OSB + (size_t)m * 512 + lane * 8); a = op[0]; b = op[1]; }
                    while (m < M_ALL) { const int mn = m + NW4; f32x4 an = a, bn = b;
                        if (mn < M_ALL) { const f32x4* op = (const f32x4*)(OSB + (size_t)mn * 512 + lane * 8); an = op[0]; bn = op[1]; }
                        float ss = ((a[0] * a[0] + a[1] * a[1]) + (a[2] * a[2] + a[3] * a[3])) + ((b[0] * b[0] + b[1] * b[1]) + (b[2] * b[2] + b[3] * b[3]));
                        ss = wave_sum(ss); const float rs = rsqrtf(ss * (1.0f / 512.0f) + 1e-6f);
                        *(u32x4*)(MIX + (size_t)m * 1024 + lane * 8) = (u32x4){pk2(a[0] * rs * ga[0], a[1] * rs * ga[1]), pk2(a[2] * rs * ga[2], a[3] * rs * ga[3]),
                                                                              pk2(b[0] * rs * gb[0], b[1] * rs * gb[1]), pk2(b[2] * rs * gb[2], b[3] * rs * gb[3])};
                        a = an; b = bn; m = mn; } }
            }
            GRID_BAR();
        }
#pragma nounroll
        for (int st = 0; st < 3; ++st) {
            { WAVE_IDS; unsigned char* w_ = ws; int l_ = l; OPQP(unsigned char, w_); OPQ(l_);
              const unsigned long long* tab = (const unsigned long long*)w_; unsigned char* wl = w_ + WS_W0 + (size_t)l_ * WS_WL;
              float* X = (float*)(w_ + WS_X);
              const bf16_t* A = (const bf16_t*)(w_ + (st == 0 ? WS_MIX : (st == 1 ? WS_OM : WS_H))); const bf16_t* Bt = (const bf16_t*)(wl + (st == 0 ? W_OUT : (st == 1 ? W_MO : W_2)));
              const int K = st == 0 ? 1024 : (st == 1 ? 512 : 4096);
              { Gemm g{A, Bt, NPROMPT, 1024, K, 0};
                EpiResid E{(st == 0 && l_ == 0) ? FPTR(tab[0]) : X, nullptr, X, (bf16_t*)(w_ + WS_XB), (float*)(w_ + WS_SSQ)};
                StaticOrder S; S.init(NPROMPT, 1024, G, bid);
                gemm_phase<EpiResid, StaticOrder, true, true>(lds, g, S, E); }
              { Gemm g{A, Bt, M_ALL, 1024, 256, K};
                EpiPart E{(float*)(w_ + WS_PART)};
                SplitOrder S; S.init(2, 1024, K / 256, G, bid, 64);
                gemm_phase<EpiPart, SplitOrder, true, true>(lds, g, S, E); } }
            GRID_BAR();
            { WAVE_IDS; unsigned char* w_ = ws; int l_ = l; OPQP(unsigned char, w_); OPQ(l_);
              const unsigned long long* tab = (const unsigned long long*)w_; const int nS = (st == 0 ? 1024 : (st == 1 ? 512 : 4096)) / 256;
              float* X = (float*)(w_ + WS_X); bf16_t* XB = (bf16_t*)(w_ + WS_XB); float* SSQ = (float*)(w_ + WS_SSQ); const float* PART = (const float*)(w_ + WS_PART);
              const float* bs = (st == 0 && l_ == 0) ? FPTR(tab[1]) : X + (size_t)NPROMPT * 1024;
              LAS float* red = (LAS float*)lds;
              for (int mb = bid; mb < 256; mb += G) { const int m = mb * 2 + (wave >> 2), cq = wave & 3, col = cq * 256 + lane * 4;
                  f32x4 v = *(const f32x4*)(bs + (size_t)m * 1024 + col); f32x4 pp[16];
#pragma unroll
                  for (int ks = 0; ks < 16; ++ks) { const int kc = ks < nS ? ks : 0; pp[ks] = *(const f32x4*)(PART + ((size_t)kc * 512 + m) * 1024 + col); }
#pragma unroll
                  for (int ks = 0; ks < 16; ++ks) { const float on = ks < nS ? 1.f : 0.f; v += pp[ks] * on; }
                  *(f32x4*)(X + (size_t)(NPROMPT + m) * 1024 + col) = v;
                  u32x2 w; w.x = pk2(v[0], v[1]); w.y = pk2(v[2], v[3]); *(u32x2*)(XB + (size_t)(NPROMPT + m) * 1024 + col) = w;
                  float s = wave_sum((v[0] * v[0] + v[1] * v[1]) + (v[2] * v[2] + v[3] * v[3]));
                  if (lane == 0) red[wave] = s;
                  __syncthreads();
                  if (cq == 0 && lane == 0) ((float*)(w_ + WS_RSTD))[NPROMPT + m] = rsqrtf(((red[wave] + red[wave + 1]) + (red[wave + 2] + red[wave + 3])) * (1.0f / 1024.0f) + 1e-6f);
                  __syncthreads(); }
              if (tid < 64) for (int r = bid * 64 + tid; r < NPROMPT; r += G * 64) ((float*)(w_ + WS_RSTD))[r] = row_rstd(SSQ, r); }
            GRID_BAR();
            if (st < 2) {
                WAVE_IDS; unsigned char* w_ = ws; int l_ = l; OPQP(unsigned char, w_); OPQ(l_); unsigned char* wl = w_ + WS_W0 + (size_t)l_ * WS_WL;
                Gemm g; EpiBf16S E;
                if (st == 0) { g = Gemm{(const bf16_t*)(w_ + WS_XB), (const bf16_t*)(wl + W_MQ), M_ALL, 512, 1024}; E = EpiBf16S{(bf16_t*)(w_ + WS_QM), 512, (const float*)(w_ + WS_RSTD), 0.08838834764831845f, 0}; }
                else { g = Gemm{(const bf16_t*)(w_ + WS_XB), (const bf16_t*)(wl + W_1), M_ALL, 4096, 1024}; E = EpiBf16S{(bf16_t*)(w_ + WS_H), 4096, (const float*)(w_ + WS_RSTD), 1.0f, 1}; }
                StaticOrder S; S.init(M_ALL, g.N, G, bid);
                gemm_phase<EpiBf16S, StaticOrder, true, true>(lds, g, S, E);
                if (st == 0 && l_ == 0 && bid >= 132 && G == 256) {
                    const unsigned long long* tabc = (const unsigned long long*)w_; LAS float* scr = (LAS float*)(lds + wave * 16384);
#define TABP(i) FPTR(tabc[i])
                    for (int j = (bid - 132) * 8 + wave; j < 6912; j += 124 * 8) CONV_ITEM(TABP, 1, j < 2560 ? j : j + 512, w_);
#undef TABP
                }
                GRID_BAR();
            }
            if (st == 0) {
                WAVE_IDS; unsigned char* w_ = ws; float* o_ = out; int l_ = l; OPQP(unsigned char, w_); OPQP(float, o_); OPQ(l_);
                const unsigned long long* tab = (const unsigned long long*)w_; const float* cache_mk = GPTR(tab[6]); const float* cache_mv = GPTR(tab[7]);
                const bf16_t* QM = (const bf16_t*)(w_ + WS_QM); bf16_t* OM = (bf16_t*)(w_ + WS_OM);
                for (int it = bid; it < 1152; it += G) {
                    int row0, tvalid, hm; const float* Kg; const float* Vg;
                    if (it < 1024) { const int tt = it >> 2; hm = it & 3; row0 = tt * 64; tvalid = 64; const int b = tt >> 7;
                        Kg = o_ + O_MKP + (size_t)(l_ * 2 + b) * 131072 + hm * 128; Vg = o_ + O_MVP + (size_t)(l_ * 2 + b) * 131072 + hm * 128; }
                    else { const int si = it - 1024, s = si >> 2; hm = si & 3; row0 = NPROMPT + 16 * s; tvalid = 16;
                        Kg = cache_mk + (size_t)(l_ * 32 + s) * 131072 + hm * 128; Vg = cache_mv + (size_t)(l_ * 32 + s) * 131072 + hm * 128; }
                    int t2 = tid; asm volatile("" : "+v"(t2));
                    xattn_item(lds, QM, Kg, Vg, row0, tvalid, hm, OM, t2, t2 & 63, wave);
                }
                GRID_BAR();
            }
        }
    }
    { WAVE_IDS; unsigned char* w_ = ws; float* o_ = out; OPQP(unsigned char, w_); OPQP(float, o_);
      const float* nf = GPTR(((const unsigned long long*)w_)[23]); const float* X = (const float*)(w_ + WS_X);
      for (int m0 = gw; m0 < M_ALL; m0 += 2 * NGW) { const int m1 = (m0 + NGW < M_ALL) ? m0 + NGW : m0;
          const f32x4* xa = (const f32x4*)(X + (size_t)m0 * 1024) + lane; const f32x4* xb = (const f32x4*)(X + (size_t)m1 * 1024) + lane; f32x4 va[4], vb[4]; float sa = 0.f, sb = 0.f;
#pragma unroll
          for (int j = 0; j < 4; ++j) { va[j] = xa[64 * j]; vb[j] = xb[64 * j]; }
#pragma unroll
          for (int j = 0; j < 4; ++j) { sa += (va[j][0] * va[j][0] + va[j][1] * va[j][1]) + (va[j][2] * va[j][2] + va[j][3] * va[j][3]); sb += (vb[j][0] * vb[j][0] + vb[j][1] * vb[j][1]) + (vb[j][2] * vb[j][2] + vb[j][3] * vb[j][3]); }
          sa = wave_sum(sa); sb = wave_sum(sb); const float ra = rsqrtf(sa * (1.0f / 1024.0f) + 1e-6f), rb = rsqrtf(sb * (1.0f / 1024.0f) + 1e-6f);
          f32x4* ya = (f32x4*)(o_ + (m0 < NPROMPT ? O_YP + (size_t)m0 * 1024 : O_YS + (size_t)(m0 - NPROMPT) * 1024)) + lane;
          f32x4* yb = (f32x4*)(o_ + (m1 < NPROMPT ? O_YP + (size_t)m1 * 1024 : O_YS + (size_t)(m1 - NPROMPT) * 1024)) + lane;
#pragma unroll
          for (int j = 0; j < 4; ++j) { const f32x4 g = *((const f32x4*)nf + lane + 64 * j); ya[64 * j] = va[j] * ra * g; if (m1 != m0) yb[64 * j] = vb[j] * rb * g; } } }
}

extern "C" void kernel_launch(void* const* d_in, const int* in_sizes, int n_in, void* d_out, int out_size, void* d_ws, size_t ws_size, hipStream_t stream) {
    static int grid = 0;
    if (grid == 0) {
        int dev = 0, cus = 0, per_cu = 0;
        (void)hipGetDevice(&dev); (void)hipDeviceGetAttribute(&cus, hipDeviceAttributeMultiprocessorCount, dev);
        if (hipFuncSetAttribute((const void*)mega_fwd, hipFuncAttributeMaxDynamicSharedMemorySize, LDS_BYTES) != hipSuccess) fprintf(stderr, "kernel_launch: hipFuncSetAttribute failed\n");
        if (hipOccupancyMaxActiveBlocksPerMultiprocessor(&per_cu, (const void*)mega_fwd, 512, LDS_BYTES) != hipSuccess || per_cu < 1) { fprintf(stderr, "kernel_launch: occupancy query says %d\n", per_cu); per_cu = 1; }
        (void)hipGetLastError();
        if (cus <= 0) cus = 256;
        grid = cus;
    }
    Args a{};
    for (int i = 0; i < 24; ++i) a.in[i] = (const float*)d_in[i];
    a.out = (float*)d_out; a.ws = (unsigned char*)d_ws;
    void* kargs[] = {&a};
    const hipError_t e = hipLaunchCooperativeKernel((const void*)mega_fwd, dim3(grid), dim3(512), kargs, LDS_BYTES, stream);
    if (e != hipSuccess) fprintf(stderr, "kernel_launch: cooperative launch failed: %s (grid %d)\n", hipGetErrorString(e), grid);
}
```

```cpp
#include <hip/hip_runtime.h>
#include <hip/hip_cooperative_groups.h>
#include <cstdio>
#include <cstdint>
namespace cg = cooperative_groups;
namespace pg8 {
#define PG8_LAS __attribute__((address_space(3)))
typedef unsigned short bf16_t;
typedef short bf16x8 __attribute__((ext_vector_type(8)));
typedef float f32x4 __attribute__((ext_vector_type(4)));
typedef unsigned u32x4 __attribute__((ext_vector_type(4)));
constexpr int BM = 256, BK = 64, HALF = 128, HTB = HALF * BK * 2  , STAGE_BYTES = 8 * HTB, NXCD = 8, WGM = 8;

__host__ __device__ __forceinline__ int lds_byte(int r, int c) { const int st = (r >> 4) * 2 + (c >> 5), rr = r & 15, cc = c & 31, ob = rr * 64 + cc * 2; return st * 1024 + (ob ^ (((ob >> 9) & 1) << 5)); }
__host__ __device__ __forceinline__ void stage_rc(int b, int& R, int& C) { const int st = b / 1024, sb = b % 1024, swz = sb ^ (((sb >> 9) & 1) << 5); R = (st >> 1) * 16 + swz / 64; C = (st & 1) * 32 + (swz % 64) / 2; }
__host__ __device__ __forceinline__ int perm32(int rho) { const int n = rho >> 4, i = rho & 15; return 8 * (i >> 2) + 4 * n + (i & 3); }

struct Unit { int pm, pn, ks; };
struct Gemm { const bf16_t* A; const bf16_t* Bt; int M, N, K, ld; };

struct StaticOrder {
    int nM, nN, nwg, G, c;
    __host__ __device__ void init(int M, int N, int G_, int c_) { nM = M / BM; nN = N / BM; nwg = nM * nN; G = G_; c = c_; }
    __host__ __device__ bool next(int i, Unit& u) const {
        const long L = (long)i * G + c; if (L >= nwg) return false;
        int wgid = (int)L; { const int q = nwg / NXCD, r = nwg % NXCD, xcd = wgid % NXCD, off = wgid / NXCD; wgid = (xcd < r ? xcd * (q + 1) : r * (q + 1) + (xcd - r) * q) + off; }
        const int nig = WGM * nN, gid = wgid / nig, fm = gid * WGM, gsz = (nM - fm) < WGM ? (nM - fm) : WGM;
        u.pm = fm + ((wgid % nig) % gsz); u.pn = (wgid % nig) / gsz; u.ks = 0; return true;
    }
    __device__ __forceinline__ void a_ready(const Unit&) const {}
    __device__ __forceinline__ void done(const Unit&) const {}
};
struct SplitOrder {
    int nN, nS, nwg, G, c, pm0;
    __host__ __device__ void init(int nMs, int N, int nS_, int G_, int c_, int pm0_) { nN = N / BM; nS = nS_; nwg = nMs * nN * nS; G = G_; c = c_; pm0 = pm0_; }
    __host__ __device__ bool next(int i, Unit& u) const { const long L = (long)i * G + c; if (L >= nwg) return false; const int t = (int)L / nS; u.ks = (int)L % nS; u.pn = t % nN; u.pm = pm0 + t / nN; return true; }
    __device__ __forceinline__ void a_ready(const Unit&) const {}
    __device__ __forceinline__ void done(const Unit&) const {}
};
__device__ __forceinline__ unsigned cvt_pk_bf16(float lo, float hi) { unsigned r; asm volatile("v_cvt_pk_bf16_f32 %0, %1, %2" : "=v"(r) : "v"(lo), "v"(hi)); return r; }
typedef float f32x2 __attribute__((ext_vector_type(2)));
typedef unsigned u32x2 __attribute__((ext_vector_type(2)));
constexpr int NPROMPT = 16384;
constexpr size_t O_YP = 0, O_YS = 16777216, O_KP = 17301504, O_VP = 34078720, O_HP = 50855936, O_MKP = 51118080, O_MVP = 51642368,
                 O_KS = 52166656, O_VS = 52690944, O_HS = 53215232;
__device__ __forceinline__ float row_rstd(const float* ssq, int row) {
    const f32x4* p = (const f32x4*)(ssq + (size_t)row * 16);
    const f32x4 a = p[0], b = p[1], c = p[2], d = p[3];
    const float s = (((a[0] + a[1]) + (a[2] + a[3])) + ((b[0] + b[1]) + (b[2] + b[3]))) + (((c[0] + c[1]) + (c[2] + c[3])) + ((d[0] + d[1]) + (d[2] + d[3])));
    return rsqrtf(s * (1.0f / 1024.0f) + 1e-6f);
}
struct EpiF32 {
    static constexpr bool PERM = true, AFTER_DRAIN = false;
    int mode; const float* rstd; float* proj; float* outp; int l; bf16_t* vt; bf16_t* kb;
    __device__ __forceinline__ void operator()(const f32x4 (&acc)[2][2][4][2], const Unit& u, int wr, int wc, int fr_, int fq_) const {
        int tq = threadIdx.x; asm volatile("" : "+v"(tq)); const int fr = tq & 15, fq = (tq >> 4) & 3;
        float* base; int pitch, colt, rsub = 0; const int pn = u.pn;
        if (mode == 0) {
            if (pn >= 2 && pn < 6) { const size_t isv = pn >= 4 ? 1 : 0; colt = (pn & 1) * 256; pitch = 512;
                if (u.pm < 64) base = outp + (O_KP + isv * (O_VP - O_KP) + (size_t)l * NPROMPT * 512);
                else { base = outp + (O_KS + isv * (O_VS - O_KS) + (size_t)l * 262144); rsub = NPROMPT; } }
            else { base = proj; pitch = 3584; colt = pn * 256; }
        } else { const size_t sel = (size_t)(pn >> 1); base = outp + (O_MKP + (sel & 1) * (O_MVP - O_MKP) + (sel >> 1) * 262144); pitch = 512; colt = (pn & 1) * 256; }
        const int col0 = colt + wc * 32 + 8 * fq, rowb = u.pm * BM + wr * 64 + fr;
        float rs[2][4];
#pragma unroll
        for (int ai = 0; ai < 2; ++ai)
#pragma unroll
            for (int m = 0; m < 4; ++m) rs[ai][m] = rstd[rowb + ai * HALF + m * 16];
#pragma unroll
        for (int ai = 0; ai < 2; ++ai)
#pragma unroll
            for (int m = 0; m < 4; ++m) { const int row = rowb + ai * HALF + m * 16;
                float* rp = base + (size_t)(row - rsub) * pitch + col0;
#pragma unroll
                for (int bj = 0; bj < 2; ++bj)
#pragma unroll
                    for (int n = 0; n < 2; ++n) *(f32x4*)(rp + bj * HALF + n * 4) = acc[ai][bj][m][n] * rs[ai][m]; }
        if (mode == 0 && pn >= 2 && pn < 4 && u.pm < 64) {
#pragma unroll
            for (int ai = 0; ai < 2; ++ai)
#pragma unroll
                for (int m = 0; m < 4; ++m) { const int row = rowb + ai * HALF + m * 16, t = row & 8191;
#pragma unroll
                    for (int bj = 0; bj < 2; ++bj) { const f32x4 v0 = acc[ai][bj][m][0] * rs[ai][m], v1 = acc[ai][bj][m][1] * rs[ai][m]; const int c = col0 + bj * HALF, hh = c >> 6, d0 = c & 63;
                        u32x4 w; w.x = cvt_pk_bf16(v0[0], v0[1]); w.y = cvt_pk_bf16(v0[2], v0[3]); w.z = cvt_pk_bf16(v1[0], v1[1]); w.w = cvt_pk_bf16(v1[2], v1[3]);
                        *(u32x4*)(kb + ((((size_t)((row >> 13) * 8 + hh) * 256 + (t >> 5)) * 8 + (d0 >> 3)) * 32 + (t & 31)) * 8) = w; } }
        }
        if (mode == 0 && pn >= 4 && pn < 6 && u.pm < 64) {
            const int qi = fr & 3;
#pragma unroll
            for (int ai = 0; ai < 2; ++ai)
#pragma unroll
                for (int m = 0; m < 4; ++m) { const int row = rowb + ai * HALF + m * 16, t0 = (row & 8191) & ~3; const size_t tb = ((size_t)(row >> 13) * 8 * 2048 * 64 + (size_t)(t0 >> 2) * 64) * 4;
#pragma unroll
                    for (int bj = 0; bj < 2; ++bj)
#pragma unroll
                        for (int n = 0; n < 2; ++n) { const f32x4 v = acc[ai][bj][m][n] * rs[ai][m]; const int c = col0 + bj * HALF + n * 4;
                            const unsigned p01 = cvt_pk_bf16(v[0], v[1]), p23 = cvt_pk_bf16(v[2], v[3]);
                            const unsigned snd1 = (qi & 2) ? p01 : p23, kep1 = (qi & 2) ? p23 : p01, rcv1 = (unsigned)__shfl_xor((int)snd1, 2);
                            const unsigned q0 = (qi & 2) ? rcv1 : kep1, q2 = (qi & 2) ? kep1 : rcv1;
                            const unsigned los = (q0 & 0xffffu) | (q2 << 16), his = (q0 >> 16) | (q2 & 0xffff0000u);
                            const unsigned rcv2 = (unsigned)__shfl_xor((int)((qi & 1) ? los : his), 1), mine = (qi & 1) ? his : los;
                            u32x2 w;
                            if (qi & 1) { w.x = (rcv2 & 0xffffu) | (mine << 16); w.y = (rcv2 >> 16) | (mine & 0xffff0000u); }
                            else { w.x = (mine & 0xffffu) | (rcv2 << 16); w.y = (mine >> 16) | (rcv2 & 0xffff0000u); }
                            const int cc = c + (qi & 2) + (qi & 1), hh = cc >> 6, dd = cc & 63;
                            *(u32x2*)(vt + tb + ((size_t)hh * 2048 * 64 + dd) * 4) = w; } }
        }
    }
};
struct EpiResid {
    static constexpr bool PERM = true, AFTER_DRAIN = false;
    const float* bp; const float* bs; float* X; bf16_t* XB; float* ssq;
    __device__ __forceinline__ void operator()(const f32x4 (&acc)[2][2][4][2], const Unit& u, int wr, int wc, int fr_, int fq_) const {
        int tq = threadIdx.x; asm volatile("" : "+v"(tq)); const int fr = tq & 15, fq = (tq >> 4) & 3;
        const int col0 = u.pn * BM + wc * 32 + 8 * fq;
#pragma unroll
        for (int ai = 0; ai < 2; ++ai) {
            f32x4 res[4][2][2];
#pragma unroll
            for (int m = 0; m < 4; ++m) { const int row = u.pm * BM + ai * HALF + wr * 64 + m * 16 + fr;
                const float* br = (row < NPROMPT ? bp + (size_t)row * 1024 : bs + (size_t)(row - NPROMPT) * 1024) + col0;
#pragma unroll
                for (int bj = 0; bj < 2; ++bj) { res[m][bj][0] = *(const f32x4*)(br + bj * HALF); res[m][bj][1] = *(const f32x4*)(br + bj * HALF + 4); } }
            asm volatile("" ::: "memory");
#pragma unroll
            for (int m = 0; m < 4; ++m) { const int row = u.pm * BM + ai * HALF + wr * 64 + m * 16 + fr;
                float* xr = X + (size_t)row * 1024 + col0; bf16_t* xb = XB + (size_t)row * 1024 + col0; float ss = 0.f;
#pragma unroll
                for (int bj = 0; bj < 2; ++bj) { const f32x4 v0 = acc[ai][bj][m][0] + res[m][bj][0], v1 = acc[ai][bj][m][1] + res[m][bj][1];
                    *(f32x4*)(xr + bj * HALF) = v0; *(f32x4*)(xr + bj * HALF + 4) = v1;
                    ss += ((v0[0] * v0[0] + v0[1] * v0[1]) + (v0[2] * v0[2] + v0[3] * v0[3])) + ((v1[0] * v1[0] + v1[1] * v1[1]) + (v1[2] * v1[2] + v1[3] * v1[3]));
                    u32x4 w; w.x = cvt_pk_bf16(v0[0], v0[1]); w.y = cvt_pk_bf16(v0[2], v0[3]); w.z = cvt_pk_bf16(v1[0], v1[1]); w.w = cvt_pk_bf16(v1[2], v1[3]); *(u32x4*)(xb + bj * HALF) = w; }
                ss += __shfl_xor(ss, 16); ss += __shfl_xor(ss, 32);
                if (fq == 0) ssq[(size_t)row * 16 + u.pn * 4 + wc] = ss; }
            asm volatile("" ::: "memory"); }
    }
};
struct EpiBf16S {
    static constexpr bool PERM = true, AFTER_DRAIN = false;
    bf16_t* O; int ldc; const float* rstd; float scale; int act;
    __device__ __forceinline__ void operator()(const f32x4 (&acc)[2][2][4][2], const Unit& u, int wr, int wc, int fr_, int fq_) const {
        int tq = threadIdx.x; asm volatile("" : "+v"(tq)); const int fr = tq & 15, fq = (tq >> 4) & 3;
        const int col0 = u.pn * BM + wc * 32 + 8 * fq, rowb = u.pm * BM + wr * 64 + fr;
        float rs[2][4];
#pragma unroll
        for (int ai = 0; ai < 2; ++ai)
#pragma unroll
            for (int m = 0; m < 4; ++m) rs[ai][m] = rstd[rowb + ai * HALF + m * 16];
#pragma unroll
        for (int ai = 0; ai < 2; ++ai)
#pragma unroll
            for (int m = 0; m < 4; ++m) { const int row = rowb + ai * HALF + m * 16; const float r1 = rs[ai][m];
                bf16_t* rowp = O + (size_t)row * ldc + col0;
#pragma unroll
                for (int bj = 0; bj < 2; ++bj) { f32x4 v0 = acc[ai][bj][m][0] * r1, v1 = acc[ai][bj][m][1] * r1;
                    if (act == 1) { v0 = __builtin_elementwise_max(v0, (f32x4){0.f, 0.f, 0.f, 0.f}); v1 = __builtin_elementwise_max(v1, (f32x4){0.f, 0.f, 0.f, 0.f}); v0 = v0 * v0; v1 = v1 * v1; }
                    v0 = v0 * scale; v1 = v1 * scale;
                    u32x4 w; w.x = cvt_pk_bf16(v0[0], v0[1]); w.y = cvt_pk_bf16(v0[2], v0[3]); w.z = cvt_pk_bf16(v1[0], v1[1]); w.w = cvt_pk_bf16(v1[2], v1[3]);
                    *(u32x4*)(rowp + bj * HALF) = w; } }
    }
};
struct EpiPart {
    static constexpr bool PERM = true, AFTER_DRAIN = false;
    float* part;
    __device__ __forceinline__ void operator()(const f32x4 (&acc)[2][2][4][2], const Unit& u, int wr, int wc, int fr_, int fq_) const {
        int tq = threadIdx.x; asm volatile("" : "+v"(tq)); const int fr = tq & 15, fq = (tq >> 4) & 3;
        const int col0 = u.pn * BM + wc * 32 + 8 * fq;
#pragma unroll
        for (int ai = 0; ai < 2; ++ai)
#pragma unroll
            for (int m = 0; m < 4; ++m) { const int row = (u.pm - 64) * BM + ai * HALF + wr * 64 + m * 16 + fr;
                float* rp = part + ((size_t)u.ks * 512 + row) * 1024 + col0;
#pragma unroll
                for (int bj = 0; bj < 2; ++bj)
#pragma unroll
                    for (int n = 0; n < 2; ++n) *(f32x4*)(rp + bj * HALF + n * 4) = acc[ai][bj][m][n];
                asm volatile("" ::: "memory"); }
    }
};
template <class Epi, class Sched, bool ALIGN_EPI = false, bool SP2 = false>
__device__ __forceinline__ void gemm_phase(PG8_LAS unsigned char* lds, const Gemm g, const Sched& S, const Epi& E) {
    int tid_ = threadIdx.x; asm volatile("" : "+v"(tid_));
    const int tid = tid_, wid = __builtin_amdgcn_readfirstlane(tid >> 6), lane = tid & 63, wr = wid >> 2, wc = wid & 3, fr = lane & 15, fq = lane >> 4;
    const int K = g.ld ? g.ld : g.K, nt = g.K / BK;
    unsigned voffA[2], voffB[2];
#pragma unroll
    for (int i = 0; i < 2; ++i) { int R, C; stage_rc(tid * 16 + i * 8192, R, C); const int Rb = Epi::PERM ? ((R & ~31) + perm32(R & 31)) : R;
        voffA[i] = (unsigned)(R * K + C) * 2u; voffB[i] = (unsigned)(Rb * K + C) * 2u; }
    const size_t kstep = (size_t)(BK * 2);
    const size_t hstep = (size_t)HALF * K * 2;
    const size_t tstep = 2 * hstep;
    const unsigned ldsw = (unsigned)wid * 1024u;
    const int aoff = lds_byte(wr * 64 + fr, fq * 8), boff = lds_byte(wc * 32 + fr, fq * 8);
#define PG8_SA(b, h) (((b) * 2 + (h)) * HTB)
#define PG8_SB(b, h) ((4 + (b) * 2 + (h)) * HTB)
#define PG8_STAGE(bufoff, gbase, voff) do { _Pragma("unroll") for (int _i = 0; _i < 2; ++_i) \
        __builtin_amdgcn_global_load_lds((const unsigned*)((const char*)(gbase) + (voff)[_i]), (PG8_LAS unsigned*)(lds + (bufoff) + ldsw + _i * 8192), 16, 0, 0); } while (0)
#define PG8_LDA(dst, b, h) do { _Pragma("unroll") for (int m = 0; m < 4; ++m) _Pragma("unroll") for (int k = 0; k < 2; ++k) dst[m][k] = *(const PG8_LAS bf16x8*)(lds + PG8_SA(b, h) + aoff + m * 2048 + k * 1024); } while (0)
#define PG8_LDB(dst, b, h) do { _Pragma("unroll") for (int n = 0; n < 2; ++n) _Pragma("unroll") for (int k = 0; k < 2; ++k) dst[n][k] = *(const PG8_LAS bf16x8*)(lds + PG8_SB(b, h) + boff + n * 2048 + k * 1024); } while (0)
#define PG8_MMA(ai, bj, At, Bt) do { __builtin_amdgcn_s_setprio(1); _Pragma("unroll") for (int m = 0; m < 4; ++m) _Pragma("unroll") for (int n = 0; n < 2; ++n) _Pragma("unroll") for (int k = 0; k < 2; ++k) \
        acc[ai][bj][m][n] = __builtin_amdgcn_mfma_f32_16x16x32_bf16(Bt[n][k], At[m][k], acc[ai][bj][m][n], 0, 0, 0); __builtin_amdgcn_s_setprio(0); } while (0)
#define PG8_WAIT_V(n) asm volatile("s_waitcnt vmcnt(" #n ")" ::: "memory")
#define PG8_WAIT_L(n) asm volatile("s_waitcnt lgkmcnt(" #n ")" ::: "memory")
#define PG8_BAR __builtin_amdgcn_s_barrier()
#define PG8_SCHED __builtin_amdgcn_sched_barrier(0)
    Unit cur, nxt; int ui = 0;
    if (!S.next(0, cur)) return;
    f32x4 acc[2][2][4][2];
#pragma unroll
    for (int a = 0; a < 2; ++a)
#pragma unroll
        for (int b = 0; b < 2; ++b)
#pragma unroll
            for (int m = 0; m < 4; ++m)
#pragma unroll
                for (int n = 0; n < 2; ++n) acc[a][b][m][n] = (f32x4){0.f, 0.f, 0.f, 0.f};
    bf16x8 At[4][2], B0[2][2], B1[2][2];
    const size_t sstep = (size_t)g.K * 2;
    const char* cA = (const char*)g.A + (size_t)cur.pm * tstep + (size_t)cur.ks * sstep; const char* cB = (const char*)g.Bt + (size_t)cur.pn * tstep + (size_t)cur.ks * sstep;
    S.a_ready(cur);
    if constexpr (SP2) {
        PG8_STAGE(PG8_SB(0, 0), cB, voffB); PG8_STAGE(PG8_SB(0, 1), cB + hstep, voffB); PG8_STAGE(PG8_SA(0, 0), cA, voffA); PG8_STAGE(PG8_SA(0, 1), cA + hstep, voffA);
        if (wr == 1) PG8_BAR;
        PG8_WAIT_V(2); PG8_BAR;
        PG8_STAGE(PG8_SB(1, 0), cB + kstep, voffB); PG8_STAGE(PG8_SA(1, 0), cA + kstep, voffA); PG8_STAGE(PG8_SB(1, 1), cB + hstep + kstep, voffB);
        PG8_WAIT_V(6); PG8_BAR;
    } else {
        PG8_STAGE(PG8_SB(0, 0), cB, voffB); PG8_STAGE(PG8_SA(0, 0), cA, voffA); PG8_STAGE(PG8_SB(0, 1), cB + hstep, voffB); PG8_STAGE(PG8_SA(0, 1), cA + hstep, voffA);
        if (wr == 1) PG8_BAR;
        PG8_WAIT_V(4); PG8_BAR;
        PG8_STAGE(PG8_SB(1, 0), cB + kstep, voffB); PG8_STAGE(PG8_SA(1, 0), cA + kstep, voffA); PG8_STAGE(PG8_SB(1, 1), cB + hstep + kstep, voffB);
        PG8_WAIT_V(6); PG8_BAR;
    }
    for (;;) {
        const bool has_next = S.next(ui + 1, nxt);
        const char* nA = has_next ? (const char*)g.A + (size_t)nxt.pm * tstep + (size_t)nxt.ks * sstep : cA; const char* nB = has_next ? (const char*)g.Bt + (size_t)nxt.pn * tstep + (size_t)nxt.ks * sstep : cB;
        for (int t = 0; t < nt; t += 2) {
            const bool last = (t == nt - 2);
            const char* a1 = cA + (size_t)(t + 1) * kstep;
            const char* a2 = last ? nA : cA + (size_t)(t + 2) * kstep; const char* b2 = last ? nB : cB + (size_t)(t + 2) * kstep;
            const char* a3 = a2 + kstep; const char* b3 = b2 + kstep;
            if (last && has_next) S.a_ready(nxt);
            if constexpr (SP2) {
            PG8_LDB(B0, 0, 0); PG8_LDB(B1, 0, 1); PG8_SCHED; PG8_LDA(At, 0, 0); PG8_STAGE(PG8_SA(1, 1), a1 + hstep, voffA);
            PG8_WAIT_V(8); PG8_WAIT_L(0); PG8_BAR; PG8_MMA(0, 0, At, B0); PG8_MMA(0, 1, At, B1); PG8_BAR; PG8_SCHED;
            PG8_LDA(At, 0, 1); PG8_STAGE(PG8_SB(0, 0), b2, voffB); PG8_STAGE(PG8_SB(0, 1), b2 + hstep, voffB); PG8_STAGE(PG8_SA(0, 0), a2, voffA);
            PG8_WAIT_V(8); PG8_WAIT_L(0); PG8_BAR; PG8_MMA(1, 0, At, B0); PG8_MMA(1, 1, At, B1); PG8_BAR; PG8_SCHED;
            PG8_LDB(B0, 1, 0); PG8_LDB(B1, 1, 1); PG8_SCHED; PG8_LDA(At, 1, 0); PG8_STAGE(PG8_SA(0, 1), a2 + hstep, voffA);
            PG8_WAIT_V(8); PG8_WAIT_L(0); PG8_BAR; PG8_MMA(0, 0, At, B0); PG8_MMA(0, 1, At, B1); PG8_BAR; PG8_SCHED;
            PG8_LDA(At, 1, 1); PG8_STAGE(PG8_SB(1, 0), b3, voffB); PG8_STAGE(PG8_SB(1, 1), b3 + hstep, voffB); PG8_STAGE(PG8_SA(1, 0), a3, voffA);
            PG8_WAIT_V(8); PG8_WAIT_L(0); PG8_BAR; PG8_MMA(1, 0, At, B0); PG8_MMA(1, 1, At, B1); PG8_BAR; PG8_SCHED;
            } else {
            PG8_LDB(B0, 0, 0); PG8_SCHED; PG8_LDA(At, 0, 0); PG8_STAGE(PG8_SA(1, 1), a1 + hstep, voffA);
            PG8_WAIT_L(8); PG8_BAR; PG8_WAIT_L(0); PG8_MMA(0, 0, At, B0); PG8_BAR; PG8_SCHED;
            PG8_LDB(B1, 0, 1); PG8_STAGE(PG8_SB(0, 0), b2, voffB);
            PG8_BAR; PG8_WAIT_L(0); PG8_MMA(0, 1, At, B1); PG8_BAR;
            PG8_LDA(At, 0, 1); PG8_STAGE(PG8_SA(0, 0), a2, voffA);
            PG8_BAR; PG8_WAIT_L(0); PG8_MMA(1, 0, At, B0); PG8_BAR; PG8_SCHED;
            PG8_STAGE(PG8_SB(0, 1), b2 + hstep, voffB);
            PG8_WAIT_V(6); PG8_BAR; PG8_MMA(1, 1, At, B1); PG8_BAR;
            PG8_LDB(B0, 1, 0); PG8_SCHED; PG8_LDA(At, 1, 0); PG8_STAGE(PG8_SA(0, 1), a2 + hstep, voffA);
            PG8_WAIT_L(8); PG8_BAR; PG8_WAIT_L(0); PG8_MMA(0, 0, At, B0); PG8_BAR; PG8_SCHED;
            PG8_LDB(B1, 1, 1); PG8_STAGE(PG8_SB(1, 0), b3, voffB);
            PG8_BAR; PG8_WAIT_L(0); PG8_MMA(0, 1, At, B1); PG8_BAR;
            PG8_LDA(At, 1, 1); PG8_STAGE(PG8_SA(1, 0), a3, voffA);
            PG8_BAR; PG8_WAIT_L(0); PG8_MMA(1, 0, At, B0); PG8_BAR; PG8_SCHED;
            PG8_STAGE(PG8_SB(1, 1), b3 + hstep, voffB);
            PG8_WAIT_V(6); PG8_BAR; PG8_MMA(1, 1, At, B1); PG8_BAR;
            }
        }
        if constexpr (ALIGN_EPI) { if (wr == 0) PG8_BAR; }
        if constexpr (!Epi::AFTER_DRAIN) { E(acc, cur, wr, wc, fr, fq); S.done(cur); }
        if (!has_next) break;
#pragma unroll
        for (int a = 0; a < 2; ++a)
#pragma unroll
            for (int b = 0; b < 2; ++b)
#pragma unroll
                for (int m = 0; m < 4; ++m)
#pragma unroll
                    for (int n = 0; n < 2; ++n) acc[a][b][m][n] = (f32x4){0.f, 0.f, 0.f, 0.f};
        cur = nxt; cA = nA; cB = nB; ++ui;
        if constexpr (ALIGN_EPI) { if (wr == 1) PG8_BAR; }
    }
    PG8_WAIT_V(0);
    if constexpr (!ALIGN_EPI) { if (wr == 0) PG8_BAR; }
    PG8_BAR;
    if constexpr (Epi::AFTER_DRAIN) { E.fused(acc, cur, wr, wc, fr, fq, lds, wid, lane); S.done(cur); }
#undef PG8_SA
#undef PG8_SB
#undef PG8_STAGE
#undef PG8_LDA
#undef PG8_LDB
#undef PG8_MMA
#undef PG8_WAIT_V
#undef PG8_WAIT_L
#undef PG8_BAR
#undef PG8_SCHED
}
}
using namespace pg8;
#define LAS __attribute__((address_space(3)))
typedef LAS unsigned char* ldsp;
typedef float f32x16 __attribute__((ext_vector_type(16)));
#define LDS_WAIT() asm volatile("s_waitcnt lgkmcnt(0)" ::: "memory")

constexpr int M_ALL = 16896;
constexpr int PLD = 3584;
constexpr size_t MiB = 1u << 20;
constexpr size_t WS_W0 = 2 * MiB, WS_WL = 32 * MiB;
constexpr size_t W_IN = 0, W_OUT = 7 * MiB, W_MQ = 9 * MiB, W_MO = 10 * MiB, W_1 = 11 * MiB, W_2 = 19 * MiB;
constexpr size_t WS_WMKV = 66 * MiB;
constexpr size_t WS_XB = 80 * MiB, WS_X = 128 * MiB, WS_SSQ = 196 * MiB, WS_MEMB = 198 * MiB, WS_MEMSSQ = 199 * MiB, WS_RSTD = 199 * MiB + 65536, WS_MEMRSTD = 199 * MiB + 196608;
constexpr size_t WS_PROJ = 256 * MiB, WS_OSB = 512 * MiB, WS_MIX = 560 * MiB, WS_DS = 608 * MiB, WS_DD = 672 * MiB;
constexpr size_t WS_QM = 688 * MiB, WS_OM = 720 * MiB, WS_H = 768 * MiB, WS_PART = 904 * MiB, WS_VT = 940 * MiB, WS_KB = 960 * MiB;
constexpr int LDS_BYTES = 147456;
constexpr size_t WS_BAR = 65536;
constexpr size_t WS_CTR = 65536 + 16384;
constexpr int LDS_BARST = 131072 + 1024;

__device__ __forceinline__ float wave_sum(float v) {
#pragma unroll
    for (int o = 1; o < 64; o <<= 1) v += __shfl_xor(v, o);
    return v;
}
typedef float f32x2_t __attribute__((ext_vector_type(2))); typedef __bf16 bf16x2_t __attribute__((ext_vector_type(2)));
__device__ __forceinline__ unsigned pk2(float lo, float hi) { const f32x2_t v = {lo, hi}; const bf16x2_t b = __builtin_convertvector(v, bf16x2_t); return __builtin_bit_cast(unsigned, b); }
__device__ __forceinline__ unsigned f2bf(float f) { return pk2(f, f) & 0xffffu; }
__device__ __forceinline__ bf16x8 pack8(float a, float b, float c, float d, float e, float f, float g, float h) { return __builtin_bit_cast(bf16x8, (u32x4){pk2(a, b), pk2(c, d), pk2(e, f), pk2(g, h)}); }
__device__ __forceinline__ float fexp(float x) { return __builtin_amdgcn_exp2f(x * 1.4426950408889634f); }
__device__ __forceinline__ float flog(float x) { return __builtin_amdgcn_logf(x) * 0.6931471805599453f; }
__device__ __forceinline__ int crow(int i, int hi) { return (i & 3) + 8 * (i >> 2) + 4 * hi; }
#define MFMA32(a, b, c) __builtin_amdgcn_mfma_f32_32x32x16_bf16((a), (b), (c), 0, 0, 0)
#define MFMA16(a, b, c) __builtin_amdgcn_mfma_f32_16x16x32_bf16((a), (b), (c), 0, 0, 0)

__device__ __forceinline__ void transpose_item(const float* W, int K, int N, bf16_t* WT, int row_off, const float* gain, LAS float* scr, int item, int lane) {
    const int nblk = N / 32, kb = item / nblk, nb = item % nblk, k0 = 64 * kb, n0 = 32 * nb;
    float wv[32], gv[32];
#pragma unroll
    for (int i = 0; i < 32; ++i) { const int kk = 2 * i + (lane >> 5); wv[i] = W[(size_t)(k0 + kk) * N + n0 + (lane & 31)]; gv[i] = gain ? gain[k0 + kk] : 1.f; }
#pragma unroll
    for (int i = 0; i < 32; ++i) { const int kk = 2 * i + (lane >> 5); scr[kk * 33 + (lane & 31)] = wv[i] * gv[i]; }
    LDS_WAIT(); asm volatile("" ::: "memory");
    const int c = lane & 7;
#pragma unroll
    for (int j = 0; j < 4; ++j) { const int n = (lane >> 3) + 8 * j; const LAS float* s = scr + (8 * c) * 33 + n;
        u32x4 o; o.x = pk2(s[0 * 33], s[1 * 33]); o.y = pk2(s[2 * 33], s[3 * 33]); o.z = pk2(s[4 * 33], s[5 * 33]); o.w = pk2(s[6 * 33], s[7 * 33]);
        *(u32x4*)(WT + (size_t)(row_off + n0 + n) * K + k0 + 8 * c) = o; }
    LDS_WAIT(); asm volatile("" ::: "memory");
}
__device__ __forceinline__ void row_prep2(const float* srcA, bf16_t* dstA, float* sqA, float* rsA, const float* srcB, bf16_t* dstB, float* sqB, float* rsB, bool hasB, int lane) {
    const f32x4* xa = (const f32x4*)srcA + lane; const f32x4* xb = (const f32x4*)srcB + lane; f32x4 va[4], vb[4]; float sa = 0.f, sb = 0.f;
#pragma unroll
    for (int j = 0; j < 4; ++j) { va[j] = xa[64 * j]; vb[j] = xb[64 * j]; }
#pragma unroll
    for (int j = 0; j < 4; ++j) { sa += (va[j][0] * va[j][0] + va[j][1] * va[j][1]) + (va[j][2] * va[j][2] + va[j][3] * va[j][3]); sb += (vb[j][0] * vb[j][0] + vb[j][1] * vb[j][1]) + (vb[j][2] * vb[j][2] + vb[j][3] * vb[j][3]); }
    sa = wave_sum(sa); sb = wave_sum(sb);
    u32x2* oa = (u32x2*)dstA + lane; u32x2* ob = (u32x2*)dstB + lane;
#pragma unroll
    for (int j = 0; j < 4; ++j) { u32x2 w; w.x = pk2(va[j][0], va[j][1]); w.y = pk2(va[j][2], va[j][3]); oa[64 * j] = w;
        if (hasB) { u32x2 w2; w2.x = pk2(vb[j][0], vb[j][1]); w2.y = pk2(vb[j][2], vb[j][3]); ob[64 * j] = w2; } }
    if (lane < 16) { sqA[lane] = lane == 0 ? sa : 0.f; if (hasB) sqB[lane] = lane == 0 ? sb : 0.f; }
    if (lane == 0) { *rsA = rsqrtf(sa * (1.0f / 1024.0f) + 1e-6f); if (hasB) *rsB = rsqrtf(sb * (1.0f / 1024.0f) + 1e-6f); }
}
template <bool SAMPLE> __device__ __forceinline__ void sb_item(int item, int layer, const float* PROJ, const float* KP, const float* VP, const float* KS, const float* VS,
                                        const float* CK, const float* CV, const bf16_t* VT, const bf16_t* KB, float* OSB, int lane) {
    const int r32 = lane & 31, hi = lane >> 5;
    int qrow, qpos, ptop, split, h, qmin; bool qvalid; const float *kA, *vA, *kB, *vB;
    const bf16_t* VTh = VT; const bf16_t* KBh = KB;
    if (!SAMPLE) { const int b = item >> 11, rem = item & 2047, qt = rem & 255; h = rem >> 8; VTh = VT + ((size_t)(b * 8 + h) * 2048 * 64 + r32) * 4; KBh = KB + ((size_t)(b * 8 + h) * 256 * 8 * 32 + hi * 32 + r32) * 8;
        qrow = b * 8192 + qt * 32 + r32; qpos = qt * 32 + r32; qvalid = true; ptop = qt * 32; split = 1 << 30; qmin = qt * 32;
        kA = KP + (size_t)(b * 8192) * 512 + h * 64; vA = VP + (size_t)(b * 8192) * 512 + h * 64; kB = kA; vB = vA;
    } else { const int it = item - 4096, s = it >> 3; h = it & 7;
        qrow = NPROMPT + s * 16 + (r32 & 15); qpos = 2048 + (r32 & 15); qvalid = r32 < 16; ptop = 2032; split = 2048; qmin = 2048;
        kA = CK + (size_t)((layer * 32 + s) * 2048) * 512 + h * 64; vA = CV + (size_t)((layer * 32 + s) * 2048) * 512 + h * 64;
        kB = KS + ((long)(s * 16) - 2048) * 512 + h * 64; vB = VS + ((long)(s * 16) - 2048) * 512 + h * 64; }
    bf16x8 qh[4];
    { const float* qp = PROJ + (size_t)qrow * PLD + h * 64 + 8 * hi;
#pragma unroll
      for (int ds = 0; ds < 4; ++ds) { const f32x4 a = *(const f32x4*)(qp + 16 * ds) * 0.125f, b = *(const f32x4*)(qp + 16 * ds + 4) * 0.125f; qh[ds] = pack8(a[0], a[1], a[2], a[3], b[0], b[1], b[2], b[3]); } }
    f32x16 oacc[2];
#pragma unroll
    for (int i = 0; i < 16; ++i) { oacc[0][i] = 0.f; oacc[1][i] = 0.f; }
    float carry = 0.f;
    f32x4 kraw[8]; float vraw[2][2][8]; u32x2 vpk[2][2][2]; bf16x8 kq[4];
#define SB_LOAD_TILE(P0) do { if (SAMPLE) { const int pr_ = (P0) + r32, prc_ = pr_ < 0 ? 0 : pr_; const float* kp_ = (prc_ >= split ? kB : kA) + (long)prc_ * 512 + 8 * hi; \
        _Pragma("unroll") for (int ds = 0; ds < 4; ++ds) { kraw[2 * ds] = *(const f32x4*)(kp_ + 16 * ds); kraw[2 * ds + 1] = *(const f32x4*)(kp_ + 16 * ds + 4); } } \
        else { const int pq_ = (P0) < 0 ? 0 : (P0); _Pragma("unroll") for (int ds = 0; ds < 4; ++ds) kq[ds] = *(const bf16x8*)(KBh + ((size_t)(pq_ >> 5) * 8 + 2 * ds) * 32 * 8); } \
        if (SAMPLE) { _Pragma("unroll") for (int t = 0; t < 2; ++t) _Pragma("unroll") for (int j = 0; j < 8; ++j) { const int pk_ = (P0) + 16 * t + 8 * (j >> 2) + 4 * hi + (j & 3), pkc_ = pk_ < 0 ? 0 : pk_; \
            const float* vp_ = (pkc_ >= split ? vB : vA) + (long)pkc_ * 512 + r32; vraw[t][0][j] = vp_[0]; vraw[t][1][j] = vp_[32]; } } \
        else { const int pc_ = (P0) < 0 ? 0 : (P0); _Pragma("unroll") for (int t = 0; t < 2; ++t) _Pragma("unroll") for (int dt = 0; dt < 2; ++dt) { const bf16_t* vq_ = VTh + ((size_t)((pc_ >> 2) + 4 * t + hi) * 64 + dt * 32) * 4; \
            vpk[t][dt][0] = *(const u32x2*)vq_; vpk[t][dt][1] = *(const u32x2*)(vq_ + 2 * 64 * 4); } } } while (0)
    SB_LOAD_TILE(ptop);
    for (int p0 = ptop; p0 > -32; p0 -= 32) {
        bf16x8 kf[4], va[2][2];
#pragma unroll
        for (int ds = 0; ds < 4; ++ds) { if (SAMPLE) kf[ds] = pack8(kraw[2 * ds][0], kraw[2 * ds][1], kraw[2 * ds][2], kraw[2 * ds][3], kraw[2 * ds + 1][0], kraw[2 * ds + 1][1], kraw[2 * ds + 1][2], kraw[2 * ds + 1][3]); else kf[ds] = kq[ds]; }
#pragma unroll
        for (int t = 0; t < 2; ++t)
#pragma unroll
            for (int dt = 0; dt < 2; ++dt) { if (SAMPLE) va[t][dt] = pack8(vraw[t][dt][0], vraw[t][dt][1], vraw[t][dt][2], vraw[t][dt][3], vraw[t][dt][4], vraw[t][dt][5], vraw[t][dt][6], vraw[t][dt][7]);
                else va[t][dt] = __builtin_bit_cast(bf16x8, (u32x4){vpk[t][dt][0].x, vpk[t][dt][0].y, vpk[t][dt][1].x, vpk[t][dt][1].y}); }
        SB_LOAD_TILE(p0 - 32);
        asm volatile("" ::: "memory");
        f32x16 acc;
#pragma unroll
        for (int i = 0; i < 16; ++i) acc[i] = 0.f;
#pragma unroll
        for (int ds = 0; ds < 4; ++ds) acc = MFMA32(kf[ds], qh[ds], acc);
        float L[16], ls[16];
        if (p0 >= 0 && p0 + 32 <= qmin) {
#pragma unroll
            for (int i = 0; i < 16; ++i) { const float z = acc[i]; const float sp = fmaxf(z, 0.f) + flog(1.f + fexp(-fabsf(z))); L[i] = -sp; ls[i] = z - sp; }
        } else {
#pragma unroll
            for (int i = 0; i < 16; ++i) { const int kpos = p0 + crow(i, hi); const bool valid = (kpos < qpos) && (kpos >= 0); const float z = acc[i];
                const float sp = fmaxf(z, 0.f) + flog(1.f + fexp(-fabsf(z)));
                L[i] = valid ? -sp : 0.f; ls[i] = valid ? (z - sp) : -1e30f; }
        }
        float G[4], PG[4], T[4];
#pragma unroll
        for (int g = 0; g < 4; ++g) { G[g] = (L[4 * g] + L[4 * g + 1]) + (L[4 * g + 2] + L[4 * g + 3]); PG[g] = __shfl_xor(G[g], 32); T[g] = G[g] + PG[g]; }
        float A[4]; A[3] = 0.f; A[2] = T[3]; A[1] = T[3] + T[2]; A[0] = A[1] + T[1];
        float P[16];
#pragma unroll
        for (int g = 0; g < 4; ++g) { const float e3 = carry + A[g] + (hi == 0 ? PG[g] : 0.f), e2 = e3 + L[4 * g + 3], e1 = e2 + L[4 * g + 2], e0 = e1 + L[4 * g + 1];
            P[4 * g + 3] = fexp(ls[4 * g + 3] + e3); P[4 * g + 2] = fexp(ls[4 * g + 2] + e2); P[4 * g + 1] = fexp(ls[4 * g + 1] + e1); P[4 * g] = fexp(ls[4 * g] + e0); }
        carry += (T[0] + T[1]) + (T[2] + T[3]);
#pragma unroll
        for (int t = 0; t < 2; ++t) { const bf16x8 pb = pack8(P[8 * t], P[8 * t + 1], P[8 * t + 2], P[8 * t + 3], P[8 * t + 4], P[8 * t + 5], P[8 * t + 6], P[8 * t + 7]);
            oacc[0] = MFMA32(va[t][0], pb, oacc[0]); oacc[1] = MFMA32(va[t][1], pb, oacc[1]); }
        if (__all(carry < -110.0f)) break;
    }
    if (qvalid) { float* op = OSB + (size_t)qrow * 512 + h * 64 + 4 * hi;
#pragma unroll
        for (int dt = 0; dt < 2; ++dt)
#pragma unroll
            for (int g = 0; g < 4; ++g) *(f32x4*)(op + dt * 32 + 8 * g) = (f32x4){oacc[dt][4 * g], oacc[dt][4 * g + 1], oacc[dt][4 * g + 2], oacc[dt][4 * g + 3]}; }
}

__device__ __forceinline__ void hg_load(const float* PROJ, int row0, int tvalid, int h, int tg, int k, int coff, float (&zr)[16]) {
#pragma unroll
    for (int j = 0; j < 16; ++j) { const int t = 16 * tg + j, tc = t < tvalid ? t : 0; zr[j] = PROJ[(size_t)(row0 + tc) * PLD + coff + h * 128 + k]; }
}
__device__ __forceinline__ void hg_prep(const float (&zr)[16], const float (&qr)[16], int tvalid, float lbv, int tg, float (&loc)[16], float (&kk)[16], float (&qv)[16]) {
    float run = 0.f;
#pragma unroll
    for (int j = 0; j < 16; ++j) { const int t = 16 * tg + j; const bool ok = t < tvalid; const float z = ok ? zr[j] : 0.f, q = ok ? qr[j] : 0.f;
        const float ez = fexp(-fabsf(z)), inv = __builtin_amdgcn_rcpf(1.f + ez);
        const float sig = z >= 0.f ? inv : ez * inv, nsig = z >= 0.f ? ez * inv : inv;
        float lf = (lbv > 0.f) ? flog(lbv + (1.f - lbv) * sig) : (fminf(z, 0.f) - flog(1.f + ez));
        if (!ok) lf = 0.f;
        run += lf; loc[j] = run; kk[j] = ok ? (1.f - lbv) * nsig : 0.f; qv[j] = q * 0.08838834764831845f; }
}
__device__ __forceinline__ void hg_h1(ldsp lds, const float* PROJ, const float (&zr)[16], int row0, int tvalid, int h, float lbv, float* dsOut, float* ddOut, const float* s0, int tid, int lane, int wave) {
    const int tg = tid >> 7, k = tid & 127;
    float loc[16], kk[16], qv[16], iv[16];
#pragma unroll
    for (int j = 0; j < 16; ++j) { const int ta = 16 * tg + j, tc = ta < tvalid ? ta : 0; const float x = PROJ[(size_t)(row0 + tc) * PLD + 2560 + h * 128 + k]; iv[j] = ta < tvalid ? x : 0.f; }
    hg_prep(zr, zr, tvalid, lbv, tg, loc, kk, qv);
    LAS float* TOT = (LAS float*)lds; LAS float* DK = (LAS float*)(lds + 2048);
    TOT[tg * 128 + k] = loc[15];
    __syncthreads();
    const float t0 = TOT[k], t1 = TOT[128 + k], t2 = TOT[256 + k], t3 = TOT[384 + k];
    const float r1 = t0, r2 = r1 + t1, r3 = r2 + t2, r4 = r3 + t3;
    const float rtg = tg == 0 ? 0.f : (tg == 1 ? r1 : (tg == 2 ? r2 : r3));
    { unsigned w[8];
#pragma unroll
      for (int jj = 0; jj < 8; ++jj) w[jj] = pk2(kk[2 * jj] * fexp(r4 - rtg - loc[2 * jj]), kk[2 * jj + 1] * fexp(r4 - rtg - loc[2 * jj + 1]));
      *(LAS u32x4*)(lds + 4096 + k * 144 + tg * 32) = (u32x4){w[0], w[1], w[2], w[3]}; *(LAS u32x4*)(lds + 4096 + k * 144 + tg * 32 + 16) = (u32x4){w[4], w[5], w[6], w[7]};
#pragma unroll
      for (int jj = 0; jj < 8; ++jj) w[jj] = pk2(iv[2 * jj], iv[2 * jj + 1]);
      *(LAS u32x4*)(lds + 22528 + k * 144 + tg * 32) = (u32x4){w[0], w[1], w[2], w[3]}; *(LAS u32x4*)(lds + 22528 + k * 144 + tg * 32 + 16) = (u32x4){w[4], w[5], w[6], w[7]}; }
    if (tg == 0) { const float dk = fexp(r4); DK[k] = dk; if (ddOut) ddOut[k] = dk; }
    __syncthreads();
    const int r32 = lane & 31, hi = lane >> 5, km = wave & 3, vn0 = (wave >> 2) * 2;
#pragma unroll
    for (int vv = 0; vv < 2; ++vv) { f32x16 acc;
#pragma unroll
        for (int i = 0; i < 16; ++i) acc[i] = 0.f;
#pragma unroll
        for (int ks = 0; ks < 4; ++ks) { const bf16x8 a = *(LAS bf16x8*)(lds + 4096 + (32 * km + r32) * 144 + ks * 32 + hi * 16);
            const bf16x8 b = *(LAS bf16x8*)(lds + 22528 + (32 * (vn0 + vv) + r32) * 144 + ks * 32 + hi * 16); acc = MFMA32(a, b, acc); }
        const int v = 32 * (vn0 + vv) + r32;
#pragma unroll
        for (int i = 0; i < 16; ++i) { if (s0) { const int kr = 32 * km + crow(i, hi); dsOut[kr * 128 + v] = acc[i] + DK[kr] * s0[kr * 128 + v]; } }
        if (!s0) { bf16_t* db = (bf16_t*)dsOut + v * 128 + 32 * km + 4 * hi;
#pragma unroll
            for (int g = 0; g < 4; ++g) *(u32x2*)(db + 8 * g) = (u32x2){pk2(acc[4 * g], acc[4 * g + 1]), pk2(acc[4 * g + 2], acc[4 * g + 3])}; } }
    __syncthreads();
}
__device__ __forceinline__ void hg_h3(ldsp lds, const float* PROJ, const float (&zr)[16], int row0, int tvalid, int h, float lbv, const float* Ssrc, bool sbf, const float* hgain, bf16_t* MIX, int tid, int lane, int wave) {
    constexpr int QE = 2048, KE = 19456, ST = 62976, IV = 97792, PM = 116224, OST = 19456;
    const int tg = tid >> 7, k = tid & 127;
    float loc[16], kk[16], qv[16];
    f32x4 gv[4], gav[4];
    float qr[16]; hg_load(PROJ, row0, tvalid, h, tg, k, 1536, qr);
    hg_prep(zr, qr, tvalid, lbv, tg, loc, kk, qv);
    LAS float* TOT = (LAS float*)lds;
    TOT[tg * 128 + k] = loc[15];
    for (int i = tid; i < 2304; i += 512) ((LAS unsigned*)(lds + PM))[i] = 0u;
    if (sbf) {
#pragma unroll
        for (int jj = 0; jj < 4; ++jj) { const int cidx = tid + 512 * jj, v = cidx >> 4, kc = cidx & 15;
            *(LAS u32x4*)(lds + ST + v * 272 + kc * 16) = *(const u32x4*)((const bf16_t*)Ssrc + v * 128 + kc * 8); }
    } else {
#pragma unroll
        for (int jj = 0; jj < 16; ++jj) { const int kp = 2 * ((tid >> 7) + 4 * jj), v = tid & 127;
            *(LAS unsigned*)(lds + ST + v * 272 + kp * 2) = pk2(Ssrc[kp * 128 + v], Ssrc[(kp + 1) * 128 + v]); } }
    { unsigned w[8];
#pragma unroll
      for (int jj = 0; jj < 8; ++jj) { const int ta = 16 * tg + 2 * jj, t0 = ta < tvalid ? ta : 0, t1 = (ta + 1) < tvalid ? ta + 1 : 0;
          const float x0 = PROJ[(size_t)(row0 + t0) * PLD + 2560 + h * 128 + k], x1 = PROJ[(size_t)(row0 + t1) * PLD + 2560 + h * 128 + k];
          w[jj] = pk2(ta < tvalid ? x0 : 0.f, (ta + 1) < tvalid ? x1 : 0.f); }
      *(LAS u32x4*)(lds + IV + k * 144 + tg * 32) = (u32x4){w[0], w[1], w[2], w[3]}; *(LAS u32x4*)(lds + IV + k * 144 + tg * 32 + 16) = (u32x4){w[4], w[5], w[6], w[7]}; }
    __syncthreads();
    { const int t = tid >> 3, v0 = (tid & 7) * 16; const int tc = t < tvalid ? t : 0; const float* gp = PROJ + (size_t)(row0 + tc) * PLD + 3072 + h * 128 + v0; const float* hg = hgain + h * 128 + v0;
#pragma unroll
      for (int c = 0; c < 4; ++c) { gv[c] = *(const f32x4*)(gp + 4 * c); gav[c] = *(const f32x4*)(hg + 4 * c); } }
    const float t0 = TOT[k], t1 = TOT[128 + k], t2 = TOT[256 + k];
    const float r1 = t0, r2 = r1 + t1, r3 = r2 + t2;
    const float rtg = tg == 0 ? 0.f : (tg == 1 ? r1 : (tg == 2 ? r2 : r3));
#pragma unroll
    for (int j = 0; j < 16; ++j) *(LAS unsigned short*)(lds + QE + (16 * tg + j) * 272 + k * 2) = (unsigned short)f2bf(qv[j] * fexp(loc[j]));
#pragma unroll
    for (int i = 0; i < 4; ++i) { if (i >= tg) { const float ri = i == 0 ? 0.f : (i == 1 ? r1 : (i == 2 ? r2 : r3)); const int rb = 8 * i * (i + 1);
#pragma unroll
        for (int j = 0; j < 16; ++j) *(LAS unsigned short*)(lds + KE + (rb + 16 * tg + j) * 272 + k * 2) = (unsigned short)f2bf(kk[j] * fexp(fminf(ri - rtg - loc[j], 80.f))); } }
    __syncthreads();
    { const int c16 = lane & 15, q4 = lane >> 4;
      for (int tix = wave; tix < 10; tix += 8) { const int i = tix < 1 ? 0 : (tix < 3 ? 1 : (tix < 6 ? 2 : 3)), j = tix - i * (i + 1) / 2, rb = 8 * i * (i + 1);
          f32x4 acc = {0.f, 0.f, 0.f, 0.f};
#pragma unroll
          for (int ks = 0; ks < 4; ++ks) { const bf16x8 a = *(LAS bf16x8*)(lds + QE + (16 * i + c16) * 272 + ks * 64 + q4 * 16);
              const bf16x8 b = *(LAS bf16x8*)(lds + KE + (rb + 16 * j + c16) * 272 + ks * 64 + q4 * 16); acc = MFMA16(a, b, acc); }
#pragma unroll
          for (int ii = 0; ii < 4; ++ii) { const int tl = 4 * q4 + ii; float pv = acc[ii]; if (i == j && c16 > tl) pv = 0.f;
              *(LAS unsigned short*)(lds + PM + (16 * i + tl) * 144 + (16 * j + c16) * 2) = (unsigned short)f2bf(pv); } } }
    __syncthreads();
#pragma unroll
    for (int j = 0; j < 16; ++j) *(LAS unsigned short*)(lds + QE + (16 * tg + j) * 272 + k * 2) = (unsigned short)f2bf(qv[j] * fexp(rtg + loc[j]));
    __syncthreads();
    { const int r32 = lane & 31, hi = lane >> 5, tm = wave & 1, vn = wave >> 1; f32x16 acc;
#pragma unroll
      for (int i = 0; i < 16; ++i) acc[i] = 0.f;
#pragma unroll
      for (int ks = 0; ks < 8; ++ks) { const bf16x8 a = *(LAS bf16x8*)(lds + QE + (32 * tm + r32) * 272 + ks * 32 + hi * 16);
          const bf16x8 b = *(LAS bf16x8*)(lds + ST + (32 * vn + r32) * 272 + ks * 32 + hi * 16); acc = MFMA32(a, b, acc); }
#pragma unroll
      for (int ks = 0; ks < 4; ++ks) { const bf16x8 a = *(LAS bf16x8*)(lds + PM + (32 * tm + r32) * 144 + ks * 32 + hi * 16);
          const bf16x8 b = *(LAS bf16x8*)(lds + IV + (32 * vn + r32) * 144 + ks * 32 + hi * 16); acc = MFMA32(a, b, acc); }
#pragma unroll
      for (int i = 0; i < 16; ++i) *(LAS float*)(lds + OST + (32 * tm + crow(i, hi)) * 528 + (32 * vn + r32) * 4) = acc[i]; }
    __syncthreads();
    { const int t = tid >> 3, v0 = (tid & 7) * 16; f32x4 o[4]; float ss = 0.f;
#pragma unroll
      for (int c = 0; c < 4; ++c) { o[c] = *(LAS f32x4*)(lds + OST + t * 528 + (v0 + 4 * c) * 4); ss += (o[c][0] * o[c][0] + o[c][1] * o[c][1]) + (o[c][2] * o[c][2] + o[c][3] * o[c][3]); }
      ss += __shfl_xor(ss, 1); ss += __shfl_xor(ss, 2); ss += __shfl_xor(ss, 4);
      const float rs = rsqrtf(ss * (1.0f / 128.0f) + 1e-6f);
      if (t < tvalid) { const size_t row = (size_t)(row0 + t); unsigned w[8];
#pragma unroll
          for (int c = 0; c < 4; ++c) { const f32x4 g = gv[c], ga = gav[c]; f32x4 r;
#pragma unroll
              for (int e = 0; e < 4; ++e) r[e] = o[c][e] * rs * ga[e] * (g[e] * __builtin_amdgcn_rcpf(1.f + fexp(-g[e])));
              w[2 * c] = pk2(r[0], r[1]); w[2 * c + 1] = pk2(r[2], r[3]); }
          bf16_t* mp = MIX + row * 1024 + 512 + h * 128 + v0;
          *(u32x4*)mp = (u32x4){w[0], w[1], w[2], w[3]}; *(u32x4*)(mp + 8) = (u32x4){w[4], w[5], w[6], w[7]}; } }
    __syncthreads();
}

__device__ __forceinline__ void xattn_item(ldsp lds, const bf16_t* QM, const float* Kg, const float* Vg, int row0, int tvalid, int hm, bf16_t* OM, int tid, int lane, int wave) {
    constexpr int KM = 0, QS = 69632, PMX = 87040, RMO = 120832, RSO = 121344, VT = 0;
#pragma unroll
    for (int jj = 0; jj < 8; ++jj) { const int cidx = tid + 512 * jj, m = cidx >> 4, dc = cidx & 15; const float* p = Kg + (size_t)m * 512 + dc * 8;
        const f32x4 a = *(const f32x4*)p, b = *(const f32x4*)(p + 4);
        *(LAS u32x4*)(lds + KM + m * 272 + dc * 16) = (u32x4){pk2(a[0], a[1]), pk2(a[2], a[3]), pk2(b[0], b[1]), pk2(b[2], b[3])}; }
#pragma unroll
    for (int jj = 0; jj < 2; ++jj) { const int cidx = tid + 512 * jj, t = cidx >> 4, dc = cidx & 15; u32x4 w = {0u, 0u, 0u, 0u};
        if (t < tvalid) w = *(const u32x4*)(QM + (size_t)(row0 + t) * 512 + hm * 128 + dc * 8);
        *(LAS u32x4*)(lds + QS + t * 272 + dc * 16) = w; }
    float vr0[32], vr1[32];
#pragma unroll
    for (int jj = 0; jj < 32; ++jj) { const int idx = tid + 512 * jj, d = idx & 127, mp = idx >> 7; vr0[jj] = Vg[(size_t)(2 * mp) * 512 + d]; vr1[jj] = Vg[(size_t)(2 * mp + 1) * 512 + d]; }
    __syncthreads();
    const int tgp = wave & 3, mh = wave >> 2, c16 = lane & 15, q4 = lane >> 4, tok = 16 * tgp + c16;
    LAS float* RM = (LAS float*)(lds + RMO); LAS float* RS = (LAS float*)(lds + RSO);
    f32x4 sacc[8];
    { bf16x8 bq[4];
#pragma unroll
      for (int ks = 0; ks < 4; ++ks) bq[ks] = *(LAS bf16x8*)(lds + QS + tok * 272 + ks * 64 + q4 * 16);
#pragma unroll
      for (int j = 0; j < 8; ++j) { f32x4 acc = {0.f, 0.f, 0.f, 0.f};
#pragma unroll
          for (int ks = 0; ks < 4; ++ks) { const bf16x8 a = *(LAS bf16x8*)(lds + KM + (128 * mh + 16 * j + c16) * 272 + ks * 64 + q4 * 16); acc = MFMA16(a, bq[ks], acc); }
          sacc[j] = acc; } }
    float mx = -3.0e38f;
#pragma unroll
    for (int j = 0; j < 8; ++j) mx = fmaxf(fmaxf(mx, fmaxf(sacc[j][0], sacc[j][1])), fmaxf(sacc[j][2], sacc[j][3]));
    mx = fmaxf(mx, __shfl_xor(mx, 16)); mx = fmaxf(mx, __shfl_xor(mx, 32));
    if (q4 == 0) RM[mh * 64 + tok] = mx;
    __syncthreads();
    { const float m = fmaxf(RM[tok], RM[64 + tok]); float sum = 0.f;
#pragma unroll
      for (int j = 0; j < 8; ++j) { const float p0 = fexp(sacc[j][0] - m), p1 = fexp(sacc[j][1] - m), p2 = fexp(sacc[j][2] - m), p3 = fexp(sacc[j][3] - m);
          sum += (p0 + p1) + (p2 + p3);
          *(LAS u32x2*)(lds + PMX + tok * 528 + (128 * mh + 16 * j + 4 * q4) * 2) = (u32x2){pk2(p0, p1), pk2(p2, p3)}; }
      sum += __shfl_xor(sum, 16); sum += __shfl_xor(sum, 32);
      if (q4 == 0) RS[mh * 64 + tok] = sum; }
    __syncthreads();
#pragma unroll
    for (int jj = 0; jj < 32; ++jj) { const int idx = tid + 512 * jj, d = idx & 127, mp = idx >> 7;
        *(LAS unsigned*)(lds + VT + d * 528 + mp * 4) = pk2(vr0[jj], vr1[jj]); }
    __syncthreads();
    { const int r32 = lane & 31, hi = lane >> 5, tm = wave & 1, dn = wave >> 1; f32x16 acc;
#pragma unroll
      for (int i = 0; i < 16; ++i) acc[i] = 0.f;
#pragma unroll
      for (int ks = 0; ks < 16; ++ks) { const bf16x8 a = *(LAS bf16x8*)(lds + PMX + (32 * tm + r32) * 528 + ks * 32 + hi * 16);
          const bf16x8 b = *(LAS bf16x8*)(lds + VT + (32 * dn + r32) * 528 + ks * 32 + hi * 16); acc = MFMA32(a, b, acc); }
#pragma unroll
      for (int i = 0; i < 16; ++i) { const int tk = 32 * tm + crow(i, hi); const float inv = __builtin_amdgcn_rcpf(RS[tk] + RS[64 + tk]);
          if (tk < tvalid) OM[(size_t)(row0 + tk) * 512 + hm * 128 + 32 * dn + r32] = (bf16_t)f2bf(acc[i] * inv); } }
    __syncthreads();
}
#define XB_TMO      128
#define XB_XCNT(j)  (256  + 64 * (j))
#define XB_XSUB(j)  (1280 + 64 * (j))
#define XB_XGEN(j)  (2304 + 64 * (j))
#define XB_TOP      3328
#define XB_TOPGEN   3392
#define XCD_BAR_WORDS 3456
#define XB_SPIN_CAP (1u << 18)

__device__ __forceinline__ unsigned xb_ld(unsigned* p)              { return __hip_atomic_load(p, __ATOMIC_RELAXED, __HIP_MEMORY_SCOPE_AGENT); }
__device__ __forceinline__ unsigned xb_add(unsigned* p, unsigned v) { return __hip_atomic_fetch_add(p, v, __ATOMIC_RELAXED, __HIP_MEMORY_SCOPE_AGENT); }
__device__ __forceinline__ unsigned xb_xcc_id() { return (unsigned)__builtin_amdgcn_s_getreg((3 << 11) | 20) & 0xFu; }
#define XB_SPIN(cond, bar) do { unsigned _sp = 0; while (cond) { __builtin_amdgcn_s_sleep(1); \
    if ((++_sp & 255u) == 0u) { if (xb_ld(&(bar)[XB_TMO])) break; if (_sp > XB_SPIN_CAP) { atomicAdd(&(bar)[XB_TMO], 1u); break; } } } } while (0)

struct XcdBarrier {
    unsigned* bar; unsigned x;
    volatile LAS unsigned* st;
};

__device__ __forceinline__ XcdBarrier xcd_barrier_post(unsigned* bar, volatile LAS unsigned* st) {
    XcdBarrier b; b.bar = bar; b.x = xb_xcc_id(); b.st = st;
    if (threadIdx.x == 0) (void)xb_add(&bar[XB_XCNT(b.x)], 1u);
    return b;
}
__device__ __forceinline__ void xcd_barrier_complete(unsigned* bar, unsigned x, unsigned& nloc, unsigned& nx) {
    const unsigned G = gridDim.x * gridDim.y * gridDim.z;
    unsigned sum, cnt, mine, sp = 0u;
    for (;;) {
        sum = 0u; cnt = 0u; mine = 0u;
#pragma unroll
        for (unsigned j = 0; j < 16; ++j) { const unsigned c = xb_ld(&bar[XB_XCNT(j)]); sum += c; cnt += (c > 0u) ? 1u : 0u; mine = (j == x) ? c : mine; }
        if (sum == G) break;
        __builtin_amdgcn_s_sleep(1);
        if ((++sp & 255u) == 0u) { if (xb_ld(&bar[XB_TMO])) break; if (sp > XB_SPIN_CAP) { atomicAdd(&bar[XB_TMO], 1u); break; } }
    }
    nloc = mine > 0u ? mine : 1u; nx = cnt > 0u ? cnt : 1u;
}

__device__ __forceinline__ void xcd_barrier(const XcdBarrier& b) {
    asm volatile("s_waitcnt vmcnt(0)" ::: "memory");
    __syncthreads();
    if (threadIdx.x == 0) {
        unsigned* bar = b.bar;
        __builtin_amdgcn_s_waitcnt(0);
        unsigned nloc = b.st[0], nx = b.st[1];
        if (nloc == 0u) { xcd_barrier_complete(bar, b.x, nloc, nx); b.st[0] = nloc; b.st[1] = nx; }
        const unsigned old = xb_add(&bar[XB_XSUB(b.x)], 1u);
        const unsigned gen = old / nloc;
        if (old + 1u == (gen + 1u) * nloc) {
            __builtin_amdgcn_fence(__ATOMIC_RELEASE, "agent");
            asm volatile("s_waitcnt vmcnt(0)" ::: "memory");
            const unsigned og = xb_add(&bar[XB_TOP], 1u);
            const unsigned tg = og / nx;
            if (og + 1u == (tg + 1u) * nx) xb_add(&bar[XB_TOPGEN], 1u);
            else XB_SPIN(xb_ld(&bar[XB_TOPGEN]) == tg, bar);
            __builtin_amdgcn_fence(__ATOMIC_ACQUIRE, "agent");
            xb_add(&bar[XB_XGEN(b.x)], 1u);
            asm volatile("s_waitcnt vmcnt(0)" ::: "memory");
        } else {
            XB_SPIN(xb_ld(&bar[XB_XGEN(b.x)]) == gen, bar);
            __builtin_amdgcn_fence(__ATOMIC_ACQUIRE, "agent");
            asm volatile("s_waitcnt vmcnt(0)" ::: "memory");
        }
    }
    __syncthreads();
}

__device__ __forceinline__ const float* gptr_(unsigned long long v) { return (const float*)(const __attribute__((address_space(1))) float*)v; }
#define GPTR(p) gptr_(p)
#define FPTR(p) ((const float*)(p))
#define OPQ(x) asm volatile("" : "+s"(x))
#define OPQP(T, x) do { unsigned long long xi_ = (unsigned long long)(x); asm volatile("" : "+s"(xi_)); x = (T*)(__attribute__((address_space(1))) T*)xi_; } while (0)
struct Args { const float* in[24]; float* out; unsigned char* ws; };
__global__ void __launch_bounds__(512, 2) mega_fwd(Args args) {
    extern __shared__ __attribute__((aligned(16))) unsigned char lds_raw[];
    cg::grid_group grid = cg::this_grid();
    ldsp lds = (ldsp)lds_raw;
    unsigned char* const ws = args.ws; float* const out = args.out;
#define WAVE_IDS int tid = threadIdx.x; asm volatile("" : "+v"(tid)); const int lane = tid & 63, wave = __builtin_amdgcn_readfirstlane(tid >> 6), G = gridDim.x, bid = blockIdx.x, gw = bid * 8 + wave, NGW = G * 8; (void)lane; (void)gw; (void)NGW

    {
        WAVE_IDS;
        if (bid == 0) for (int i = tid; i < XCD_BAR_WORDS; i += 512) ((unsigned*)(ws + WS_BAR))[i] = 0u;
        if (bid == 0 && tid < 8) ((unsigned*)(ws + WS_CTR))[tid] = 0u;
        if (tid < 2) ((LAS unsigned*)(lds + LDS_BARST))[tid] = 0u;
        if (bid == 0 && tid == 0) { const float** tab = (const float**)ws;
#pragma unroll
            for (int i = 0; i < 24; ++i) tab[i] = args.in[i]; }
        bf16_t* XB = (bf16_t*)(ws + WS_XB); float* SSQ = (float*)(ws + WS_SSQ); bf16_t* MEMB = (bf16_t*)(ws + WS_MEMB); float* MEMSSQ = (float*)(ws + WS_MEMSSQ); bf16_t* WMKV = (bf16_t*)(ws + WS_WMKV);
        LAS float* scr = (LAS float*)(lds + wave * 16384);
#define CONV_ITEM(PTR, L_, R_, WSB) do { const int l = (L_); int r = (R_); unsigned char* wl = (WSB) + WS_W0 + (size_t)l * WS_WL; bf16_t* wmkv = (bf16_t*)((WSB) + WS_WMKV); \
            if (r < 1792) { transpose_item(PTR(10) + (size_t)l * 1024 * 3584, 1024, 3584, (bf16_t*)(wl + W_IN), 0, PTR(9) + l * 1024, scr, r, lane); break; } r -= 1792; \
            if (r < 512)  { transpose_item(PTR(13) + (size_t)l * 1024 * 1024, 1024, 1024, (bf16_t*)(wl + W_OUT), 0, nullptr, scr, r, lane); break; } r -= 512; \
            if (r < 256)  { transpose_item(PTR(16) + (size_t)l * 1024 * 512, 1024, 512, (bf16_t*)(wl + W_MQ), 0, PTR(14) + l * 1024, scr, r, lane); break; } r -= 256; \
            if (r < 256)  { transpose_item(PTR(17) + (size_t)l * 1024 * 512, 1024, 512, wmkv + (size_t)l * 1024 * 1024, 0, PTR(15) + l * 1024, scr, r, lane); break; } r -= 256; \
            if (r < 256)  { transpose_item(PTR(18) + (size_t)l * 1024 * 512, 1024, 512, wmkv + (size_t)l * 1024 * 1024, 512, PTR(15) + l * 1024, scr, r, lane); break; } r -= 256; \
            if (r < 256)  { transpose_item(PTR(19) + (size_t)l * 512 * 1024, 512, 1024, (bf16_t*)(wl + W_MO), 0, nullptr, scr, r, lane); break; } r -= 256; \
            if (r < 2048) { transpose_item(PTR(21) + (size_t)l * 1024 * 4096, 1024, 4096, (bf16_t*)(wl + W_1), 0, PTR(20) + l * 1024, scr, r, lane); break; } r -= 2048; \
            transpose_item(PTR(22) + (size_t)l * 4096 * 1024, 4096, 1024, (bf16_t*)(wl + W_2), 0, nullptr, scr, r, lane); } while (0)
#define ARGP(i) args.in[i]
        const bool defer = (G == 256);
        for (int it = gw; it < (defer ? 3328 + 512 : 14848); it += NGW) {
            if (defer) { if (it < 3328) CONV_ITEM(ARGP, 0, it, ws); else CONV_ITEM(ARGP, 1, 2560 + (it - 3328), ws); }
            else { if (it < 7424) CONV_ITEM(ARGP, 0, it, ws); else CONV_ITEM(ARGP, 1, it - 7424, ws); } }
#undef ARGP
#define ROW_PTRS(m, S, D, Q, R) do { if ((m) < NPROMPT) { S = args.in[0] + (size_t)(m) * 1024; D = XB + (size_t)(m) * 1024; Q = SSQ + (size_t)(m) * 16; R = (float*)(ws + WS_RSTD) + (m); } \
            else if ((m) < M_ALL) { S = args.in[1] + (size_t)((m) - NPROMPT) * 1024; D = XB + (size_t)(m) * 1024; Q = SSQ + (size_t)(m) * 16; R = (float*)(ws + WS_RSTD) + (m); } \
            else { S = args.in[2] + (size_t)((m) - M_ALL) * 1024; D = MEMB + (size_t)((m) - M_ALL) * 1024; Q = MEMSSQ + (size_t)((m) - M_ALL) * 16; R = (float*)(ws + WS_MEMRSTD) + ((m) - M_ALL); } } while (0)
        for (int m0 = gw; m0 < M_ALL + 512; m0 += 2 * NGW) { const bool hasB = m0 + NGW < M_ALL + 512; const int m1 = hasB ? m0 + NGW : m0;
            const float *sA, *sB; bf16_t *dA, *dB; float *qA, *qB, *rA, *rB;
            ROW_PTRS(m0, sA, dA, qA, rA); ROW_PTRS(m1, sB, dB, qB, rB);
            row_prep2(sA, dA, qA, rA, sB, dB, qB, rB, hasB, lane); }
#undef ROW_PTRS
    }
    grid.sync();
    (void)xcd_barrier_post((unsigned*)(ws + WS_BAR), (volatile LAS unsigned*)(lds + LDS_BARST));
#define GRID_BAR() do { XcdBarrier b_; b_.bar = (unsigned*)(ws + WS_BAR); b_.x = xb_xcc_id(); b_.st = (volatile LAS unsigned*)(lds + LDS_BARST); xcd_barrier(b_); } while (0)

#pragma nounroll
    for (int l = 0; l < 2; ++l) {
#pragma nounroll
        for (int q = 0; q < (l == 0 ? 2 : 1); ++q) {
            WAVE_IDS; unsigned char* w_ = ws; float* o_ = out; int l_ = l; OPQP(unsigned char, w_); OPQP(float, o_); OPQ(l_);
            Gemm g; EpiF32 E;
            if (q == 0) { g = Gemm{(const bf16_t*)(w_ + WS_XB), (const bf16_t*)(w_ + WS_W0 + (size_t)l_ * WS_WL + W_IN), M_ALL, 3584, 1024};
                E = EpiF32{0, (const float*)(w_ + WS_RSTD), (float*)(w_ + WS_PROJ), o_, l_, (bf16_t*)(w_ + WS_VT), (bf16_t*)(w_ + WS_KB)}; }
            else { g = Gemm{(const bf16_t*)(w_ + WS_MEMB), (const bf16_t*)(w_ + WS_WMKV), 512, 2048, 1024};
                E = EpiF32{1, (const float*)(w_ + WS_MEMRSTD), nullptr, o_, l_, nullptr, nullptr}; }
            StaticOrder S; S.init(g.M, g.N, G, q == 0 ? bid : (bid + 16) % G);
            gemm_phase<EpiF32, StaticOrder, true, true>(lds, g, S, E);
        }
        if (l == 0 && gridDim.x == 256 && blockIdx.x >= 156 && blockIdx.x < 240) {
            WAVE_IDS; unsigned char* w_ = ws; OPQP(unsigned char, w_);
            const unsigned long long* tabc = (const unsigned long long*)w_; LAS float* scr = (LAS float*)(lds + wave * 16384);
#define TABP(i) FPTR(tabc[i])
            for (int j = (bid - 156) * 8 + wave; j < 4096; j += 84 * 8) CONV_ITEM(TABP, 0, 3328 + j, w_);
#undef TABP
        }
        GRID_BAR();
#pragma nounroll
        for (int ph = 0; ph < 3; ++ph) {
            WAVE_IDS; unsigned char* w_ = ws; float* o_ = out; int l_ = l; OPQP(unsigned char, w_); OPQP(float, o_); OPQ(l_);
            const unsigned long long* tab = (const unsigned long long*)w_;
            float* PROJ = (float*)(w_ + WS_PROJ); float* OSB = (float*)(w_ + WS_OSB); bf16_t* MIX = (bf16_t*)(w_ + WS_MIX); float* DS = (float*)(w_ + WS_DS); float* DD = (float*)(w_ + WS_DD);
            if (ph != 1) {
                const int nit = ph == 0 ? 1152 : 1024;
                const float* state_hgrn = GPTR(tab[5]); const float* lb_logits = GPTR(tab[8]); const float* hgain = GPTR(tab[12]) + l_ * 512;
#define HG_DECODE(IT, ROW0, TV, H) do { if ((IT) < 1024) { const int bh_ = (IT) >> 7; H = bh_ & 3; ROW0 = (bh_ >> 2) * 8192 + ((IT) & 127) * 64; TV = 64; } \
                    else { const int si_ = (IT) - 1024; H = si_ & 3; ROW0 = NPROMPT + 16 * (si_ >> 2); TV = 16; } } while (0)
#define HG_MAP(Q) (ph == 0 ? ((Q) < 128 ? 1024 + (Q) : (Q) - 128) : (Q))
                volatile LAS unsigned* LW = (volatile LAS unsigned*)(lds + LDS_BARST);
                unsigned* ctr = (unsigned*)(w_ + WS_CTR) + 2 * l_;
                unsigned nextq = 0; int cur;
                if (ph == 0) { if (tid == 0) LW[4] = atomicAdd(ctr, 1u); __syncthreads(); cur = (int)LW[4]; if (tid == 0) nextq = atomicAdd(ctr, 1u); }
                else cur = bid;
                while (cur < nit) {
                    const int it = HG_MAP(cur); int nxt;
                    if (ph == 0) { __syncthreads(); if (tid == 0) LW[4] = nextq; __syncthreads(); nxt = (int)LW[4]; if (tid == 0 && nxt < nit) nextq = atomicAdd(ctr, 1u); }
                    else nxt = cur + G;
                    int row0, tvalid, h; HG_DECODE(it, row0, tvalid, h);
                    float* dsOut; float* ddOut; const float* s0; const float* Ssrc;
                    if (it < 1024) { const int bh = it >> 7, c = it & 127; dsOut = DS + (size_t)(bh * 128 + c) * 16384; ddOut = DD + (size_t)(bh * 128 + c) * 128; s0 = nullptr; Ssrc = dsOut; }
                    else { const int si = it - 1024, s = si >> 2; s0 = state_hgrn + (size_t)((l_ * 32 + s) * 4 + h) * 16384; Ssrc = s0; dsOut = o_ + O_HS + (size_t)((l_ * 32 + s) * 4 + h) * 16384; ddOut = nullptr; }
                    int t2 = tid; asm volatile("" : "+v"(t2)); const int lane2 = t2 & 63, tg2 = t2 >> 7, k2 = t2 & 127;
                    const int ch = h * 128 + k2;
                    const float lbv = l_ == 0 ? 0.f : __builtin_amdgcn_rcpf(1.f + fexp(lb_logits[ch] - lb_logits[512 + ch]));
                    { float zc[16]; hg_load(PROJ, row0, tvalid, h, tg2, k2, 2048, zc);
                      if (ph == 0) hg_h1(lds, PROJ, zc, row0, tvalid, h, lbv, dsOut, ddOut, s0, t2, lane2, wave);
                      if (ph == 2 || it >= 1024) hg_h3(lds, PROJ, zc, row0, tvalid, h, lbv, Ssrc, it < 1024, hgain, MIX, t2, lane2, wave); }
                    cur = nxt;
                }
#undef HG_DECODE
#undef HG_MAP
                if (ph == 0) { unsigned char* w2 = ws; float* o2 = out; int l2 = l; OPQP(unsigned char, w2); OPQP(float, o2); OPQ(l2);
                    const unsigned long long* tab2 = (const unsigned long long*)w2; unsigned* ctr2 = (unsigned*)(w2 + WS_CTR) + 2 * l2 + 1;
                    unsigned wq = 0; if (lane == 0) wq = atomicAdd(ctr2, 1u); int w = __builtin_amdgcn_readfirstlane(wq);
                    while (w < 4352) { unsigned wn = 0; if (lane == 0) wn = atomicAdd(ctr2, 1u);
                        int lane2 = lane; asm volatile("" : "+v"(lane2));
                        if (w < 256) sb_item<true>(4096 + w, l2, (const float*)(w2 + WS_PROJ), o2 + O_KP + (size_t)l2 * NPROMPT * 512, o2 + O_VP + (size_t)l2 * NPROMPT * 512,
                                                    o2 + O_KS + (size_t)l2 * 262144, o2 + O_VS + (size_t)l2 * 262144, GPTR(tab2[3]), GPTR(tab2[4]), (const bf16_t*)(w2 + WS_VT), (const bf16_t*)(w2 + WS_KB), (float*)(w2 + WS_OSB), lane2);
                        else sb_item<false>(w - 256, l2, (const float*)(w2 + WS_PROJ), o2 + O_KP + (size_t)l2 * NPROMPT * 512, o2 + O_VP + (size_t)l2 * NPROMPT * 512,
                                                    o2 + O_KS + (size_t)l2 * 262144, o2 + O_VS + (size_t)l2 * 262144, GPTR(tab2[3]), GPTR(tab2[4]), (const bf16_t*)(w2 + WS_VT), (const bf16_t*)(w2 + WS_KB), (float*)(w2 + WS_OSB), lane2);
                        w = __builtin_amdgcn_readfirstlane(wn); } }
            } else {
                if (wave < 4) {
                    for (int p = bid * 256 + tid; p < 65536; p += G * 256) { const int e = 2 * p, bh = e >> 14, rem = e & 16383, k = rem & 127, v = rem >> 7;
                        unsigned* dsp = (unsigned*)(DS + (size_t)(bh * 128) * 16384) + (rem >> 1); const float* ddp = DD + (size_t)(bh * 128) * 128 + k;
                        float S0 = 0.f, S1 = 0.f;
                        for (int c = 0; c < 128; c += 16) { unsigned x[16]; f32x2_t d[16];
#pragma unroll
                            for (int u = 0; u < 16; ++u) { x[u] = dsp[(size_t)(c + u) * 16384]; d[u] = *(const f32x2_t*)(ddp + (c + u) * 128); }
#pragma unroll
                            for (int u = 0; u < 16; ++u) { dsp[(size_t)(c + u) * 16384] = pk2(S0, S1);
                                S0 = d[u].x * S0 + __uint_as_float(x[u] << 16); S1 = d[u].y * S1 + __uint_as_float(x[u] & 0xffff0000u); } }
                        float* op = o_ + O_HP + (size_t)l_ * 131072 + (size_t)bh * 16384 + k * 128 + v; op[0] = S0; op[128] = S1; }
                } else {
                    const float* sbg = GPTR(tab[11]) + l_ * 512; const int NW4 = G * 4;
                    const f32x4 ga = *(const f32x4*)(sbg + lane * 8), gb = *(const f32x4*)(sbg + lane * 8 + 4);
                    int m = bid * 4 + (wave - 4); f32x4 a = {0.f, 0.f, 0.f, 0.f}, b = a;
                    if (m < M_ALL) { const f32x4* op = (const f32x4*)(OSB + (size_t)m * 512 + lane * 8); a = op[0]; b = op[1]; }
                    while (m < M_ALL) { const int mn = m + NW4; f32x4 an = a, bn = b;
                        if (mn < M_ALL) { const f32x4* op = (const f32x4*)(OSB + (size_t)mn * 512 + lane * 8); an = op[0]; bn = op[1]; }
                        float ss = ((a[0] * a[0] + a[1] * a[1]) + (a[2] * a[2] + a[3] * a[3])) + ((b[0] * b[0] + b[1] * b[1]) + (b[2] * b[2] + b[3] * b[3]));
                        ss = wave_sum(ss); const float rs = rsqrtf(ss * (1.0f / 512.0f) + 1e-6f);
                        *(u32x4*)(MIX + (size_t)m * 1024 + lane * 8) = (u32x4){pk2(a[0] * rs * ga[0], a[1] * rs * ga[1]), pk2(a[2] * rs * ga[2], a[3] * rs * ga[3]),
                                                                              pk2(b[0] * rs * gb[0], b[1] * rs * gb[1]), pk2(b[2] * rs * gb[2], b[3] * rs * gb[3])};
                        a = an; b = bn; m = mn; } }
            }
            GRID_BAR();
        }
#pragma nounroll
        for (int st = 0; st < 3; ++st) {
            { WAVE_IDS; unsigned char* w_ = ws; int l_ = l; OPQP(unsigned char, w_); OPQ(l_);
              const unsigned long long* tab = (const unsigned long long*)w_; unsigned char* wl = w_ + WS_W0 + (size_t)l_ * WS_WL;
              float* X = (float*)(w_ + WS_X);
              const bf16_t* A = (const bf16_t*)(w_ + (st == 0 ? WS_MIX : (st == 1 ? WS_OM : WS_H))); const bf16_t* Bt = (const bf16_t*)(wl + (st == 0 ? W_OUT : (st == 1 ? W_MO : W_2)));
              const int K = st == 0 ? 1024 : (st == 1 ? 512 : 4096);
              { Gemm g{A, Bt, NPROMPT, 1024, K, 0};
                EpiResid E{(st == 0 && l_ == 0) ? FPTR(tab[0]) : X, nullptr, X, (bf16_t*)(w_ + WS_XB), (float*)(w_ + WS_SSQ)};
                StaticOrder S; S.init(NPROMPT, 1024, G, bid);
                gemm_phase<EpiResid, StaticOrder, true, true>(lds, g, S, E); }
              { Gemm g{A, Bt, M_ALL, 1024, 256, K};
                EpiPart E{(float*)(w_ + WS_PART)};
                SplitOrder S; S.init(2, 1024, K / 256, G, bid, 64);
                gemm_phase<EpiPart, SplitOrder, true, true>(lds, g, S, E); } }
            GRID_BAR();
            { WAVE_IDS; unsigned char* w_ = ws; int l_ = l; OPQP(unsigned char, w_); OPQ(l_);
              const unsigned long long* tab = (const unsigned long long*)w_; const int nS = (st == 0 ? 1024 : (st == 1 ? 512 : 4096)) / 256;
              float* X = (float*)(w_ + WS_X); bf16_t* XB = (bf16_t*)(w_ + WS_XB); float* SSQ = (float*)(w_ + WS_SSQ); const float* PART = (const float*)(w_ + WS_PART);
              const float* bs = (st == 0 && l_ == 0) ? FPTR(tab[1]) : X + (size_t)NPROMPT * 1024;
              LAS float* red = (LAS float*)lds;
              for (int mb = bid; mb < 256; mb += G) { const int m = mb * 2 + (wave >> 2), cq = wave & 3, col = cq * 256 + lane * 4;
                  f32x4 v = *(const f32x4*)(bs + (size_t)m * 1024 + col); f32x4 pp[16];
#pragma unroll
                  for (int ks = 0; ks < 16; ++ks) { const int kc = ks < nS ? ks : 0; pp[ks] = *(const f32x4*)(PART + ((size_t)kc * 512 + m) * 1024 + col); }
#pragma unroll
                  for (int ks = 0; ks < 16; ++ks) { const float on = ks < nS ? 1.f : 0.f; v += pp[ks] * on; }
                  *(f32x4*)(X + (size_t)(NPROMPT + m) * 1024 + col) = v;
                  u32x2 w; w.x = pk2(v[0], v[1]); w.y = pk2(v[2], v[3]); *(u32x2*)(XB + (size_t)(NPROMPT + m) * 1024 + col) = w;
                  float s = wave_sum((v[0] * v[0] + v[1] * v[1]) + (v[2] * v[2] + v[3] * v[3]));
                  if (lane == 0) red[wave] = s;
                  __syncthreads();
                  if (cq == 0 && lane == 0) ((float*)(w_ + WS_RSTD))[NPROMPT + m] = rsqrtf(((red[wave] + red[wave + 1]) + (red[wave + 2] + red[wave + 3])) * (1.0f / 1024.0f) + 1e-6f);
                  __syncthreads(); }
              if (tid < 64) for (int r = bid * 64 + tid; r < NPROMPT; r += G * 64) ((float*)(w_ + WS_RSTD))[r] = row_rstd(SSQ, r); }
            GRID_BAR();
            if (st < 2) {
                WAVE_IDS; unsigned char* w_ = ws; int l_ = l; OPQP(unsigned char, w_); OPQ(l_); unsigned char* wl = w_ + WS_W0 + (size_t)l_ * WS_WL;
                Gemm g; EpiBf16S E;
                if (st == 0) { g = Gemm{(const bf16_t*)(w_ + WS_XB), (const bf16_t*)(wl + W_MQ), M_ALL, 512, 1024}; E = EpiBf16S{(bf16_t*)(w_ + WS_QM), 512, (const float*)(w_ + WS_RSTD), 0.08838834764831845f, 0}; }
                else { g = Gemm{(const bf16_t*)(w_ + WS_XB), (const bf16_t*)(wl + W_1), M_ALL, 4096, 1024}; E = EpiBf16S{(bf16_t*)(w_ + WS_H), 4096, (const float*)(w_ + WS_RSTD), 1.0f, 1}; }
                StaticOrder S; S.init(M_ALL, g.N, G, bid);
                gemm_phase<EpiBf16S, StaticOrder, true, true>(lds, g, S, E);
                if (st == 0 && l_ == 0 && bid >= 132 && G == 256) {
                    const unsigned long long* tabc = (const unsigned long long*)w_; LAS float* scr = (LAS float*)(lds + wave * 16384);
#define TABP(i) FPTR(tabc[i])
                    for (int j = (bid - 132) * 8 + wave; j < 6912; j += 124 * 8) CONV_ITEM(TABP, 1, j < 2560 ? j : j + 512, w_);
#undef TABP
                }
                GRID_BAR();
            }
            if (st == 0) {
                WAVE_IDS; unsigned char* w_ = ws; float* o_ = out; int l_ = l; OPQP(unsigned char, w_); OPQP(float, o_); OPQ(l_);
                const unsigned long long* tab = (const unsigned long long*)w_; const float* cache_mk = GPTR(tab[6]); const float* cache_mv = GPTR(tab[7]);
                const bf16_t* QM = (const bf16_t*)(w_ + WS_QM); bf16_t* OM = (bf16_t*)(w_ + WS_OM);
                for (int it = bid; it < 1152; it += G) {
                    int row0, tvalid, hm; const float* Kg; const float* Vg;
                    if (it < 1024) { const int tt = it >> 2; hm = it & 3; row0 = tt * 64; tvalid = 64; const int b = tt >> 7;
                        Kg = o_ + O_MKP + (size_t)(l_ * 2 + b) * 131072 + hm * 128; Vg = o_ + O_MVP + (size_t)(l_ * 2 + b) * 131072 + hm * 128; }
                    else { const int si = it - 1024, s = si >> 2; hm = si & 3; row0 = NPROMPT + 16 * s; tvalid = 16;
                        Kg = cache_mk + (size_t)(l_ * 32 + s) * 131072 + hm * 128; Vg = cache_mv + (size_t)(l_ * 32 + s) * 131072 + hm * 128; }
                    int t2 = tid; asm volatile("" : "+v"(t2));
                    xattn_item(lds, QM, Kg, Vg, row0, tvalid, hm, OM, t2, t2 & 63, wave);
                }
                GRID_BAR();
            }
        }
    }
    { WAVE_IDS; unsigned char* w_ = ws; float* o_ = out; OPQP(unsigned char, w_); OPQP(float, o_);
      const float* nf = GPTR(((const unsigned long long*)w_)[23]); const float* X = (const float*)(w_ + WS_X);
      for (int m0 = gw; m0 < M_ALL; m0 += 2 * NGW) { const int m1 = (m0 + NGW < M_ALL) ? m0 + NGW : m0;
          const f32x4* xa = (const f32x4*)(X + (size_t)m0 * 1024) + lane; const f32x4* xb = (const f32x4*)(X + (size_t)m1 * 1024) + lane; f32x4 va[4], vb[4]; float sa = 0.f, sb = 0.f;
#pragma unroll
          for (int j = 0; j < 4; ++j) { va[j] = xa[64 * j]; vb[j] = xb[64 * j]; }
#pragma unroll
          for (int j = 0; j < 4; ++j) { sa += (va[j][0] * va[j][0] + va[j][1] * va[j][1]) + (va[j][2] * va[j][2] + va[j][3] * va[j][3]); sb += (vb[j][0] * vb[j][0] + vb[j][1] * vb[j][1]) + (vb[j][2] * vb[j][2] + vb[j][3] * vb[j][3]); }
          sa = wave_sum(sa); sb = wave_sum(sb); const float ra = rsqrtf(sa * (1.0f / 1024.0f) + 1e-6f), rb = rsqrtf(sb * (1.0f / 1024.0f) + 1e-6f);
          f32x4* ya = (f32x4*)(o_ + (m0 < NPROMPT ? O_YP + (size_t)m0 * 1024 : O_YS + (size_t)(m0 - NPROMPT) * 1024)) + lane;
          f32x4* yb = (f32x4*)(o_ + (m1 < NPROMPT ? O_YP + (size_t)m1 * 1024 : O_YS + (size_t)(m1 - NPROMPT) * 1024)) + lane;
#pragma unroll
          for (int j = 0; j < 4; ++j) { const f32x4 g = *((const f32x4*)nf + lane + 64 * j); ya[64 * j] = va[j] * ra * g; if (m1 != m0) yb[64 * j] = vb[j] * rb * g; } } }
}

extern "C" void kernel_launch(void* const* d_in, const int* in_sizes, int n_in, void* d_out, int out_size, void* d_ws, size_t ws_size, hipStream_t stream) {
    static int grid = 0;
    if (grid == 0) {
        int dev = 0, cus = 0, per_cu = 0;
        (void)hipGetDevice(&dev); (void)hipDeviceGetAttribute(&cus, hipDeviceAttributeMultiprocessorCount, dev);
        if (hipFuncSetAttribute((const void*)mega_fwd, hipFuncAttributeMaxDynamicSharedMemorySize, LDS_BYTES) != hipSuccess) fprintf(stderr, "kernel_launch: hipFuncSetAttribute failed\n");
        if (hipOccupancyMaxActiveBlocksPerMultiprocessor(&per_cu, (const void*)mega_fwd, 512, LDS_BYTES) != hipSuccess || per_cu < 1) { fprintf(stderr, "kernel_launch: occupancy query says %d\n", per_cu); per_cu = 1; }
        (void)hipGetLastError();
        if (cus <= 0) cus = 256;
        grid = cus;
    }
    Args a{};
    for (int i = 0; i < 24; ++i) a.in[i] = (const float*)d_in[i];
    a.out = (float*)d_out; a.ws = (unsigned char*)d_ws;
    void* kargs[] = {&a};
    const hipError_t e = hipLaunchCooperativeKernel((const void*)mega_fwd, dim3(grid), dim3(512), kargs, LDS_BYTES, stream);
    if (e != hipSuccess) fprintf(stderr, "kernel_launch: cooperative launch failed: %s (grid %d)\n", hipGetErrorString(e), grid);
}
```

```cpp
#include <hip/hip_runtime.h>
#include <hip/hip_cooperative_groups.h>
#include <cstdio>
#include <cstdint>
namespace cg = cooperative_groups;
namespace pg8 {
#define PG8_LAS __attribute__((address_space(3)))
typedef unsigned short bf16_t;
typedef short bf16x8 __attribute__((ext_vector_type(8)));
typedef float f32x4 __attribute__((ext_vector_type(4)));
typedef unsigned u32x4 __attribute__((ext_vector_type(4)));
constexpr int BM = 256, BK = 64, HALF = 128, HTB = HALF * BK * 2  , STAGE_BYTES = 8 * HTB, NXCD = 8, WGM = 8;

__host__ __device__ __forceinline__ int lds_byte(int r, int c) { const int st = (r >> 4) * 2 + (c >> 5), rr = r & 15, cc = c & 31, ob = rr * 64 + cc * 2; return st * 1024 + (ob ^ (((ob >> 9) & 1) << 5)); }
__host__ __device__ __forceinline__ void stage_rc(int b, int& R, int& C) { const int st = b / 1024, sb = b % 1024, swz = sb ^ (((sb >> 9) & 1) << 5); R = (st >> 1) * 16 + swz / 64; C = (st & 1) * 32 + (swz % 64) / 2; }
__host__ __device__ __forceinline__ int perm32(int rho) { const int n = rho >> 4, i = rho & 15; return 8 * (i >> 2) + 4 * n + (i & 3); }

struct Unit { int pm, pn, ks; };
struct Gemm { const bf16_t* A; const bf16_t* Bt; int M, N, K, ld; };

struct StaticOrder {
    int nM, nN, nwg, G, c;
    __host__ __device__ void init(int M, int N, int G_, int c_) { nM = M / BM; nN = N / BM; nwg = nM * nN; G = G_; c = c_; }
    __host__ __device__ bool next(int i, Unit& u) const {
        const long L = (long)i * G + c; if (L >= nwg) return false;
        int wgid = (int)L; { const int q = nwg / NXCD, r = nwg % NXCD, xcd = wgid % NXCD, off = wgid / NXCD; wgid = (xcd < r ? xcd * (q + 1) : r * (q + 1) + (xcd - r) * q) + off; }
        const int nig = WGM * nN, gid = wgid / nig, fm = gid * WGM, gsz = (nM - fm) < WGM ? (nM - fm) : WGM;
        u.pm = fm + ((wgid % nig) % gsz); u.pn = (wgid % nig) / gsz; u.ks = 0; return true;
    }
    __device__ __forceinline__ void a_ready(const Unit&) const {}
    __device__ __forceinline__ void done(const Unit&) const {}
};
struct SplitOrder {
    int nN, nS, nwg, G, c, pm0;
    __host__ __device__ void init(int nMs, int N, int nS_, int G_, int c_, int pm0_) { nN = N / BM; nS = nS_; nwg = nMs * nN * nS; G = G_; c = c_; pm0 = pm0_; }
    __host__ __device__ bool next(int i, Unit& u) const { const long L = (long)i * G + c; if (L >= nwg) return false; const int t = (int)L / nS; u.ks = (int)L % nS; u.pn = t % nN; u.pm = pm0 + t / nN; return true; }
    __device__ __forceinline__ void a_ready(const Unit&) const {}
    __device__ __forceinline__ void done(const Unit&) const {}
};
__device__ __forceinline__ unsigned cvt_pk_bf16(float lo, float hi) { unsigned r; asm volatile("v_cvt_pk_bf16_f32 %0, %1, %2" : "=v"(r) : "v"(lo), "v"(hi)); return r; }
typedef float f32x2 __attribute__((ext_vector_type(2)));
typedef unsigned u32x2 __attribute__((ext_vector_type(2)));
constexpr int NPROMPT = 16384;
constexpr size_t O_YP = 0, O_YS = 16777216, O_KP = 17301504, O_VP = 34078720, O_HP = 50855936, O_MKP = 51118080, O_MVP = 51642368,
                 O_KS = 52166656, O_VS = 52690944, O_HS = 53215232;
__device__ __forceinline__ float row_rstd(const float* ssq, int row) {
    const f32x4* p = (const f32x4*)(ssq + (size_t)row * 16);
    const f32x4 a = p[0], b = p[1], c = p[2], d = p[3];
    const float s = (((a[0] + a[1]) + (a[2] + a[3])) + ((b[0] + b[1]) + (b[2] + b[3]))) + (((c[0] + c[1]) + (c[2] + c[3])) + ((d[0] + d[1]) + (d[2] + d[3])));
    return rsqrtf(s * (1.0f / 1024.0f) + 1e-6f);
}
struct EpiF32 {
    static constexpr bool PERM = true, AFTER_DRAIN = false;
    int mode; const float* rstd; float* proj; float* outp; int l; bf16_t* vt; bf16_t* kb;
    __device__ __forceinline__ void operator()(const f32x4 (&acc)[2][2][4][2], const Unit& u, int wr, int wc, int fr_, int fq_) const {
        int tq = threadIdx.x; asm volatile("" : "+v"(tq)); const int fr = tq & 15, fq = (tq >> 4) & 3;
        float* base; int pitch, colt, rsub = 0; const int pn = u.pn;
        if (mode == 0) {
            if (pn >= 2 && pn < 6) { const size_t isv = pn >= 4 ? 1 : 0; colt = (pn & 1) * 256; pitch = 512;
                if (u.pm < 64) base = outp + (O_KP + isv * (O_VP - O_KP) + (size_t)l * NPROMPT * 512);
                else { base = outp + (O_KS + isv * (O_VS - O_KS) + (size_t)l * 262144); rsub = NPROMPT; } }
            else { base = proj; pitch = 3584; colt = pn * 256; }
        } else { const size_t sel = (size_t)(pn >> 1); base = outp + (O_MKP + (sel & 1) * (O_MVP - O_MKP) + (sel >> 1) * 262144); pitch = 512; colt = (pn & 1) * 256; }
        const int col0 = colt + wc * 32 + 8 * fq, rowb = u.pm * BM + wr * 64 + fr;
        float rs[2][4];
#pragma unroll
        for (int ai = 0; ai < 2; ++ai)
#pragma unroll
            for (int m = 0; m < 4; ++m) rs[ai][m] = rstd[rowb + ai * HALF + m * 16];
#pragma unroll
        for (int ai = 0; ai < 2; ++ai)
#pragma unroll
            for (int m = 0; m < 4; ++m) { const int row = rowb + ai * HALF + m * 16;
                float* rp = base + (size_t)(row - rsub) * pitch + col0;
#pragma unroll
                for (int bj = 0; bj < 2; ++bj)
#pragma unroll
                    for (int n = 0; n < 2; ++n) *(f32x4*)(rp + bj * HALF + n * 4) = acc[ai][bj][m][n] * rs[ai][m]; }
        if (mode == 1) {
            const int sel = pn >> 1, lyr = sel >> 1, isv = sel & 1, bb = u.pm;
#pragma unroll
            for (int ai = 0; ai < 2; ++ai)
#pragma unroll
                for (int m = 0; m < 4; ++m) { const int row = rowb + ai * HALF + m * 16, mm = row & 255;
#pragma unroll
                    for (int bj = 0; bj < 2; ++bj) { const f32x4 v0 = acc[ai][bj][m][0] * rs[ai][m], v1 = acc[ai][bj][m][1] * rs[ai][m]; const int c = col0 + bj * HALF, hh = c >> 7, d0 = c & 127;
                        const unsigned p0 = cvt_pk_bf16(v0[0], v0[1]), p1 = cvt_pk_bf16(v0[2], v0[3]), p2 = cvt_pk_bf16(v1[0], v1[1]), p3 = cvt_pk_bf16(v1[2], v1[3]);
                        const size_t hb = (size_t)((lyr * 2 + bb) * 4 + hh) * 32768;
                        if (!isv) { u32x4 w; w.x = p0; w.y = p1; w.z = p2; w.w = p3; *(u32x4*)(kb + hb + (size_t)mm * 128 + d0) = w; }
                        else { bf16_t* q = vt + hb + (size_t)d0 * 256 + mm;
                            q[0] = (bf16_t)(p0 & 0xffffu); q[256] = (bf16_t)(p0 >> 16); q[512] = (bf16_t)(p1 & 0xffffu); q[768] = (bf16_t)(p1 >> 16);
                            q[1024] = (bf16_t)(p2 & 0xffffu); q[1280] = (bf16_t)(p2 >> 16); q[1536] = (bf16_t)(p3 & 0xffffu); q[1792] = (bf16_t)(p3 >> 16); } } }
        }
        if (mode == 0 && pn >= 2 && pn < 4 && u.pm < 64) {
#pragma unroll
            for (int ai = 0; ai < 2; ++ai)
#pragma unroll
                for (int m = 0; m < 4; ++m) { const int row = rowb + ai * HALF + m * 16, t = row & 8191;
#pragma unroll
                    for (int bj = 0; bj < 2; ++bj) { const f32x4 v0 = acc[ai][bj][m][0] * rs[ai][m], v1 = acc[ai][bj][m][1] * rs[ai][m]; const int c = col0 + bj * HALF, hh = c >> 6, d0 = c & 63;
                        u32x4 w; w.x = cvt_pk_bf16(v0[0], v0[1]); w.y = cvt_pk_bf16(v0[2], v0[3]); w.z = cvt_pk_bf16(v1[0], v1[1]); w.w = cvt_pk_bf16(v1[2], v1[3]);
                        *(u32x4*)(kb + ((((size_t)((row >> 13) * 8 + hh) * 256 + (t >> 5)) * 8 + (d0 >> 3)) * 32 + (t & 31)) * 8) = w; } }
        }
        if (mode == 0 && pn >= 4 && pn < 6 && u.pm < 64) {
            const int qi = fr & 3;
#pragma unroll
            for (int ai = 0; ai < 2; ++ai)
#pragma unroll
                for (int m = 0; m < 4; ++m) { const int row = rowb + ai * HALF + m * 16, t0 = (row & 8191) & ~3; const size_t tb = ((size_t)(row >> 13) * 8 * 2048 * 64 + (size_t)(t0 >> 2) * 64) * 4;
#pragma unroll
                    for (int bj = 0; bj < 2; ++bj)
#pragma unroll
                        for (int n = 0; n < 2; ++n) { const f32x4 v = acc[ai][bj][m][n] * rs[ai][m]; const int c = col0 + bj * HALF + n * 4;
                            const unsigned p01 = cvt_pk_bf16(v[0], v[1]), p23 = cvt_pk_bf16(v[2], v[3]);
                            const unsigned snd1 = (qi & 2) ? p01 : p23, kep1 = (qi & 2) ? p23 : p01, rcv1 = (unsigned)__shfl_xor((int)snd1, 2);
                            const unsigned q0 = (qi & 2) ? rcv1 : kep1, q2 = (qi & 2) ? kep1 : rcv1;
                            const unsigned los = (q0 & 0xffffu) | (q2 << 16), his = (q0 >> 16) | (q2 & 0xffff0000u);
                            const unsigned rcv2 = (unsigned)__shfl_xor((int)((qi & 1) ? los : his), 1), mine = (qi & 1) ? his : los;
                            u32x2 w;
                            if (qi & 1) { w.x = (rcv2 & 0xffffu) | (mine << 16); w.y = (rcv2 >> 16) | (mine & 0xffff0000u); }
                            else { w.x = (mine & 0xffffu) | (rcv2 << 16); w.y = (mine >> 16) | (rcv2 & 0xffff0000u); }
                            const int cc = c + (qi & 2) + (qi & 1), hh = cc >> 6, dd = cc & 63;
                            *(u32x2*)(vt + tb + ((size_t)hh * 2048 * 64 + dd) * 4) = w; } }
        }
    }
};
struct EpiResid {
    static constexpr bool PERM = true, AFTER_DRAIN = false;
    const float* bp; const float* bs; float* X; bf16_t* XB; float* ssq;
    __device__ __forceinline__ void operator()(const f32x4 (&acc)[2][2][4][2], const Unit& u, int wr, int wc, int fr_, int fq_) const {
        int tq = threadIdx.x; asm volatile("" : "+v"(tq)); const int fr = tq & 15, fq = (tq >> 4) & 3;
        const int col0 = u.pn * BM + wc * 32 + 8 * fq;
#pragma unroll
        for (int ai = 0; ai < 2; ++ai) {
            f32x4 res[4][2][2];
#pragma unroll
            for (int m = 0; m < 4; ++m) { const int row = u.pm * BM + ai * HALF + wr * 64 + m * 16 + fr;
                const float* br = (row < NPROMPT ? bp + (size_t)row * 1024 : bs + (size_t)(row - NPROMPT) * 1024) + col0;
#pragma unroll
                for (int bj = 0; bj < 2; ++bj) { res[m][bj][0] = *(const f32x4*)(br + bj * HALF); res[m][bj][1] = *(const f32x4*)(br + bj * HALF + 4); } }
            asm volatile("" ::: "memory");
#pragma unroll
            for (int m = 0; m < 4; ++m) { const int row = u.pm * BM + ai * HALF + wr * 64 + m * 16 + fr;
                float* xr = X + (size_t)row * 1024 + col0; bf16_t* xb = XB + (size_t)row * 1024 + col0; float ss = 0.f;
#pragma unroll
                for (int bj = 0; bj < 2; ++bj) { const f32x4 v0 = acc[ai][bj][m][0] + res[m][bj][0], v1 = acc[ai][bj][m][1] + res[m][bj][1];
                    *(f32x4*)(xr + bj * HALF) = v0; *(f32x4*)(xr + bj * HALF + 4) = v1;
                    ss += ((v0[0] * v0[0] + v0[1] * v0[1]) + (v0[2] * v0[2] + v0[3] * v0[3])) + ((v1[0] * v1[0] + v1[1] * v1[1]) + (v1[2] * v1[2] + v1[3] * v1[3]));
                    u32x4 w; w.x = cvt_pk_bf16(v0[0], v0[1]); w.y = cvt_pk_bf16(v0[2], v0[3]); w.z = cvt_pk_bf16(v1[0], v1[1]); w.w = cvt_pk_bf16(v1[2], v1[3]); *(u32x4*)(xb + bj * HALF) = w; }
                ss += __shfl_xor(ss, 16); ss += __shfl_xor(ss, 32);
                if (fq == 0) ssq[(size_t)row * 16 + u.pn * 4 + wc] = ss; }
            asm volatile("" ::: "memory"); }
    }
};
struct EpiBf16S {
    static constexpr bool PERM = true, AFTER_DRAIN = false;
    bf16_t* O; int ldc; const float* rstd; float scale; int act;
    __device__ __forceinline__ void operator()(const f32x4 (&acc)[2][2][4][2], const Unit& u, int wr, int wc, int fr_, int fq_) const {
        int tq = threadIdx.x; asm volatile("" : "+v"(tq)); const int fr = tq & 15, fq = (tq >> 4) & 3;
        const int col0 = u.pn * BM + wc * 32 + 8 * fq, rowb = u.pm * BM + wr * 64 + fr;
        float rs[2][4];
#pragma unroll
        for (int ai = 0; ai < 2; ++ai)
#pragma unroll
            for (int m = 0; m < 4; ++m) rs[ai][m] = rstd[rowb + ai * HALF + m * 16];
#pragma unroll
        for (int ai = 0; ai < 2; ++ai)
#pragma unroll
            for (int m = 0; m < 4; ++m) { const int row = rowb + ai * HALF + m * 16; const float r1 = rs[ai][m];
                bf16_t* rowp = O + (size_t)row * ldc + col0;
#pragma unroll
                for (int bj = 0; bj < 2; ++bj) { f32x4 v0 = acc[ai][bj][m][0] * r1, v1 = acc[ai][bj][m][1] * r1;
                    if (act == 1) { v0 = __builtin_elementwise_max(v0, (f32x4){0.f, 0.f, 0.f, 0.f}); v1 = __builtin_elementwise_max(v1, (f32x4){0.f, 0.f, 0.f, 0.f}); v0 = v0 * v0; v1 = v1 * v1; }
                    v0 = v0 * scale; v1 = v1 * scale;
                    u32x4 w; w.x = cvt_pk_bf16(v0[0], v0[1]); w.y = cvt_pk_bf16(v0[2], v0[3]); w.z = cvt_pk_bf16(v1[0], v1[1]); w.w = cvt_pk_bf16(v1[2], v1[3]);
                    *(u32x4*)(rowp + bj * HALF) = w; } }
    }
};
struct EpiPart {
    static constexpr bool PERM = true, AFTER_DRAIN = false;
    float* part;
    __device__ __forceinline__ void operator()(const f32x4 (&acc)[2][2][4][2], const Unit& u, int wr, int wc, int fr_, int fq_) const {
        int tq = threadIdx.x; asm volatile("" : "+v"(tq)); const int fr = tq & 15, fq = (tq >> 4) & 3;
        const int col0 = u.pn * BM + wc * 32 + 8 * fq;
#pragma unroll
        for (int ai = 0; ai < 2; ++ai)
#pragma unroll
            for (int m = 0; m < 4; ++m) { const int row = (u.pm - 64) * BM + ai * HALF + wr * 64 + m * 16 + fr;
                float* rp = part + ((size_t)u.ks * 512 + row) * 1024 + col0;
#pragma unroll
                for (int bj = 0; bj < 2; ++bj)
#pragma unroll
                    for (int n = 0; n < 2; ++n) *(f32x4*)(rp + bj * HALF + n * 4) = acc[ai][bj][m][n];
                asm volatile("" ::: "memory"); }
    }
};
template <class Epi, class Sched, bool ALIGN_EPI = false, bool SP2 = false>
__device__ __forceinline__ void gemm_phase(PG8_LAS unsigned char* lds, const Gemm g, const Sched& S, const Epi& E) {
    int tid_ = threadIdx.x; asm volatile("" : "+v"(tid_));
    const int tid = tid_, wid = __builtin_amdgcn_readfirstlane(tid >> 6), lane = tid & 63, wr = wid >> 2, wc = wid & 3, fr = lane & 15, fq = lane >> 4;
    const int K = g.ld ? g.ld : g.K, nt = g.K / BK;
    unsigned voffA[2], voffB[2];
#pragma unroll
    for (int i = 0; i < 2; ++i) { int R, C; stage_rc(tid * 16 + i * 8192, R, C); const int Rb = Epi::PERM ? ((R & ~31) + perm32(R & 31)) : R;
        voffA[i] = (unsigned)(R * K + C) * 2u; voffB[i] = (unsigned)(Rb * K + C) * 2u; }
    const size_t kstep = (size_t)(BK * 2);
    const size_t hstep = (size_t)HALF * K * 2;
    const size_t tstep = 2 * hstep;
    const unsigned ldsw = (unsigned)wid * 1024u;
    const int aoff = lds_byte(wr * 64 + fr, fq * 8), boff = lds_byte(wc * 32 + fr, fq * 8);
#define PG8_SA(b, h) (((b) * 2 + (h)) * HTB)
#define PG8_SB(b, h) ((4 + (b) * 2 + (h)) * HTB)
#define PG8_STAGE(bufoff, gbase, voff) do { _Pragma("unroll") for (int _i = 0; _i < 2; ++_i) \
        __builtin_amdgcn_global_load_lds((const unsigned*)((const char*)(gbase) + (voff)[_i]), (PG8_LAS unsigned*)(lds + (bufoff) + ldsw + _i * 8192), 16, 0, 0); } while (0)
#define PG8_LDA(dst, b, h) do { _Pragma("unroll") for (int m = 0; m < 4; ++m) _Pragma("unroll") for (int k = 0; k < 2; ++k) dst[m][k] = *(const PG8_LAS bf16x8*)(lds + PG8_SA(b, h) + aoff + m * 2048 + k * 1024); } while (0)
#define PG8_LDB(dst, b, h) do { _Pragma("unroll") for (int n = 0; n < 2; ++n) _Pragma("unroll") for (int k = 0; k < 2; ++k) dst[n][k] = *(const PG8_LAS bf16x8*)(lds + PG8_SB(b, h) + boff + n * 2048 + k * 1024); } while (0)
#define PG8_MMA(ai, bj, At, Bt) do { __builtin_amdgcn_s_setprio(1); _Pragma("unroll") for (int m = 0; m < 4; ++m) _Pragma("unroll") for (int n = 0; n < 2; ++n) _Pragma("unroll") for (int k = 0; k < 2; ++k) \
        acc[ai][bj][m][n] = __builtin_amdgcn_mfma_f32_16x16x32_bf16(Bt[n][k], At[m][k], acc[ai][bj][m][n], 0, 0, 0); __builtin_amdgcn_s_setprio(0); } while (0)
#define PG8_WAIT_V(n) asm volatile("s_waitcnt vmcnt(" #n ")" ::: "memory")
#define PG8_WAIT_L(n) asm volatile("s_waitcnt lgkmcnt(" #n ")" ::: "memory")
#define PG8_BAR __builtin_amdgcn_s_barrier()
#define PG8_SCHED __builtin_amdgcn_sched_barrier(0)
    Unit cur, nxt; int ui = 0;
    if (!S.next(0, cur)) return;
    f32x4 acc[2][2][4][2];
#pragma unroll
    for (int a = 0; a < 2; ++a)
#pragma unroll
        for (int b = 0; b < 2; ++b)
#pragma unroll
            for (int m = 0; m < 4; ++m)
#pragma unroll
                for (int n = 0; n < 2; ++n) acc[a][b][m][n] = (f32x4){0.f, 0.f, 0.f, 0.f};
    bf16x8 At[4][2], B0[2][2], B1[2][2];
    const size_t sstep = (size_t)g.K * 2;
    const char* cA = (const char*)g.A + (size_t)cur.pm * tstep + (size_t)cur.ks * sstep; const char* cB = (const char*)g.Bt + (size_t)cur.pn * tstep + (size_t)cur.ks * sstep;
    S.a_ready(cur);
    if constexpr (SP2) {
        PG8_STAGE(PG8_SB(0, 0), cB, voffB); PG8_STAGE(PG8_SB(0, 1), cB + hstep, voffB); PG8_STAGE(PG8_SA(0, 0), cA, voffA); PG8_STAGE(PG8_SA(0, 1), cA + hstep, voffA);
        if (wr == 1) PG8_BAR;
        PG8_WAIT_V(2); PG8_BAR;
        PG8_STAGE(PG8_SB(1, 0), cB + kstep, voffB); PG8_STAGE(PG8_SA(1, 0), cA + kstep, voffA); PG8_STAGE(PG8_SB(1, 1), cB + hstep + kstep, voffB);
        PG8_WAIT_V(6); PG8_BAR;
    } else {
        PG8_STAGE(PG8_SB(0, 0), cB, voffB); PG8_STAGE(PG8_SA(0, 0), cA, voffA); PG8_STAGE(PG8_SB(0, 1), cB + hstep, voffB); PG8_STAGE(PG8_SA(0, 1), cA + hstep, voffA);
        if (wr == 1) PG8_BAR;
        PG8_WAIT_V(4); PG8_BAR;
        PG8_STAGE(PG8_SB(1, 0), cB + kstep, voffB); PG8_STAGE(PG8_SA(1, 0), cA + kstep, voffA); PG8_STAGE(PG8_SB(1, 1), cB + hstep + kstep, voffB);
        PG8_WAIT_V(6); PG8_BAR;
    }
    for (;;) {
        const bool has_next = S.next(ui + 1, nxt);
        const char* nA = has_next ? (const char*)g.A + (size_t)nxt.pm * tstep + (size_t)nxt.ks * sstep : cA; const char* nB = has_next ? (const char*)g.Bt + (size_t)nxt.pn * tstep + (size_t)nxt.ks * sstep : cB;
        for (int t = 0; t < nt; t += 2) {
            const bool last = (t == nt - 2);
            const char* a1 = cA + (size_t)(t + 1) * kstep;
            const char* a2 = last ? nA : cA + (size_t)(t + 2) * kstep; const char* b2 = last ? nB : cB + (size_t)(t + 2) * kstep;
            const char* a3 = a2 + kstep; const char* b3 = b2 + kstep;
            if (last && has_next) S.a_ready(nxt);
            if constexpr (SP2) {
            PG8_LDB(B0, 0, 0); PG8_LDB(B1, 0, 1); PG8_SCHED; PG8_LDA(At, 0, 0); PG8_STAGE(PG8_SA(1, 1), a1 + hstep, voffA);
            PG8_WAIT_V(8); PG8_WAIT_L(0); PG8_BAR; PG8_MMA(0, 0, At, B0); PG8_MMA(0, 1, At, B1); PG8_BAR; PG8_SCHED;
            PG8_LDA(At, 0, 1); PG8_STAGE(PG8_SB(0, 0), b2, voffB); PG8_STAGE(PG8_SB(0, 1), b2 + hstep, voffB); PG8_STAGE(PG8_SA(0, 0), a2, voffA);
            PG8_WAIT_V(8); PG8_WAIT_L(0); PG8_BAR; PG8_MMA(1, 0, At, B0); PG8_MMA(1, 1, At, B1); PG8_BAR; PG8_SCHED;
            PG8_LDB(B0, 1, 0); PG8_LDB(B1, 1, 1); PG8_SCHED; PG8_LDA(At, 1, 0); PG8_STAGE(PG8_SA(0, 1), a2 + hstep, voffA);
            PG8_WAIT_V(8); PG8_WAIT_L(0); PG8_BAR; PG8_MMA(0, 0, At, B0); PG8_MMA(0, 1, At, B1); PG8_BAR; PG8_SCHED;
            PG8_LDA(At, 1, 1); PG8_STAGE(PG8_SB(1, 0), b3, voffB); PG8_STAGE(PG8_SB(1, 1), b3 + hstep, voffB); PG8_STAGE(PG8_SA(1, 0), a3, voffA);
            PG8_WAIT_V(8); PG8_WAIT_L(0); PG8_BAR; PG8_MMA(1, 0, At, B0); PG8_MMA(1, 1, At, B1); PG8_BAR; PG8_SCHED;
            } else {
            PG8_LDB(B0, 0, 0); PG8_SCHED; PG8_LDA(At, 0, 0); PG8_STAGE(PG8_SA(1, 1), a1 + hstep, voffA);
            PG8_WAIT_L(8); PG8_BAR; PG8_WAIT_L(0); PG8_MMA(0, 0, At, B0); PG8_BAR; PG8_SCHED;
            PG8_LDB(B1, 0, 1); PG8_STAGE(PG8_SB(0, 0), b2, voffB);
            PG8_BAR; PG8_WAIT_L(0); PG8_MMA(0, 1, At, B1); PG8_BAR;
            PG8_LDA(At, 0, 1); PG8_STAGE(PG8_SA(0, 0), a2, voffA);
            PG8_BAR; PG8_WAIT_L(0); PG8_MMA(1, 0, At, B0); PG8_BAR; PG8_SCHED;
            PG8_STAGE(PG8_SB(0, 1), b2 + hstep, voffB);
            PG8_WAIT_V(6); PG8_BAR; PG8_MMA(1, 1, At, B1); PG8_BAR;
            PG8_LDB(B0, 1, 0); PG8_SCHED; PG8_LDA(At, 1, 0); PG8_STAGE(PG8_SA(0, 1), a2 + hstep, voffA);
            PG8_WAIT_L(8); PG8_BAR; PG8_WAIT_L(0); PG8_MMA(0, 0, At, B0); PG8_BAR; PG8_SCHED;
            PG8_LDB(B1, 1, 1); PG8_STAGE(PG8_SB(1, 0), b3, voffB);
            PG8_BAR; PG8_WAIT_L(0); PG8_MMA(0, 1, At, B1); PG8_BAR;
            PG8_LDA(At, 1, 1); PG8_STAGE(PG8_SA(1, 0), a3, voffA);
            PG8_BAR; PG8_WAIT_L(0); PG8_MMA(1, 0, At, B0); PG8_BAR; PG8_SCHED;
            PG8_STAGE(PG8_SB(1, 1), b3 + hstep, voffB);
            PG8_WAIT_V(6); PG8_BAR; PG8_MMA(1, 1, At, B1); PG8_BAR;
            }
        }
        if constexpr (ALIGN_EPI) { if (wr == 0) PG8_BAR; }
        if constexpr (!Epi::AFTER_DRAIN) { E(acc, cur, wr, wc, fr, fq); S.done(cur); }
        if (!has_next) break;
#pragma unroll
        for (int a = 0; a < 2; ++a)
#pragma unroll
            for (int b = 0; b < 2; ++b)
#pragma unroll
                for (int m = 0; m < 4; ++m)
#pragma unroll
                    for (int n = 0; n < 2; ++n) acc[a][b][m][n] = (f32x4){0.f, 0.f, 0.f, 0.f};
        cur = nxt; cA = nA; cB = nB; ++ui;
        if constexpr (ALIGN_EPI) { if (wr == 1) PG8_BAR; }
    }
    PG8_WAIT_V(0);
    if constexpr (!ALIGN_EPI) { if (wr == 0) PG8_BAR; }
    PG8_BAR;
    if constexpr (Epi::AFTER_DRAIN) { E.fused(acc, cur, wr, wc, fr, fq, lds, wid, lane); S.done(cur); }
#undef PG8_SA
#undef PG8_SB
#undef PG8_STAGE
#undef PG8_LDA
#undef PG8_LDB
#undef PG8_MMA
#undef PG8_WAIT_V
#undef PG8_WAIT_L
#undef PG8_BAR
#undef PG8_SCHED
}
}
using namespace pg8;
#define LAS __attribute__((address_space(3)))
typedef LAS unsigned char* ldsp;
typedef float f32x16 __attribute__((ext_vector_type(16)));
#define LDS_WAIT() asm volatile("s_waitcnt lgkmcnt(0)" ::: "memory")

constexpr int M_ALL = 16896;
constexpr int PLD = 3584;
constexpr size_t MiB = 1u << 20;
constexpr size_t WS_W0 = 2 * MiB, WS_WL = 32 * MiB;
constexpr size_t W_IN = 0, W_OUT = 7 * MiB, W_MQ = 9 * MiB, W_MO = 10 * MiB, W_1 = 11 * MiB, W_2 = 19 * MiB;
constexpr size_t WS_WMKV = 66 * MiB;
constexpr size_t WS_XB = 80 * MiB, WS_X = 128 * MiB, WS_SSQ = 196 * MiB, WS_MEMB = 198 * MiB, WS_MEMSSQ = 199 * MiB, WS_RSTD = 199 * MiB + 65536, WS_MEMRSTD = 199 * MiB + 196608;
constexpr size_t WS_PROJ = 256 * MiB, WS_OSB = 512 * MiB, WS_MIX = 560 * MiB, WS_DS = 608 * MiB, WS_DD = 672 * MiB;
constexpr size_t WS_QM = 688 * MiB, WS_OM = 720 * MiB, WS_H = 768 * MiB, WS_PART = 904 * MiB, WS_VT = 940 * MiB, WS_KB = 960 * MiB, WS_MKB = 980 * MiB, WS_MVT = 982 * MiB;
constexpr int LDS_BYTES = 147456;
constexpr size_t WS_BAR = 65536;
constexpr size_t WS_CTR = 65536 + 16384;
constexpr int LDS_BARST = 131072 + 1024;

__device__ __forceinline__ float wave_sum(float v) {
#pragma unroll
    for (int o = 1; o < 64; o <<= 1) v += __shfl_xor(v, o);
    return v;
}
typedef float f32x2_t __attribute__((ext_vector_type(2))); typedef __bf16 bf16x2_t __attribute__((ext_vector_type(2)));
__device__ __forceinline__ unsigned pk2(float lo, float hi) { const f32x2_t v = {lo, hi}; const bf16x2_t b = __builtin_convertvector(v, bf16x2_t); return __builtin_bit_cast(unsigned, b); }
__device__ __forceinline__ unsigned f2bf(float f) { return pk2(f, f) & 0xffffu; }
__device__ __forceinline__ bf16x8 pack8(float a, float b, float c, float d, float e, float f, float g, float h) { return __builtin_bit_cast(bf16x8, (u32x4){pk2(a, b), pk2(c, d), pk2(e, f), pk2(g, h)}); }
__device__ __forceinline__ float fexp(float x) { return __builtin_amdgcn_exp2f(x * 1.4426950408889634f); }
__device__ __forceinline__ float flog(float x) { return __builtin_amdgcn_logf(x) * 0.6931471805599453f; }
__device__ __forceinline__ int crow(int i, int hi) { return (i & 3) + 8 * (i >> 2) + 4 * hi; }
#define MFMA32(a, b, c) __builtin_amdgcn_mfma_f32_32x32x16_bf16((a), (b), (c), 0, 0, 0)
#define MFMA16(a, b, c) __builtin_amdgcn_mfma_f32_16x16x32_bf16((a), (b), (c), 0, 0, 0)

__device__ __forceinline__ void transpose_item(const float* W, int K, int N, bf16_t* WT, int row_off, const float* gain, LAS float* scr, int item, int lane) {
    const int nblk = N / 32, kb = item / nblk, nb = item % nblk, k0 = 64 * kb, n0 = 32 * nb;
    float wv[32], gv[32];
#pragma unroll
    for (int i = 0; i < 32; ++i) { const int kk = 2 * i + (lane >> 5); wv[i] = W[(size_t)(k0 + kk) * N + n0 + (lane & 31)]; gv[i] = gain ? gain[k0 + kk] : 1.f; }
#pragma unroll
    for (int i = 0; i < 32; ++i) { const int kk = 2 * i + (lane >> 5); scr[kk * 33 + (lane & 31)] = wv[i] * gv[i]; }
    LDS_WAIT(); asm volatile("" ::: "memory");
    const int c = lane & 7;
#pragma unroll
    for (int j = 0; j < 4; ++j) { const int n = (lane >> 3) + 8 * j; const LAS float* s = scr + (8 * c) * 33 + n;
        u32x4 o; o.x = pk2(s[0 * 33], s[1 * 33]); o.y = pk2(s[2 * 33], s[3 * 33]); o.z = pk2(s[4 * 33], s[5 * 33]); o.w = pk2(s[6 * 33], s[7 * 33]);
        *(u32x4*)(WT + (size_t)(row_off + n0 + n) * K + k0 + 8 * c) = o; }
    LDS_WAIT(); asm volatile("" ::: "memory");
}
__device__ __forceinline__ void row_prep2(const float* srcA, bf16_t* dstA, float* sqA, float* rsA, const float* srcB, bf16_t* dstB, float* sqB, float* rsB, bool hasB, int lane) {
    const f32x4* xa = (const f32x4*)srcA + lane; const f32x4* xb = (const f32x4*)srcB + lane; f32x4 va[4], vb[4]; float sa = 0.f, sb = 0.f;
#pragma unroll
    for (int j = 0; j < 4; ++j) { va[j] = xa[64 * j]; vb[j] = xb[64 * j]; }
#pragma unroll
    for (int j = 0; j < 4; ++j) { sa += (va[j][0] * va[j][0] + va[j][1] * va[j][1]) + (va[j][2] * va[j][2] + va[j][3] * va[j][3]); sb += (vb[j][0] * vb[j][0] + vb[j][1] * vb[j][1]) + (vb[j][2] * vb[j][2] + vb[j][3] * vb[j][3]); }
    sa = wave_sum(sa); sb = wave_sum(sb);
    u32x2* oa = (u32x2*)dstA + lane; u32x2* ob = (u32x2*)dstB + lane;
#pragma unroll
    for (int j = 0; j < 4; ++j) { u32x2 w; w.x = pk2(va[j][0], va[j][1]); w.y = pk2(va[j][2], va[j][3]); oa[64 * j] = w;
        if (hasB) { u32x2 w2; w2.x = pk2(vb[j][0], vb[j][1]); w2.y = pk2(vb[j][2], vb[j][3]); ob[64 * j] = w2; } }
    if (lane < 16) { sqA[lane] = lane == 0 ? sa : 0.f; if (hasB) sqB[lane] = lane == 0 ? sb : 0.f; }
    if (lane == 0) { *rsA = rsqrtf(sa * (1.0f / 1024.0f) + 1e-6f); if (hasB) *rsB = rsqrtf(sb * (1.0f / 1024.0f) + 1e-6f); }
}
template <bool SAMPLE> __device__ __forceinline__ void sb_item(int item, int layer, const float* PROJ, const float* KP, const float* VP, const float* KS, const float* VS,
                                        const float* CK, const float* CV, const bf16_t* VT, const bf16_t* KB, float* OSB, int lane) {
    const int r32 = lane & 31, hi = lane >> 5;
    int qrow, qpos, ptop, split, h, qmin; bool qvalid; const float *kA, *vA, *kB, *vB;
    const bf16_t* VTh = VT; const bf16_t* KBh = KB;
    if (!SAMPLE) { const int b = item >> 11, rem = item & 2047, qt = rem & 255; h = rem >> 8; VTh = VT + ((size_t)(b * 8 + h) * 2048 * 64 + r32) * 4; KBh = KB + ((size_t)(b * 8 + h) * 256 * 8 * 32 + hi * 32 + r32) * 8;
        qrow = b * 8192 + qt * 32 + r32; qpos = qt * 32 + r32; qvalid = true; ptop = qt * 32; split = 1 << 30; qmin = qt * 32;
        kA = KP + (size_t)(b * 8192) * 512 + h * 64; vA = VP + (size_t)(b * 8192) * 512 + h * 64; kB = kA; vB = vA;
    } else { const int it = item - 4096, s = it >> 3; h = it & 7;
        qrow = NPROMPT + s * 16 + (r32 & 15); qpos = 2048 + (r32 & 15); qvalid = r32 < 16; ptop = 2032; split = 2048; qmin = 2048;
        kA = CK + (size_t)((layer * 32 + s) * 2048) * 512 + h * 64; vA = CV + (size_t)((layer * 32 + s) * 2048) * 512 + h * 64;
        kB = KS + ((long)(s * 16) - 2048) * 512 + h * 64; vB = VS + ((long)(s * 16) - 2048) * 512 + h * 64; }
    bf16x8 qh[4];
    { const float* qp = PROJ + (size_t)qrow * PLD + h * 64 + 8 * hi;
#pragma unroll
      for (int ds = 0; ds < 4; ++ds) { const f32x4 a = *(const f32x4*)(qp + 16 * ds) * 0.125f, b = *(const f32x4*)(qp + 16 * ds + 4) * 0.125f; qh[ds] = pack8(a[0], a[1], a[2], a[3], b[0], b[1], b[2], b[3]); } }
    f32x16 oacc[2];
#pragma unroll
    for (int i = 0; i < 16; ++i) { oacc[0][i] = 0.f; oacc[1][i] = 0.f; }
    float carry = 0.f;
    f32x4 kraw[8]; float vraw[2][2][8]; u32x2 vpk[2][2][2]; bf16x8 kq[4];
#define SB_LOAD_TILE(P0) do { if (SAMPLE) { const int pr_ = (P0) + r32, prc_ = pr_ < 0 ? 0 : pr_; const float* kp_ = (prc_ >= split ? kB : kA) + (long)prc_ * 512 + 8 * hi; \
        _Pragma("unroll") for (int ds = 0; ds < 4; ++ds) { kraw[2 * ds] = *(const f32x4*)(kp_ + 16 * ds); kraw[2 * ds + 1] = *(const f32x4*)(kp_ + 16 * ds + 4); } } \
        else { const int pq_ = (P0) < 0 ? 0 : (P0); _Pragma("unroll") for (int ds = 0; ds < 4; ++ds) kq[ds] = *(const bf16x8*)(KBh + ((size_t)(pq_ >> 5) * 8 + 2 * ds) * 32 * 8); } \
        if (SAMPLE) { _Pragma("unroll") for (int t = 0; t < 2; ++t) _Pragma("unroll") for (int j = 0; j < 8; ++j) { const int pk_ = (P0) + 16 * t + 8 * (j >> 2) + 4 * hi + (j & 3), pkc_ = pk_ < 0 ? 0 : pk_; \
            const float* vp_ = (pkc_ >= split ? vB : vA) + (long)pkc_ * 512 + r32; vraw[t][0][j] = vp_[0]; vraw[t][1][j] = vp_[32]; } } \
        else { const int pc_ = (P0) < 0 ? 0 : (P0); _Pragma("unroll") for (int t = 0; t < 2; ++t) _Pragma("unroll") for (int dt = 0; dt < 2; ++dt) { const bf16_t* vq_ = VTh + ((size_t)((pc_ >> 2) + 4 * t + hi) * 64 + dt * 32) * 4; \
            vpk[t][dt][0] = *(const u32x2*)vq_; vpk[t][dt][1] = *(const u32x2*)(vq_ + 2 * 64 * 4); } } } while (0)
    SB_LOAD_TILE(ptop);
    for (int p0 = ptop; p0 > -32; p0 -= 32) {
        bf16x8 kf[4], va[2][2];
#pragma unroll
        for (int ds = 0; ds < 4; ++ds) { if (SAMPLE) kf[ds] = pack8(kraw[2 * ds][0], kraw[2 * ds][1], kraw[2 * ds][2], kraw[2 * ds][3], kraw[2 * ds + 1][0], kraw[2 * ds + 1][1], kraw[2 * ds + 1][2], kraw[2 * ds + 1][3]); else kf[ds] = kq[ds]; }
#pragma unroll
        for (int t = 0; t < 2; ++t)
#pragma unroll
            for (int dt = 0; dt < 2; ++dt) { if (SAMPLE) va[t][dt] = pack8(vraw[t][dt][0], vraw[t][dt][1], vraw[t][dt][2], vraw[t][dt][3], vraw[t][dt][4], vraw[t][dt][5], vraw[t][dt][6], vraw[t][dt][7]);
                else va[t][dt] = __builtin_bit_cast(bf16x8, (u32x4){vpk[t][dt][0].x, vpk[t][dt][0].y, vpk[t][dt][1].x, vpk[t][dt][1].y}); }
        SB_LOAD_TILE(p0 - 32);
        asm volatile("" ::: "memory");
        f32x16 acc;
#pragma unroll
        for (int i = 0; i < 16; ++i) acc[i] = 0.f;
#pragma unroll
        for (int ds = 0; ds < 4; ++ds) acc = MFMA32(kf[ds], qh[ds], acc);
        float L[16], ls[16];
        if (p0 >= 0 && p0 + 32 <= qmin) {
#pragma unroll
            for (int i = 0; i < 16; ++i) { const float z = acc[i]; const float sp = fmaxf(z, 0.f) + flog(1.f + fexp(-fabsf(z))); L[i] = -sp; ls[i] = z - sp; }
        } else {
#pragma unroll
            for (int i = 0; i < 16; ++i) { const int kpos = p0 + crow(i, hi); const bool valid = (kpos < qpos) && (kpos >= 0); const float z = acc[i];
                const float sp = fmaxf(z, 0.f) + flog(1.f + fexp(-fabsf(z)));
                L[i] = valid ? -sp : 0.f; ls[i] = valid ? (z - sp) : -1e30f; }
        }
        float G[4], PG[4], T[4];
#pragma unroll
        for (int g = 0; g < 4; ++g) { G[g] = (L[4 * g] + L[4 * g + 1]) + (L[4 * g + 2] + L[4 * g + 3]); PG[g] = __shfl_xor(G[g], 32); T[g] = G[g] + PG[g]; }
        float A[4]; A[3] = 0.f; A[2] = T[3]; A[1] = T[3] + T[2]; A[0] = A[1] + T[1];
        float P[16];
#pragma unroll
        for (int g = 0; g < 4; ++g) { const float e3 = carry + A[g] + (hi == 0 ? PG[g] : 0.f), e2 = e3 + L[4 * g + 3], e1 = e2 + L[4 * g + 2], e0 = e1 + L[4 * g + 1];
            P[4 * g + 3] = fexp(ls[4 * g + 3] + e3); P[4 * g + 2] = fexp(ls[4 * g + 2] + e2); P[4 * g + 1] = fexp(ls[4 * g + 1] + e1); P[4 * g] = fexp(ls[4 * g] + e0); }
        carry += (T[0] + T[1]) + (T[2] + T[3]);
#pragma unroll
        for (int t = 0; t < 2; ++t) { const bf16x8 pb = pack8(P[8 * t], P[8 * t + 1], P[8 * t + 2], P[8 * t + 3], P[8 * t + 4], P[8 * t + 5], P[8 * t + 6], P[8 * t + 7]);
            oacc[0] = MFMA32(va[t][0], pb, oacc[0]); oacc[1] = MFMA32(va[t][1], pb, oacc[1]); }
        if (__all(carry < -110.0f)) break;
    }
    if (qvalid) { float* op = OSB + (size_t)qrow * 512 + h * 64 + 4 * hi;
#pragma unroll
        for (int dt = 0; dt < 2; ++dt)
#pragma unroll
            for (int g = 0; g < 4; ++g) *(f32x4*)(op + dt * 32 + 8 * g) = (f32x4){oacc[dt][4 * g], oacc[dt][4 * g + 1], oacc[dt][4 * g + 2], oacc[dt][4 * g + 3]}; }
}

__device__ __forceinline__ void hg_load(const float* PROJ, int row0, int tvalid, int h, int tg, int k, int coff, float (&zr)[16]) {
#pragma unroll
    for (int j = 0; j < 16; ++j) { const int t = 16 * tg + j, tc = t < tvalid ? t : 0; zr[j] = PROJ[(size_t)(row0 + tc) * PLD + coff + h * 128 + k]; }
}
__device__ __forceinline__ void hg_prep(const float (&zr)[16], const float (&qr)[16], int tvalid, float lbv, int tg, float (&loc)[16], float (&kk)[16], float (&qv)[16]) {
    float run = 0.f;
#pragma unroll
    for (int j = 0; j < 16; ++j) { const int t = 16 * tg + j; const bool ok = t < tvalid; const float z = ok ? zr[j] : 0.f, q = ok ? qr[j] : 0.f;
        const float ez = fexp(-fabsf(z)), inv = __builtin_amdgcn_rcpf(1.f + ez);
        const float sig = z >= 0.f ? inv : ez * inv, nsig = z >= 0.f ? ez * inv : inv;
        float lf = (lbv > 0.f) ? flog(lbv + (1.f - lbv) * sig) : (fminf(z, 0.f) - flog(1.f + ez));
        if (!ok) lf = 0.f;
        run += lf; loc[j] = run; kk[j] = ok ? (1.f - lbv) * nsig : 0.f; qv[j] = q * 0.08838834764831845f; }
}
__device__ __forceinline__ void hg_h1(ldsp lds, const float* PROJ, const float (&zr)[16], int row0, int tvalid, int h, float lbv, float* dsOut, float* ddOut, const float* s0, int tid, int lane, int wave) {
    const int tg = tid >> 7, k = tid & 127;
    float loc[16], kk[16], qv[16], iv[16];
#pragma unroll
    for (int j = 0; j < 16; ++j) { const int ta = 16 * tg + j, tc = ta < tvalid ? ta : 0; const float x = PROJ[(size_t)(row0 + tc) * PLD + 2560 + h * 128 + k]; iv[j] = ta < tvalid ? x : 0.f; }
    hg_prep(zr, zr, tvalid, lbv, tg, loc, kk, qv);
    LAS float* TOT = (LAS float*)lds; LAS float* DK = (LAS float*)(lds + 2048);
    TOT[tg * 128 + k] = loc[15];
    __syncthreads();
    const float t0 = TOT[k], t1 = TOT[128 + k], t2 = TOT[256 + k], t3 = TOT[384 + k];
    const float r1 = t0, r2 = r1 + t1, r3 = r2 + t2, r4 = r3 + t3;
    const float rtg = tg == 0 ? 0.f : (tg == 1 ? r1 : (tg == 2 ? r2 : r3));
    { unsigned w[8];
#pragma unroll
      for (int jj = 0; jj < 8; ++jj) w[jj] = pk2(kk[2 * jj] * fexp(r4 - rtg - loc[2 * jj]), kk[2 * jj + 1] * fexp(r4 - rtg - loc[2 * jj + 1]));
      *(LAS u32x4*)(lds + 4096 + k * 144 + tg * 32) = (u32x4){w[0], w[1], w[2], w[3]}; *(LAS u32x4*)(lds + 4096 + k * 144 + tg * 32 + 16) = (u32x4){w[4], w[5], w[6], w[7]};
#pragma unroll
      for (int jj = 0; jj < 8; ++jj) w[jj] = pk2(iv[2 * jj], iv[2 * jj + 1]);
      *(LAS u32x4*)(lds + 22528 + k * 144 + tg * 32) = (u32x4){w[0], w[1], w[2], w[3]}; *(LAS u32x4*)(lds + 22528 + k * 144 + tg * 32 + 16) = (u32x4){w[4], w[5], w[6], w[7]}; }
    if (tg == 0) { const float dk = fexp(r4); DK[k] = dk; if (ddOut) ddOut[k] = dk; }
    __syncthreads();
    const int r32 = lane & 31, hi = lane >> 5, km = wave & 3, vn0 = (wave >> 2) * 2;
#pragma unroll
    for (int vv = 0; vv < 2; ++vv) { f32x16 acc;
#pragma unroll
        for (int i = 0; i < 16; ++i) acc[i] = 0.f;
#pragma unroll
        for (int ks = 0; ks < 4; ++ks) { const bf16x8 a = *(LAS bf16x8*)(lds + 4096 + (32 * km + r32) * 144 + ks * 32 + hi * 16);
            const bf16x8 b = *(LAS bf16x8*)(lds + 22528 + (32 * (vn0 + vv) + r32) * 144 + ks * 32 + hi * 16); acc = MFMA32(a, b, acc); }
        const int v = 32 * (vn0 + vv) + r32;
#pragma unroll
        for (int i = 0; i < 16; ++i) { if (s0) { const int kr = 32 * km + crow(i, hi); dsOut[kr * 128 + v] = acc[i] + DK[kr] * s0[kr * 128 + v]; } }
        if (!s0) { bf16_t* db = (bf16_t*)dsOut + v * 128 + 32 * km + 4 * hi;
#pragma unroll
            for (int g = 0; g < 4; ++g) *(u32x2*)(db + 8 * g) = (u32x2){pk2(acc[4 * g], acc[4 * g + 1]), pk2(acc[4 * g + 2], acc[4 * g + 3])}; } }
    __syncthreads();
}
__device__ __forceinline__ void hg_h3(ldsp lds, const float* PROJ, const float (&zr)[16], int row0, int tvalid, int h, float lbv, const float* Ssrc, bool sbf, const float* hgain, bf16_t* MIX, int tid, int lane, int wave) {
    constexpr int QE = 2048, KE = 19456, ST = 62976, IV = 97792, PM = 116224, OST = 19456;
    const int tg = tid >> 7, k = tid & 127;
    float loc[16], kk[16], qv[16];
    f32x4 gv[4], gav[4];
    float qr[16]; hg_load(PROJ, row0, tvalid, h, tg, k, 1536, qr);
    hg_prep(zr, qr, tvalid, lbv, tg, loc, kk, qv);
    LAS float* TOT = (LAS float*)lds;
    TOT[tg * 128 + k] = loc[15];
    for (int i = tid; i < 2304; i += 512) ((LAS unsigned*)(lds + PM))[i] = 0u;
    if (sbf) {
#pragma unroll
        for (int jj = 0; jj < 4; ++jj) { const int cidx = tid + 512 * jj, v = cidx >> 4, kc = cidx & 15;
            *(LAS u32x4*)(lds + ST + v * 272 + kc * 16) = *(const u32x4*)((const bf16_t*)Ssrc + v * 128 + kc * 8); }
    } else {
#pragma unroll
        for (int jj = 0; jj < 16; ++jj) { const int kp = 2 * ((tid >> 7) + 4 * jj), v = tid & 127;
            *(LAS unsigned*)(lds + ST + v * 272 + kp * 2) = pk2(Ssrc[kp * 128 + v], Ssrc[(kp + 1) * 128 + v]); } }
    { unsigned w[8];
#pragma unroll
      for (int jj = 0; jj < 8; ++jj) { const int ta = 16 * tg + 2 * jj, t0 = ta < tvalid ? ta : 0, t1 = (ta + 1) < tvalid ? ta + 1 : 0;
          const float x0 = PROJ[(size_t)(row0 + t0) * PLD + 2560 + h * 128 + k], x1 = PROJ[(size_t)(row0 + t1) * PLD + 2560 + h * 128 + k];
          w[jj] = pk2(ta < tvalid ? x0 : 0.f, (ta + 1) < tvalid ? x1 : 0.f); }
      *(LAS u32x4*)(lds + IV + k * 144 + tg * 32) = (u32x4){w[0], w[1], w[2], w[3]}; *(LAS u32x4*)(lds + IV + k * 144 + tg * 32 + 16) = (u32x4){w[4], w[5], w[6], w[7]}; }
    __syncthreads();
    { const int t = tid >> 3, v0 = (tid & 7) * 16; const int tc = t < tvalid ? t : 0; const float* gp = PROJ + (size_t)(row0 + tc) * PLD + 3072 + h * 128 + v0; const float* hg = hgain + h * 128 + v0;
#pragma unroll
      for (int c = 0; c < 4; ++c) { gv[c] = *(const f32x4*)(gp + 4 * c); gav[c] = *(const f32x4*)(hg + 4 * c); } }
    const float t0 = TOT[k], t1 = TOT[128 + k], t2 = TOT[256 + k];
    const float r1 = t0, r2 = r1 + t1, r3 = r2 + t2;
    const float rtg = tg == 0 ? 0.f : (tg == 1 ? r1 : (tg == 2 ? r2 : r3));
#pragma unroll
    for (int j = 0; j < 16; ++j) *(LAS unsigned short*)(lds + QE + (16 * tg + j) * 272 + k * 2) = (unsigned short)f2bf(qv[j] * fexp(loc[j]));
#pragma unroll
    for (int i = 0; i < 4; ++i) { if (i >= tg) { const float ri = i == 0 ? 0.f : (i == 1 ? r1 : (i == 2 ? r2 : r3)); const int rb = 8 * i * (i + 1);
#pragma unroll
        for (int j = 0; j < 16; ++j) *(LAS unsigned short*)(lds + KE + (rb + 16 * tg + j) * 272 + k * 2) = (unsigned short)f2bf(kk[j] * fexp(fminf(ri - rtg - loc[j], 80.f))); } }
    __syncthreads();
    { const int c16 = lane & 15, q4 = lane >> 4;
      for (int tix = wave; tix < 10; tix += 8) { const int i = tix < 1 ? 0 : (tix < 3 ? 1 : (tix < 6 ? 2 : 3)), j = tix - i * (i + 1) / 2, rb = 8 * i * (i + 1);
          f32x4 acc = {0.f, 0.f, 0.f, 0.f};
#pragma unroll
          for (int ks = 0; ks < 4; ++ks) { const bf16x8 a = *(LAS bf16x8*)(lds + QE + (16 * i + c16) * 272 + ks * 64 + q4 * 16);
              const bf16x8 b = *(LAS bf16x8*)(lds + KE + (rb + 16 * j + c16) * 272 + ks * 64 + q4 * 16); acc = MFMA16(a, b, acc); }
#pragma unroll
          for (int ii = 0; ii < 4; ++ii) { const int tl = 4 * q4 + ii; float pv = acc[ii]; if (i == j && c16 > tl) pv = 0.f;
              *(LAS unsigned short*)(lds + PM + (16 * i + tl) * 144 + (16 * j + c16) * 2) = (unsigned short)f2bf(pv); } } }
    __syncthreads();
#pragma unroll
    for (int j = 0; j < 16; ++j) *(LAS unsigned short*)(lds + QE + (16 * tg + j) * 272 + k * 2) = (unsigned short)f2bf(qv[j] * fexp(rtg + loc[j]));
    __syncthreads();
    { const int r32 = lane & 31, hi = lane >> 5, tm = wave & 1, vn = wave >> 1; f32x16 acc;
#pragma unroll
      for (int i = 0; i < 16; ++i) acc[i] = 0.f;
#pragma unroll
      for (int ks = 0; ks < 8; ++ks) { const bf16x8 a = *(LAS bf16x8*)(lds + QE + (32 * tm + r32) * 272 + ks * 32 + hi * 16);
          const bf16x8 b = *(LAS bf16x8*)(lds + ST + (32 * vn + r32) * 272 + ks * 32 + hi * 16); acc = MFMA32(a, b, acc); }
#pragma unroll
      for (int ks = 0; ks < 4; ++ks) { const bf16x8 a = *(LAS bf16x8*)(lds + PM + (32 * tm + r32) * 144 + ks * 32 + hi * 16);
          const bf16x8 b = *(LAS bf16x8*)(lds + IV + (32 * vn + r32) * 144 + ks * 32 + hi * 16); acc = MFMA32(a, b, acc); }
#pragma unroll
      for (int i = 0; i < 16; ++i) *(LAS float*)(lds + OST + (32 * tm + crow(i, hi)) * 528 + (32 * vn + r32) * 4) = acc[i]; }
    __syncthreads();
    { const int t = tid >> 3, v0 = (tid & 7) * 16; f32x4 o[4]; float ss = 0.f;
#pragma unroll
      for (int c = 0; c < 4; ++c) { o[c] = *(LAS f32x4*)(lds + OST + t * 528 + (v0 + 4 * c) * 4); ss += (o[c][0] * o[c][0] + o[c][1] * o[c][1]) + (o[c][2] * o[c][2] + o[c][3] * o[c][3]); }
      ss += __shfl_xor(ss, 1); ss += __shfl_xor(ss, 2); ss += __shfl_xor(ss, 4);
      const float rs = rsqrtf(ss * (1.0f / 128.0f) + 1e-6f);
      if (t < tvalid) { const size_t row = (size_t)(row0 + t); unsigned w[8];
#pragma unroll
          for (int c = 0; c < 4; ++c) { const f32x4 g = gv[c], ga = gav[c]; f32x4 r;
#pragma unroll
              for (int e = 0; e < 4; ++e) r[e] = o[c][e] * rs * ga[e] * (g[e] * __builtin_amdgcn_rcpf(1.f + fexp(-g[e])));
              w[2 * c] = pk2(r[0], r[1]); w[2 * c + 1] = pk2(r[2], r[3]); }
          bf16_t* mp = MIX + row * 1024 + 512 + h * 128 + v0;
          *(u32x4*)mp = (u32x4){w[0], w[1], w[2], w[3]}; *(u32x4*)(mp + 8) = (u32x4){w[4], w[5], w[6], w[7]}; } }
    __syncthreads();
}

__device__ __forceinline__ void xattn_item(ldsp lds, const bf16_t* QM, const float* Kg, const float* Vg, const bf16_t* Kb, const bf16_t* Vtb, int row0, int tvalid, int hm, bf16_t* OM, int tid, int lane, int wave) {
    constexpr int KM = 0, QS = 69632, PMX = 87040, RMO = 120832, RSO = 121344, VT = 0;
    if (Kb) {
#pragma unroll
        for (int jj = 0; jj < 8; ++jj) { const int cidx = tid + 512 * jj, m = cidx >> 4, dc = cidx & 15; *(LAS u32x4*)(lds + KM + m * 272 + dc * 16) = *(const u32x4*)(Kb + m * 128 + dc * 8); }
    } else {
#pragma unroll
        for (int jj = 0; jj < 8; ++jj) { const int cidx = tid + 512 * jj, m = cidx >> 4, dc = cidx & 15; const float* p = Kg + (size_t)m * 512 + dc * 8;
            const f32x4 a = *(const f32x4*)p, b = *(const f32x4*)(p + 4);
            *(LAS u32x4*)(lds + KM + m * 272 + dc * 16) = (u32x4){pk2(a[0], a[1]), pk2(a[2], a[3]), pk2(b[0], b[1]), pk2(b[2], b[3])}; } }
#pragma unroll
    for (int jj = 0; jj < 2; ++jj) { const int cidx = tid + 512 * jj, t = cidx >> 4, dc = cidx & 15; u32x4 w = {0u, 0u, 0u, 0u};
        if (t < tvalid) w = *(const u32x4*)(QM + (size_t)(row0 + t) * 512 + hm * 128 + dc * 8);
        *(LAS u32x4*)(lds + QS + t * 272 + dc * 16) = w; }
    float vr0[32], vr1[32]; u32x4 vq[8];
    if (Vtb) {
#pragma unroll
        for (int jj = 0; jj < 8; ++jj) { const int cidx = tid + 512 * jj, d = cidx >> 5, mc = cidx & 31; vq[jj] = *(const u32x4*)(Vtb + d * 256 + mc * 8); }
    } else {
#pragma unroll
        for (int jj = 0; jj < 32; ++jj) { const int idx = tid + 512 * jj, d = idx & 127, mp = idx >> 7; vr0[jj] = Vg[(size_t)(2 * mp) * 512 + d]; vr1[jj] = Vg[(size_t)(2 * mp + 1) * 512 + d]; } }
    __syncthreads();
    const int tgp = wave & 3, mh = wave >> 2, c16 = lane & 15, q4 = lane >> 4, tok = 16 * tgp + c16;
    LAS float* RM = (LAS float*)(lds + RMO); LAS float* RS = (LAS float*)(lds + RSO);
    f32x4 sacc[8];
    { bf16x8 bq[4];
#pragma unroll
      for (int ks = 0; ks < 4; ++ks) bq[ks] = *(LAS bf16x8*)(lds + QS + tok * 272 + ks * 64 + q4 * 16);
#pragma unroll
      for (int j = 0; j < 8; ++j) { f32x4 acc = {0.f, 0.f, 0.f, 0.f};
#pragma unroll
          for (int ks = 0; ks < 4; ++ks) { const bf16x8 a = *(LAS bf16x8*)(lds + KM + (128 * mh + 16 * j + c16) * 272 + ks * 64 + q4 * 16); acc = MFMA16(a, bq[ks], acc); }
          sacc[j] = acc; } }
    float mx = -3.0e38f;
#pragma unroll
    for (int j = 0; j < 8; ++j) mx = fmaxf(fmaxf(mx, fmaxf(sacc[j][0], sacc[j][1])), fmaxf(sacc[j][2], sacc[j][3]));
    mx = fmaxf(mx, __shfl_xor(mx, 16)); mx = fmaxf(mx, __shfl_xor(mx, 32));
    if (q4 == 0) RM[mh * 64 + tok] = mx;
    __syncthreads();
    { const float m = fmaxf(RM[tok], RM[64 + tok]); float sum = 0.f;
#pragma unroll
      for (int j = 0; j < 8; ++j) { const float p0 = fexp(sacc[j][0] - m), p1 = fexp(sacc[j][1] - m), p2 = fexp(sacc[j][2] - m), p3 = fexp(sacc[j][3] - m);
          sum += (p0 + p1) + (p2 + p3);
          *(LAS u32x2*)(lds + PMX + tok * 528 + (128 * mh + 16 * j + 4 * q4) * 2) = (u32x2){pk2(p0, p1), pk2(p2, p3)}; }
      sum += __shfl_xor(sum, 16); sum += __shfl_xor(sum, 32);
      if (q4 == 0) RS[mh * 64 + tok] = sum; }
    __syncthreads();
    if (Vtb) {
#pragma unroll
        for (int jj = 0; jj < 8; ++jj) { const int cidx = tid + 512 * jj, d = cidx >> 5, mc = cidx & 31; *(LAS u32x4*)(lds + VT + d * 528 + mc * 16) = vq[jj]; }
    } else {
#pragma unroll
        for (int jj = 0; jj < 32; ++jj) { const int idx = tid + 512 * jj, d = idx & 127, mp = idx >> 7;
            *(LAS unsigned*)(lds + VT + d * 528 + mp * 4) = pk2(vr0[jj], vr1[jj]); } }
    __syncthreads();
    { const int r32 = lane & 31, hi = lane >> 5, tm = wave & 1, dn = wave >> 1; f32x16 acc;
#pragma unroll
      for (int i = 0; i < 16; ++i) acc[i] = 0.f;
#pragma unroll
      for (int ks = 0; ks < 16; ++ks) { const bf16x8 a = *(LAS bf16x8*)(lds + PMX + (32 * tm + r32) * 528 + ks * 32 + hi * 16);
          const bf16x8 b = *(LAS bf16x8*)(lds + VT + (32 * dn + r32) * 528 + ks * 32 + hi * 16); acc = MFMA32(a, b, acc); }
#pragma unroll
      for (int i = 0; i < 16; ++i) { const int tk = 32 * tm + crow(i, hi); const float inv = __builtin_amdgcn_rcpf(RS[tk] + RS[64 + tk]);
          if (tk < tvalid) OM[(size_t)(row0 + tk) * 512 + hm * 128 + 32 * dn + r32] = (bf16_t)f2bf(acc[i] * inv); } }
    __syncthreads();
}
#define XB_TMO      128
#define XB_XCNT(j)  (256  + 64 * (j))
#define XB_XSUB(j)  (1280 + 64 * (j))
#define XB_XGEN(j)  (2304 + 64 * (j))
#define XB_TOP      3328
#define XB_TOPGEN   3392
#define XCD_BAR_WORDS 3456
#define XB_SPIN_CAP (1u << 18)

__device__ __forceinline__ unsigned xb_ld(unsigned* p)              { return __hip_atomic_load(p, __ATOMIC_RELAXED, __HIP_MEMORY_SCOPE_AGENT); }
__device__ __forceinline__ unsigned xb_add(unsigned* p, unsigned v) { return __hip_atomic_fetch_add(p, v, __ATOMIC_RELAXED, __HIP_MEMORY_SCOPE_AGENT); }
__device__ __forceinline__ unsigned xb_xcc_id() { return (unsigned)__builtin_amdgcn_s_getreg((3 << 11) | 20) & 0xFu; }
#define XB_SPIN(cond, bar) do { unsigned _sp = 0; while (cond) { __builtin_amdgcn_s_sleep(1); \
    if ((++_sp & 255u) == 0u) { if (xb_ld(&(bar)[XB_TMO])) break; if (_sp > XB_SPIN_CAP) { atomicAdd(&(bar)[XB_TMO], 1u); break; } } } } while (0)

struct XcdBarrier {
    unsigned* bar; unsigned x;
    volatile LAS unsigned* st;
};

__device__ __forceinline__ XcdBarrier xcd_barrier_post(unsigned* bar, volatile LAS unsigned* st) {
    XcdBarrier b; b.bar = bar; b.x = xb_xcc_id(); b.st = st;
    if (threadIdx.x == 0) (void)xb_add(&bar[XB_XCNT(b.x)], 1u);
    return b;
}
__device__ __forceinline__ void xcd_barrier_complete(unsigned* bar, unsigned x, unsigned& nloc, unsigned& nx) {
    const unsigned G = gridDim.x * gridDim.y * gridDim.z;
    unsigned sum, cnt, mine, sp = 0u;
    for (;;) {
        sum = 0u; cnt = 0u; mine = 0u;
#pragma unroll
        for (unsigned j = 0; j < 16; ++j) { const unsigned c = xb_ld(&bar[XB_XCNT(j)]); sum += c; cnt += (c > 0u) ? 1u : 0u; mine = (j == x) ? c : mine; }
        if (sum == G) break;
        __builtin_amdgcn_s_sleep(1);
        if ((++sp & 255u) == 0u) { if (xb_ld(&bar[XB_TMO])) break; if (sp > XB_SPIN_CAP) { atomicAdd(&bar[XB_TMO], 1u); break; } }
    }
    nloc = mine > 0u ? mine : 1u; nx = cnt > 0u ? cnt : 1u;
}

__device__ __forceinline__ void xcd_barrier(const XcdBarrier& b) {
    asm volatile("s_waitcnt vmcnt(0)" ::: "memory");
    __syncthreads();
    if (threadIdx.x == 0) {
        unsigned* bar = b.bar;
        __builtin_amdgcn_s_waitcnt(0);
        unsigned nloc = b.st[0], nx = b.st[1];
        if (nloc == 0u) { xcd_barrier_complete(bar, b.x, nloc, nx); b.st[0] = nloc; b.st[1] = nx; }
        const unsigned old = xb_add(&bar[XB_XSUB(b.x)], 1u);
        const unsigned gen = old / nloc;
        if (old + 1u == (gen + 1u) * nloc) {
            __builtin_amdgcn_fence(__ATOMIC_RELEASE, "agent");
            asm volatile("s_waitcnt vmcnt(0)" ::: "memory");
            const unsigned og = xb_add(&bar[XB_TOP], 1u);
            const unsigned tg = og / nx;
            if (og + 1u == (tg + 1u) * nx) xb_add(&bar[XB_TOPGEN], 1u);
            else XB_SPIN(xb_ld(&bar[XB_TOPGEN]) == tg, bar);
            __builtin_amdgcn_fence(__ATOMIC_ACQUIRE, "agent");
            xb_add(&bar[XB_XGEN(b.x)], 1u);
            asm volatile("s_waitcnt vmcnt(0)" ::: "memory");
        } else {
            XB_SPIN(xb_ld(&bar[XB_XGEN(b.x)]) == gen, bar);
            __builtin_amdgcn_fence(__ATOMIC_ACQUIRE, "agent");
            asm volatile("s_waitcnt vmcnt(0)" ::: "memory");
        }
    }
    __syncthreads();
}

__device__ __forceinline__ const float* gptr_(unsigned long long v) { return (const float*)(const __attribute__((address_space(1))) float*)v; }
#define GPTR(p) gptr_(p)
#define FPTR(p) ((const float*)(p))
#define OPQ(x) asm volatile("" : "+s"(x))
#define OPQP(T, x) do { unsigned long long xi_ = (unsigned long long)(x); asm volatile("" : "+s"(xi_)); x = (T*)(__attribute__((address_space(1))) T*)xi_; } while (0)
struct Args { const float* in[24]; float* out; unsigned char* ws; };
__global__ void __launch_bounds__(512, 2) mega_fwd(Args args) {
    extern __shared__ __attribute__((aligned(16))) unsigned char lds_raw[];
    cg::grid_group grid = cg::this_grid();
    ldsp lds = (ldsp)lds_raw;
    unsigned char* const ws = args.ws; float* const out = args.out;
#define WAVE_IDS int tid = threadIdx.x; asm volatile("" : "+v"(tid)); const int lane = tid & 63, wave = __builtin_amdgcn_readfirstlane(tid >> 6), G = gridDim.x, bid = blockIdx.x, gw = bid * 8 + wave, NGW = G * 8; (void)lane; (void)gw; (void)NGW

    {
        WAVE_IDS;
        if (bid == 0) for (int i = tid; i < XCD_BAR_WORDS; i += 512) ((unsigned*)(ws + WS_BAR))[i] = 0u;
        if (bid == 0 && tid < 8) ((unsigned*)(ws + WS_CTR))[tid] = 0u;
        if (tid < 2) ((LAS unsigned*)(lds + LDS_BARST))[tid] = 0u;
        if (bid == 0 && tid == 0) { const float** tab = (const float**)ws;
#pragma unroll
            for (int i = 0; i < 24; ++i) tab[i] = args.in[i]; }
        bf16_t* XB = (bf16_t*)(ws + WS_XB); float* SSQ = (float*)(ws + WS_SSQ); bf16_t* MEMB = (bf16_t*)(ws + WS_MEMB); float* MEMSSQ = (float*)(ws + WS_MEMSSQ); bf16_t* WMKV = (bf16_t*)(ws + WS_WMKV);
        LAS float* scr = (LAS float*)(lds + wave * 16384);
#define CONV_ITEM(PTR, L_, R_, WSB) do { const int l = (L_); int r = (R_); unsigned char* wl = (WSB) + WS_W0 + (size_t)l * WS_WL; bf16_t* wmkv = (bf16_t*)((WSB) + WS_WMKV); \
            if (r < 1792) { transpose_item(PTR(10) + (size_t)l * 1024 * 3584, 1024, 3584, (bf16_t*)(wl + W_IN), 0, PTR(9) + l * 1024, scr, r, lane); break; } r -= 1792; \
            if (r < 512)  { transpose_item(PTR(13) + (size_t)l * 1024 * 1024, 1024, 1024, (bf16_t*)(wl + W_OUT), 0, nullptr, scr, r, lane); break; } r -= 512; \
            if (r < 256)  { transpose_item(PTR(16) + (size_t)l * 1024 * 512, 1024, 512, (bf16_t*)(wl + W_MQ), 0, PTR(14) + l * 1024, scr, r, lane); break; } r -= 256; \
            if (r < 256)  { transpose_item(PTR(17) + (size_t)l * 1024 * 512, 1024, 512, wmkv + (size_t)l * 1024 * 1024, 0, PTR(15) + l * 1024, scr, r, lane); break; } r -= 256; \
            if (r < 256)  { transpose_item(PTR(18) + (size_t)l * 1024 * 512, 1024, 512, wmkv + (size_t)l * 1024 * 1024, 512, PTR(15) + l * 1024, scr, r, lane); break; } r -= 256; \
            if (r < 256)  { transpose_item(PTR(19) + (size_t)l * 512 * 1024, 512, 1024, (bf16_t*)(wl + W_MO), 0, nullptr, scr, r, lane); break; } r -= 256; \
            if (r < 2048) { transpose_item(PTR(21) + (size_t)l * 1024 * 4096, 1024, 4096, (bf16_t*)(wl + W_1), 0, PTR(20) + l * 1024, scr, r, lane); break; } r -= 2048; \
            transpose_item(PTR(22) + (size_t)l * 4096 * 1024, 4096, 1024, (bf16_t*)(wl + W_2), 0, nullptr, scr, r, lane); } while (0)
#define ARGP(i) args.in[i]
        const bool defer = (G == 256);
        for (int it = gw; it < (defer ? 3328 + 512 : 14848); it += NGW) {
            if (defer) { if (it < 3328) CONV_ITEM(ARGP, 0, it, ws); else CONV_ITEM(ARGP, 1, 2560 + (it - 3328), ws); }
            else { if (it < 7424) CONV_ITEM(ARGP, 0, it, ws); else CONV_ITEM(ARGP, 1, it - 7424, ws); } }
#undef ARGP
#define ROW_PTRS(m, S, D, Q, R) do { if ((m) < NPROMPT) { S = args.in[0] + (size_t)(m) * 1024; D = XB + (size_t)(m) * 1024; Q = SSQ + (size_t)(m) * 16; R = (float*)(ws + WS_RSTD) + (m); } \
            else if ((m) < M_ALL) { S = args.in[1] + (size_t)((m) - NPROMPT) * 1024; D = XB + (size_t)(m) * 1024; Q = SSQ + (size_t)(m) * 16; R = (float*)(ws + WS_RSTD) + (m); } \
            else { S = args.in[2] + (size_t)((m) - M_ALL) * 1024; D = MEMB + (size_t)((m) - M_ALL) * 1024; Q = MEMSSQ + (size_t)((m) - M_ALL) * 16; R = (float*)(ws + WS_MEMRSTD) + ((m) - M_ALL); } } while (0)
        for (int m0 = gw; m0 < M_ALL + 512; m0 += 2 * NGW) { const bool hasB = m0 + NGW < M_ALL + 512; const int m1 = hasB ? m0 + NGW : m0;
            const float *sA, *sB; bf16_t *dA, *dB; float *qA, *qB, *rA, *rB;
            ROW_PTRS(m0, sA, dA, qA, rA); ROW_PTRS(m1, sB, dB, qB, rB);
            row_prep2(sA, dA, qA, rA, sB, dB, qB, rB, hasB, lane); }
#undef ROW_PTRS
    }
    grid.sync();
    (void)xcd_barrier_post((unsigned*)(ws + WS_BAR), (volatile LAS unsigned*)(lds + LDS_BARST));
#define GRID_BAR() do { XcdBarrier b_; b_.bar = (unsigned*)(ws + WS_BAR); b_.x = xb_xcc_id(); b_.st = (volatile LAS unsigned*)(lds + LDS_BARST); xcd_barrier(b_); } while (0)

#pragma nounroll
    for (int l = 0; l < 2; ++l) {
#pragma nounroll
        for (int q = 0; q < (l == 0 ? 2 : 1); ++q) {
            WAVE_IDS; unsigned char* w_ = ws; float* o_ = out; int l_ = l; OPQP(unsigned char, w_); OPQP(float, o_); OPQ(l_);
            Gemm g; EpiF32 E;
            if (q == 0) { g = Gemm{(const bf16_t*)(w_ + WS_XB), (const bf16_t*)(w_ + WS_W0 + (size_t)l_ * WS_WL + W_IN), M_ALL, 3584, 1024};
                E = EpiF32{0, (const float*)(w_ + WS_RSTD), (float*)(w_ + WS_PROJ), o_, l_, (bf16_t*)(w_ + WS_VT), (bf16_t*)(w_ + WS_KB)}; }
            else { g = Gemm{(const bf16_t*)(w_ + WS_MEMB), (const bf16_t*)(w_ + WS_WMKV), 512, 2048, 1024};
                E = EpiF32{1, (const float*)(w_ + WS_MEMRSTD), nullptr, o_, l_, (bf16_t*)(w_ + WS_MVT), (bf16_t*)(w_ + WS_MKB)}; }
            StaticOrder S; S.init(g.M, g.N, G, q == 0 ? bid : (bid + 16) % G);
            gemm_phase<EpiF32, StaticOrder, true, true>(lds, g, S, E);
        }
        if (l == 0 && gridDim.x == 256 && blockIdx.x >= 156 && blockIdx.x < 240) {
            WAVE_IDS; unsigned char* w_ = ws; OPQP(unsigned char, w_);
            const unsigned long long* tabc = (const unsigned long long*)w_; LAS float* scr = (LAS float*)(lds + wave * 16384);
#define TABP(i) FPTR(tabc[i])
            for (int j = (bid - 156) * 8 + wave; j < 4096; j += 84 * 8) CONV_ITEM(TABP, 0, 3328 + j, w_);
#undef TABP
        }
        GRID_BAR();
#pragma nounroll
        for (int ph = 0; ph < 3; ++ph) {
            WAVE_IDS; unsigned char* w_ = ws; float* o_ = out; int l_ = l; OPQP(unsigned char, w_); OPQP(float, o_); OPQ(l_);
            const unsigned long long* tab = (const unsigned long long*)w_;
            float* PROJ = (float*)(w_ + WS_PROJ); float* OSB = (float*)(w_ + WS_OSB); bf16_t* MIX = (bf16_t*)(w_ + WS_MIX); float* DS = (float*)(w_ + WS_DS); float* DD = (float*)(w_ + WS_DD);
            if (ph != 1) {
                const int nit = ph == 0 ? 1152 : 1024;
                const float* state_hgrn = GPTR(tab[5]); const float* lb_logits = GPTR(tab[8]); const float* hgain = GPTR(tab[12]) + l_ * 512;
#define HG_DECODE(IT, ROW0, TV, H) do { if ((IT) < 1024) { const int bh_ = (IT) >> 7; H = bh_ & 3; ROW0 = (bh_ >> 2) * 8192 + ((IT) & 127) * 64; TV = 64; } \
                    else { const int si_ = (IT) - 1024; H = si_ & 3; ROW0 = NPROMPT + 16 * (si_ >> 2); TV = 16; } } while (0)
#define HG_MAP(Q) (ph == 0 ? ((Q) < 128 ? 1024 + (Q) : (Q) - 128) : (Q))
                volatile LAS unsigned* LW = (volatile LAS unsigned*)(lds + LDS_BARST);
                unsigned* ctr = (unsigned*)(w_ + WS_CTR) + 2 * l_;
                unsigned nextq = 0; int cur;
                if (ph == 0) { if (tid == 0) LW[4] = atomicAdd(ctr, 1u); __syncthreads(); cur = (int)LW[4]; if (tid == 0) nextq = atomicAdd(ctr, 1u); }
                else cur = bid;
                while (cur < nit) {
                    const int it = HG_MAP(cur); int nxt;
                    if (ph == 0) { __syncthreads(); if (tid == 0) LW[4] = nextq; __syncthreads(); nxt = (int)LW[4]; if (tid == 0 && nxt < nit) nextq = atomicAdd(ctr, 1u); }
                    else nxt = cur + G;
                    int row0, tvalid, h; HG_DECODE(it, row0, tvalid, h);
                    float* dsOut; float* ddOut; const float* s0; const float* Ssrc;
                    if (it < 1024) { const int bh = it >> 7, c = it & 127; dsOut = DS + (size_t)(bh * 128 + c) * 16384; ddOut = DD + (size_t)(bh * 128 + c) * 128; s0 = nullptr; Ssrc = dsOut; }
                    else { const int si = it - 1024, s = si >> 2; s0 = state_hgrn + (size_t)((l_ * 32 + s) * 4 + h) * 16384; Ssrc = s0; dsOut = o_ + O_HS + (size_t)((l_ * 32 + s) * 4 + h) * 16384; ddOut = nullptr; }
                    int t2 = tid; asm volatile("" : "+v"(t2)); const int lane2 = t2 & 63, tg2 = t2 >> 7, k2 = t2 & 127;
                    const int ch = h * 128 + k2;
                    const float lbv = l_ == 0 ? 0.f : __builtin_amdgcn_rcpf(1.f + fexp(lb_logits[ch] - lb_logits[512 + ch]));
                    { float zc[16]; hg_load(PROJ, row0, tvalid, h, tg2, k2, 2048, zc);
                      if (ph == 0) hg_h1(lds, PROJ, zc, row0, tvalid, h, lbv, dsOut, ddOut, s0, t2, lane2, wave);
                      if (ph == 2 || it >= 1024) hg_h3(lds, PROJ, zc, row0, tvalid, h, lbv, Ssrc, it < 1024, hgain, MIX, t2, lane2, wave); }
                    cur = nxt;
                }
#undef HG_DECODE
#undef HG_MAP
                if (ph == 0) { unsigned char* w2 = ws; float* o2 = out; int l2 = l; OPQP(unsigned char, w2); OPQP(float, o2); OPQ(l2);
                    const unsigned long long* tab2 = (const unsigned long long*)w2; unsigned* ctr2 = (unsigned*)(w2 + WS_CTR) + 2 * l2 + 1;
                    unsigned wq = 0; if (lane == 0) wq = atomicAdd(ctr2, 1u); int w = __builtin_amdgcn_readfirstlane(wq);
                    while (w < 4352) { unsigned wn = 0; if (lane == 0) wn = atomicAdd(ctr2, 1u);
                        int lane2 = lane; asm volatile("" : "+v"(lane2));
                        if (w < 256) sb_item<true>(4096 + w, l2, (const float*)(w2 + WS_PROJ), o2 + O_KP + (size_t)l2 * NPROMPT * 512, o2 + O_VP + (size_t)l2 * NPROMPT * 512,
                                                    o2 + O_KS + (size_t)l2 * 262144, o2 + O_VS + (size_t)l2 * 262144, GPTR(tab2[3]), GPTR(tab2[4]), (const bf16_t*)(w2 + WS_VT), (const bf16_t*)(w2 + WS_KB), (float*)(w2 + WS_OSB), lane2);
                        else sb_item<false>(w - 256, l2, (const float*)(w2 + WS_PROJ), o2 + O_KP + (size_t)l2 * NPROMPT * 512, o2 + O_VP + (size_t)l2 * NPROMPT * 512,
                                                    o2 + O_KS + (size_t)l2 * 262144, o2 + O_VS + (size_t)l2 * 262144, GPTR(tab2[3]), GPTR(tab2[4]), (const bf16_t*)(w2 + WS_VT), (const bf16_t*)(w2 + WS_KB), (float*)(w2 + WS_OSB), lane2);
                        w = __builtin_amdgcn_readfirstlane(wn); } }
            } else {
                if (wave < 4) {
                    for (int p = bid * 256 + tid; p < 65536; p += G * 256) { const int e = 2 * p, bh = e >> 14, rem = e & 16383, k = rem & 127, v = rem >> 7;
                        unsigned* dsp = (unsigned*)(DS + (size_t)(bh * 128) * 16384) + (rem >> 1); const float* ddp = DD + (size_t)(bh * 128) * 128 + k;
                        float S0 = 0.f, S1 = 0.f;
                        for (int c = 0; c < 128; c += 16) { unsigned x[16]; f32x2_t d[16];
#pragma unroll
                            for (int u = 0; u < 16; ++u) { x[u] = dsp[(size_t)(c + u) * 16384]; d[u] = *(const f32x2_t*)(ddp + (c + u) * 128); }
#pragma unroll
                            for (int u = 0; u < 16; ++u) { dsp[(size_t)(c + u) * 16384] = pk2(S0, S1);
                                S0 = d[u].x * S0 + __uint_as_float(x[u] << 16); S1 = d[u].y * S1 + __uint_as_float(x[u] & 0xffff0000u); } }
                        float* op = o_ + O_HP + (size_t)l_ * 131072 + (size_t)bh * 16384 + k * 128 + v; op[0] = S0; op[128] = S1; }
                } else {
                    const float* sbg = GPTR(tab[11]) + l_ * 512; const int NW4 = G * 4;
                    const f32x4 ga = *(const f32x4*)(sbg + lane * 8), gb = *(const f32x4*)(sbg + lane * 8 + 4);
                    int m = bid * 4 + (wave - 4); f32x4 a = {0.f, 0.f, 0.f, 0.f}, b = a;
                    if (m < M_ALL) { const f32x4* op = (const f32x4*)(OSB + (size_t)m * 512 + lane * 8); a = op[0]; b = op[1]; }
                    while (m < M_ALL) { const int mn = m + NW4; f32x4 an = a, bn = b;
                        if (mn < M_ALL) { const f32x4* op = (const f32x4*)(OSB + (size_t)mn * 512 + lane * 8); an = op[0]; bn = op[1]; }
                        float ss = ((a[0] * a[0] + a[1] * a[1]) + (a[2] * a[2] + a[3] * a[3])) + ((b[0] * b[0] + b[1] * b[1]) + (b[2] * b[2] + b[3] * b[3]));
                        ss = wave_sum(ss); const float rs = rsqrtf(ss * (1.0f / 512.0f) + 1e-6f);
                        *(u32x4*)(MIX + (size_t)m * 1024 + lane * 8) = (u32x4){pk2(a[0] * rs * ga[0], a[1] * rs * ga[1]), pk2(a[2] * rs * ga[2], a[3] * rs * ga[3]),
                                                                              pk2(b[0] * rs * gb[0], b[1] * rs * gb[1]), pk2(b[2] * rs * gb[2], b[3] * rs * gb[3])};
                        a = an; b = bn; m = mn; } }
            }
            GRID_BAR();
        }
#pragma nounroll
        for (int st = 0; st < 3; ++st) {
            { WAVE_IDS; unsigned char* w_ = ws; int l_ = l; OPQP(unsigned char, w_); OPQ(l_);
              const unsigned long long* tab = (const unsigned long long*)w_; unsigned char* wl = w_ + WS_W0 + (size_t)l_ * WS_WL;
              float* X = (float*)(w_ + WS_X);
              const bf16_t* A = (const bf16_t*)(w_ + (st == 0 ? WS_MIX : (st == 1 ? WS_OM : WS_H))); const bf16_t* Bt = (const bf16_t*)(wl + (st == 0 ? W_OUT : (st == 1 ? W_MO : W_2)));
              const int K = st == 0 ? 1024 : (st == 1 ? 512 : 4096);
              { Gemm g{A, Bt, NPROMPT, 1024, K, 0};
                EpiResid E{(st == 0 && l_ == 0) ? FPTR(tab[0]) : X, nullptr, X, (bf16_t*)(w_ + WS_XB), (float*)(w_ + WS_SSQ)};
                StaticOrder S; S.init(NPROMPT, 1024, G, bid);
                gemm_phase<EpiResid, StaticOrder, true, true>(lds, g, S, E); }
              { Gemm g{A, Bt, M_ALL, 1024, 256, K};
                EpiPart E{(float*)(w_ + WS_PART)};
                SplitOrder S; S.init(2, 1024, K / 256, G, bid, 64);
                gemm_phase<EpiPart, SplitOrder, true, true>(lds, g, S, E); } }
            GRID_BAR();
            { WAVE_IDS; unsigned char* w_ = ws; int l_ = l; OPQP(unsigned char, w_); OPQ(l_);
              const unsigned long long* tab = (const unsigned long long*)w_; const int nS = (st == 0 ? 1024 : (st == 1 ? 512 : 4096)) / 256;
              float* X = (float*)(w_ + WS_X); bf16_t* XB = (bf16_t*)(w_ + WS_XB); float* SSQ = (float*)(w_ + WS_SSQ); const float* PART = (const float*)(w_ + WS_PART);
              const float* bs = (st == 0 && l_ == 0) ? FPTR(tab[1]) : X + (size_t)NPROMPT * 1024;
              LAS float* red = (LAS float*)lds;
              for (int mb = bid; mb < 256; mb += G) { const int m = mb * 2 + (wave >> 2), cq = wave & 3, col = cq * 256 + lane * 4;
                  f32x4 v = *(const f32x4*)(bs + (size_t)m * 1024 + col); f32x4 pp[16];
#pragma unroll
                  for (int ks = 0; ks < 16; ++ks) { const int kc = ks < nS ? ks : 0; pp[ks] = *(const f32x4*)(PART + ((size_t)kc * 512 + m) * 1024 + col); }
#pragma unroll
                  for (int ks = 0; ks < 16; ++ks) { const float on = ks < nS ? 1.f : 0.f; v += pp[ks] * on; }
                  *(f32x4*)(X + (size_t)(NPROMPT + m) * 1024 + col) = v;
                  u32x2 w; w.x = pk2(v[0], v[1]); w.y = pk2(v[2], v[3]); *(u32x2*)(XB + (size_t)(NPROMPT + m) * 1024 + col) = w;
                  float s = wave_sum((v[0] * v[0] + v[1] * v[1]) + (v[2] * v[2] + v[3] * v[3]));
                  if (lane == 0) red[wave] = s;
                  __syncthreads();
                  if (cq == 0 && lane == 0) ((float*)(w_ + WS_RSTD))[NPROMPT + m] = rsqrtf(((red[wave] + red[wave + 1]) + (red[wave + 2] + red[wave + 3])) * (1.0f / 1024.0f) + 1e-6f);
                  __syncthreads(); }
              if (tid < 64) for (int r = bid * 64 + tid; r < NPROMPT; r += G * 64) ((float*)(w_ + WS_RSTD))[r] = row_rstd(SSQ, r); }
            GRID_BAR();
            if (st < 2) {
                WAVE_IDS; unsigned char* w_ = ws; int l_ = l; OPQP(unsigned char, w_); OPQ(l_); unsigned char* wl = w_ + WS_W0 + (size_t)l_ * WS_WL;
                Gemm g; EpiBf16S E;
                if (st == 0) { g = Gemm{(const bf16_t*)(w_ + WS_XB), (const bf16_t*)(wl + W_MQ), M_ALL, 512, 1024}; E = EpiBf16S{(bf16_t*)(w_ + WS_QM), 512, (const float*)(w_ + WS_RSTD), 0.08838834764831845f, 0}; }
                else { g = Gemm{(const bf16_t*)(w_ + WS_XB), (const bf16_t*)(wl + W_1), M_ALL, 4096, 1024}; E = EpiBf16S{(bf16_t*)(w_ + WS_H), 4096, (const float*)(w_ + WS_RSTD), 1.0f, 1}; }
                StaticOrder S; S.init(M_ALL, g.N, G, bid);
                gemm_phase<EpiBf16S, StaticOrder, true, true>(lds, g, S, E);
                if (st == 0 && l_ == 0 && bid >= 132 && G == 256) {
                    const unsigned long long* tabc = (const unsigned long long*)w_; LAS float* scr = (LAS float*)(lds + wave * 16384);
#define TABP(i) FPTR(tabc[i])
                    for (int j = (bid - 132) * 8 + wave; j < 6912; j += 124 * 8) CONV_ITEM(TABP, 1, j < 2560 ? j : j + 512, w_);
#undef TABP
                }
                GRID_BAR();
            }
            if (st == 0) {
                WAVE_IDS; unsigned char* w_ = ws; float* o_ = out; int l_ = l; OPQP(unsigned char, w_); OPQP(float, o_); OPQ(l_);
                const unsigned long long* tab = (const unsigned long long*)w_; const float* cache_mk = GPTR(tab[6]); const float* cache_mv = GPTR(tab[7]);
                const bf16_t* QM = (const bf16_t*)(w_ + WS_QM); bf16_t* OM = (bf16_t*)(w_ + WS_OM);
                for (int it = bid; it < 1152; it += G) {
                    int row0, tvalid, hm; const float* Kg; const float* Vg; const bf16_t* Kb = nullptr; const bf16_t* Vtb = nullptr;
                    if (it < 1024) { const int tt = it >> 2; hm = it & 3; row0 = tt * 64; tvalid = 64; const int b = tt >> 7;
                        Kb = (const bf16_t*)(w_ + WS_MKB) + (size_t)((l_ * 2 + b) * 4 + hm) * 32768; Vtb = (const bf16_t*)(w_ + WS_MVT) + (size_t)((l_ * 2 + b) * 4 + hm) * 32768;
                        Kg = o_ + O_MKP + (size_t)(l_ * 2 + b) * 131072 + hm * 128; Vg = o_ + O_MVP + (size_t)(l_ * 2 + b) * 131072 + hm * 128; }
                    else { const int si = it - 1024, s = si >> 2; hm = si & 3; row0 = NPROMPT + 16 * s; tvalid = 16;
                        Kg = cache_mk + (size_t)(l_ * 32 + s) * 131072 + hm * 128; Vg = cache_mv + (size_t)(l_ * 32 + s) * 131072 + hm * 128; }
                    int t2 = tid; asm volatile("" : "+v"(t2));
                    xattn_item(lds, QM, Kg, Vg, Kb, Vtb, row0, tvalid, hm, OM, t2, t2 & 63, wave);
                }
                GRID_BAR();
            }
        }
    }
    { WAVE_IDS; unsigned char* w_ = ws; float* o_ = out; OPQP(unsigned char, w_); OPQP(float, o_);
      const float* nf = GPTR(((const unsigned long long*)w_)[23]); const float* X = (const float*)(w_ + WS_X);
      for (int m0 = gw; m0 < M_ALL; m0 += 2 * NGW) { const int m1 = (m0 + NGW < M_ALL) ? m0 + NGW : m0;
          const f32x4* xa = (const f32x4*)(X + (size_t)m0 * 1024) + lane; const f32x4* xb = (const f32x4*)(X + (size_t)m1 * 1024) + lane; f32x4 va[4], vb[4]; float sa = 0.f, sb = 0.f;
#pragma unroll
          for (int j = 0; j < 4; ++j) { va[j] = xa[64 * j]; vb[j] = xb[64 * j]; }
#pragma unroll
          for (int j = 0; j < 4; ++j) { sa += (va[j][0] * va[j][0] + va[j][1] * va[j][1]) + (va[j][2] * va[j][2] + va[j][3] * va[j][3]); sb += (vb[j][0] * vb[j][0] + vb[j][1] * vb[j][1]) + (vb[j][2] * vb[j][2] + vb[j][3] * vb[j][3]); }
          sa = wave_sum(sa); sb = wave_sum(sb); const float ra = rsqrtf(sa * (1.0f / 1024.0f) + 1e-6f), rb = rsqrtf(sb * (1.0f / 1024.0f) + 1e-6f);
          f32x4* ya = (f32x4*)(o_ + (m0 < NPROMPT ? O_YP + (size_t)m0 * 1024 : O_YS + (size_t)(m0 - NPROMPT) * 1024)) + lane;
          f32x4* yb = (f32x4*)(o_ + (m1 < NPROMPT ? O_YP + (size_t)m1 * 1024 : O_YS + (size_t)(m1 - NPROMPT) * 1024)) + lane;
#pragma unroll
          for (int j = 0; j < 4; ++j) { const f32x4 g = *((const f32x4*)nf + lane + 64 * j); ya[64 * j] = va[j] * ra * g; if (m1 != m0) yb[64 * j] = vb[j] * rb * g; } } }
}

extern "C" void kernel_launch(void* const* d_in, const int* in_sizes, int n_in, void* d_out, int out_size, void* d_ws, size_t ws_size, hipStream_t stream) {
    static int grid = 0;
    if (grid == 0) {
        int dev = 0, cus = 0, per_cu = 0;
        (void)hipGetDevice(&dev); (void)hipDeviceGetAttribute(&cus, hipDeviceAttributeMultiprocessorCount, dev);
        if (hipFuncSetAttribute((const void*)mega_fwd, hipFuncAttributeMaxDynamicSharedMemorySize, LDS_BYTES) != hipSuccess) fprintf(stderr, "kernel_launch: hipFuncSetAttribute failed\n");
        if (hipOccupancyMaxActiveBlocksPerMultiprocessor(&per_cu, (const void*)mega_fwd, 512, LDS_BYTES) != hipSuccess || per_cu < 1) { fprintf(stderr, "kernel_launch: occupancy query says %d\n", per_cu); per_cu = 1; }
        (void)hipGetLastError();
        if (cus <= 0) cus = 256;
        grid = cus;
    }
    Args a{};
    for (int i = 0; i < 24; ++i) a.in[i] = (const float*)d_in[i];
    a.out = (float*)d_out; a.ws = (unsigned char*)d_ws;
    void* kargs[] = {&a};
    const hipError_t e = hipLaunchCooperativeKernel((const void*)mega_fwd, dim3(grid), dim3(512), kargs, LDS_BYTES, stream);
    if (e != hipSuccess) fprintf(stderr, "kernel_launch: cooperative launch failed: %s (grid %d)\n", hipGetErrorString(e), grid);
}
```

```cpp
#include <hip/hip_runtime.h>
#include <hip/hip_cooperative_groups.h>
#include <cstdio>
#include <cstdint>
namespace cg = cooperative_groups;
namespace pg8 {
#define PG8_LAS __attribute__((address_space(3)))
typedef unsigned short bf16_t;
typedef short bf16x8 __attribute__((ext_vector_type(8)));
typedef float f32x4 __attribute__((ext_vector_type(4)));
typedef unsigned u32x4 __attribute__((ext_vector_type(4)));
constexpr int BM = 256, BK = 64, HALF = 128, HTB = HALF * BK * 2  , STAGE_BYTES = 8 * HTB, NXCD = 8, WGM = 8;

__host__ __device__ __forceinline__ int lds_byte(int r, int c) { const int st = (r >> 4) * 2 + (c >> 5), rr = r & 15, cc = c & 31, ob = rr * 64 + cc * 2; return st * 1024 + (ob ^ (((ob >> 9) & 1) << 5)); }
__host__ __device__ __forceinline__ void stage_rc(int b, int& R, int& C) { const int st = b / 1024, sb = b % 1024, swz = sb ^ (((sb >> 9) & 1) << 5); R = (st >> 1) * 16 + swz / 64; C = (st & 1) * 32 + (swz % 64) / 2; }
__host__ __device__ __forceinline__ int perm32(int rho) { const int n = rho >> 4, i = rho & 15; return 8 * (i >> 2) + 4 * n + (i & 3); }

struct Unit { int pm, pn, ks; };
struct Gemm { const bf16_t* A; const bf16_t* Bt; int M, N, K, ld; };

struct StaticOrder {
    int nM, nN, nwg, G, c;
    __host__ __device__ void init(int M, int N, int G_, int c_) { nM = M / BM; nN = N / BM; nwg = nM * nN; G = G_; c = c_; }
    __host__ __device__ bool next(int i, Unit& u) const {
        const long L = (long)i * G + c; if (L >= nwg) return false;
        int wgid = (int)L; { const int q = nwg / NXCD, r = nwg % NXCD, xcd = wgid % NXCD, off = wgid / NXCD; wgid = (xcd < r ? xcd * (q + 1) : r * (q + 1) + (xcd - r) * q) + off; }
        const int nig = WGM * nN, gid = wgid / nig, fm = gid * WGM, gsz = (nM - fm) < WGM ? (nM - fm) : WGM;
        u.pm = fm + ((wgid % nig) % gsz); u.pn = (wgid % nig) / gsz; u.ks = 0; return true;
    }
    __device__ __forceinline__ void a_ready(const Unit&) const {}
    __device__ __forceinline__ void done(const Unit&) const {}
};
struct SplitOrder {
    int nN, nS, nwg, G, c, pm0;
    __host__ __device__ void init(int nMs, int N, int nS_, int G_, int c_, int pm0_) { nN = N / BM; nS = nS_; nwg = nMs * nN * nS; G = G_; c = c_; pm0 = pm0_; }
    __host__ __device__ bool next(int i, Unit& u) const { const long L = (long)i * G + c; if (L >= nwg) return false; const int t = (int)L / nS; u.ks = (int)L % nS; u.pn = t % nN; u.pm = pm0 + t / nN; return true; }
    __device__ __forceinline__ void a_ready(const Unit&) const {}
    __device__ __forceinline__ void done(const Unit&) const {}
};
__device__ __forceinline__ unsigned cvt_pk_bf16(float lo, float hi) { unsigned r; asm volatile("v_cvt_pk_bf16_f32 %0, %1, %2" : "=v"(r) : "v"(lo), "v"(hi)); return r; }
typedef float f32x2 __attribute__((ext_vector_type(2)));
typedef unsigned u32x2 __attribute__((ext_vector_type(2)));
constexpr int NPROMPT = 16384;
constexpr size_t O_YP = 0, O_YS = 16777216, O_KP = 17301504, O_VP = 34078720, O_HP = 50855936, O_MKP = 51118080, O_MVP = 51642368,
                 O_KS = 52166656, O_VS = 52690944, O_HS = 53215232;
__device__ __forceinline__ float row_rstd(const float* ssq, int row) {
    const f32x4* p = (const f32x4*)(ssq + (size_t)row * 16);
    const f32x4 a = p[0], b = p[1], c = p[2], d = p[3];
    const float s = (((a[0] + a[1]) + (a[2] + a[3])) + ((b[0] + b[1]) + (b[2] + b[3]))) + (((c[0] + c[1]) + (c[2] + c[3])) + ((d[0] + d[1]) + (d[2] + d[3])));
    return rsqrtf(s * (1.0f / 1024.0f) + 1e-6f);
}
struct EpiF32 {
    static constexpr bool PERM = true, AFTER_DRAIN = false;
    int mode; const float* rstd; float* proj; float* outp; int l; bf16_t* vt; bf16_t* kb;
    __device__ __forceinline__ void operator()(const f32x4 (&acc)[2][2][4][2], const Unit& u, int wr, int wc, int fr_, int fq_) const {
        int tq = threadIdx.x; asm volatile("" : "+v"(tq)); const int fr = tq & 15, fq = (tq >> 4) & 3;
        float* base; int pitch, colt, rsub = 0; const int pn = u.pn;
        if (mode == 0) {
            if (pn >= 2 && pn < 6) { const size_t isv = pn >= 4 ? 1 : 0; colt = (pn & 1) * 256; pitch = 512;
                if (u.pm < 64) base = outp + (O_KP + isv * (O_VP - O_KP) + (size_t)l * NPROMPT * 512);
                else { base = outp + (O_KS + isv * (O_VS - O_KS) + (size_t)l * 262144); rsub = NPROMPT; } }
            else { base = proj; pitch = 3584; colt = pn * 256; }
        } else { const size_t sel = (size_t)(pn >> 1); base = outp + (O_MKP + (sel & 1) * (O_MVP - O_MKP) + (sel >> 1) * 262144); pitch = 512; colt = (pn & 1) * 256; }
        const int col0 = colt + wc * 32 + 8 * fq, rowb = u.pm * BM + wr * 64 + fr;
        float rs[2][4];
#pragma unroll
        for (int ai = 0; ai < 2; ++ai)
#pragma unroll
            for (int m = 0; m < 4; ++m) rs[ai][m] = rstd[rowb + ai * HALF + m * 16];
#pragma unroll
        for (int ai = 0; ai < 2; ++ai)
#pragma unroll
            for (int m = 0; m < 4; ++m) { const int row = rowb + ai * HALF + m * 16;
                if (base == proj && mode == 0) {
                    const float sc = rs[ai][m] * (pn < 2 ? 0.125f : 1.0f); bf16_t* bp_ = (bf16_t*)proj + (size_t)row * 3584 + col0;
#pragma unroll
                    for (int bj = 0; bj < 2; ++bj) { const f32x4 v0 = acc[ai][bj][m][0] * sc, v1 = acc[ai][bj][m][1] * sc;
                        u32x4 w; w.x = cvt_pk_bf16(v0[0], v0[1]); w.y = cvt_pk_bf16(v0[2], v0[3]); w.z = cvt_pk_bf16(v1[0], v1[1]); w.w = cvt_pk_bf16(v1[2], v1[3]); *(u32x4*)(bp_ + bj * HALF) = w; }
                } else {
                float* rp = base + (size_t)(row - rsub) * pitch + col0;
#pragma unroll
                for (int bj = 0; bj < 2; ++bj)
#pragma unroll
                    for (int n = 0; n < 2; ++n) *(f32x4*)(rp + bj * HALF + n * 4) = acc[ai][bj][m][n] * rs[ai][m]; } }
        if (mode == 1) {
            const int sel = pn >> 1, lyr = sel >> 1, isv = sel & 1, bb = u.pm;
#pragma unroll
            for (int ai = 0; ai < 2; ++ai)
#pragma unroll
                for (int m = 0; m < 4; ++m) { const int row = rowb + ai * HALF + m * 16, mm = row & 255;
#pragma unroll
                    for (int bj = 0; bj < 2; ++bj) { const f32x4 v0 = acc[ai][bj][m][0] * rs[ai][m], v1 = acc[ai][bj][m][1] * rs[ai][m]; const int c = col0 + bj * HALF, hh = c >> 7, d0 = c & 127;
                        const unsigned p0 = cvt_pk_bf16(v0[0], v0[1]), p1 = cvt_pk_bf16(v0[2], v0[3]), p2 = cvt_pk_bf16(v1[0], v1[1]), p3 = cvt_pk_bf16(v1[2], v1[3]);
                        const size_t hb = (size_t)((lyr * 2 + bb) * 4 + hh) * 32768;
                        if (!isv) { u32x4 w; w.x = p0; w.y = p1; w.z = p2; w.w = p3; *(u32x4*)(kb + hb + (size_t)mm * 128 + d0) = w; }
                        else { bf16_t* q = vt + hb + (size_t)d0 * 256 + mm;
                            q[0] = (bf16_t)(p0 & 0xffffu); q[256] = (bf16_t)(p0 >> 16); q[512] = (bf16_t)(p1 & 0xffffu); q[768] = (bf16_t)(p1 >> 16);
                            q[1024] = (bf16_t)(p2 & 0xffffu); q[1280] = (bf16_t)(p2 >> 16); q[1536] = (bf16_t)(p3 & 0xffffu); q[1792] = (bf16_t)(p3 >> 16); } } }
        }
        if (mode == 0 && pn >= 2 && pn < 4 && u.pm < 64) {
#pragma unroll
            for (int ai = 0; ai < 2; ++ai)
#pragma unroll
                for (int m = 0; m < 4; ++m) { const int row = rowb + ai * HALF + m * 16, t = row & 8191;
#pragma unroll
                    for (int bj = 0; bj < 2; ++bj) { const f32x4 v0 = acc[ai][bj][m][0] * rs[ai][m], v1 = acc[ai][bj][m][1] * rs[ai][m]; const int c = col0 + bj * HALF, hh = c >> 6, d0 = c & 63;
                        u32x4 w; w.x = cvt_pk_bf16(v0[0], v0[1]); w.y = cvt_pk_bf16(v0[2], v0[3]); w.z = cvt_pk_bf16(v1[0], v1[1]); w.w = cvt_pk_bf16(v1[2], v1[3]);
                        *(u32x4*)(kb + ((((size_t)((row >> 13) * 8 + hh) * 256 + (t >> 5)) * 8 + (d0 >> 3)) * 32 + (t & 31)) * 8) = w; } }
        }
        if (mode == 0 && pn >= 4 && pn < 6 && u.pm < 64) {
            const int qi = fr & 3;
#pragma unroll
            for (int ai = 0; ai < 2; ++ai)
#pragma unroll
                for (int m = 0; m < 4; ++m) { const int row = rowb + ai * HALF + m * 16, t0 = (row & 8191) & ~3; const size_t tb = ((size_t)(row >> 13) * 8 * 2048 * 64 + (size_t)(t0 >> 2) * 64) * 4;
#pragma unroll
                    for (int bj = 0; bj < 2; ++bj)
#pragma unroll
                        for (int n = 0; n < 2; ++n) { const f32x4 v = acc[ai][bj][m][n] * rs[ai][m]; const int c = col0 + bj * HALF + n * 4;
                            const unsigned p01 = cvt_pk_bf16(v[0], v[1]), p23 = cvt_pk_bf16(v[2], v[3]);
                            const unsigned snd1 = (qi & 2) ? p01 : p23, kep1 = (qi & 2) ? p23 : p01, rcv1 = (unsigned)__shfl_xor((int)snd1, 2);
                            const unsigned q0 = (qi & 2) ? rcv1 : kep1, q2 = (qi & 2) ? kep1 : rcv1;
                            const unsigned los = (q0 & 0xffffu) | (q2 << 16), his = (q0 >> 16) | (q2 & 0xffff0000u);
                            const unsigned rcv2 = (unsigned)__shfl_xor((int)((qi & 1) ? los : his), 1), mine = (qi & 1) ? his : los;
                            u32x2 w;
                            if (qi & 1) { w.x = (rcv2 & 0xffffu) | (mine << 16); w.y = (rcv2 >> 16) | (mine & 0xffff0000u); }
                            else { w.x = (mine & 0xffffu) | (rcv2 << 16); w.y = (mine >> 16) | (rcv2 & 0xffff0000u); }
                            const int cc = c + (qi & 2) + (qi & 1), hh = cc >> 6, dd = cc & 63;
                            *(u32x2*)(vt + tb + ((size_t)hh * 2048 * 64 + dd) * 4) = w; } }
        }
    }
};
struct EpiResid {
    static constexpr bool PERM = true, AFTER_DRAIN = false;
    const float* bp; const float* bs; float* X; bf16_t* XB; float* ssq;
    __device__ __forceinline__ void operator()(const f32x4 (&acc)[2][2][4][2], const Unit& u, int wr, int wc, int fr_, int fq_) const {
        int tq = threadIdx.x; asm volatile("" : "+v"(tq)); const int fr = tq & 15, fq = (tq >> 4) & 3;
        const int col0 = u.pn * BM + wc * 32 + 8 * fq;
#pragma unroll
        for (int ai = 0; ai < 2; ++ai) {
            f32x4 res[4][2][2];
#pragma unroll
            for (int m = 0; m < 4; ++m) { const int row = u.pm * BM + ai * HALF + wr * 64 + m * 16 + fr;
                const float* br = (row < NPROMPT ? bp + (size_t)row * 1024 : bs + (size_t)(row - NPROMPT) * 1024) + col0;
#pragma unroll
                for (int bj = 0; bj < 2; ++bj) { res[m][bj][0] = *(const f32x4*)(br + bj * HALF); res[m][bj][1] = *(const f32x4*)(br + bj * HALF + 4); } }
            asm volatile("" ::: "memory");
#pragma unroll
            for (int m = 0; m < 4; ++m) { const int row = u.pm * BM + ai * HALF + wr * 64 + m * 16 + fr;
                float* xr = X + (size_t)row * 1024 + col0; bf16_t* xb = XB + (size_t)row * 1024 + col0; float ss = 0.f;
#pragma unroll
                for (int bj = 0; bj < 2; ++bj) { const f32x4 v0 = acc[ai][bj][m][0] + res[m][bj][0], v1 = acc[ai][bj][m][1] + res[m][bj][1];
                    *(f32x4*)(xr + bj * HALF) = v0; *(f32x4*)(xr + bj * HALF + 4) = v1;
                    ss += ((v0[0] * v0[0] + v0[1] * v0[1]) + (v0[2] * v0[2] + v0[3] * v0[3])) + ((v1[0] * v1[0] + v1[1] * v1[1]) + (v1[2] * v1[2] + v1[3] * v1[3]));
                    u32x4 w; w.x = cvt_pk_bf16(v0[0], v0[1]); w.y = cvt_pk_bf16(v0[2], v0[3]); w.z = cvt_pk_bf16(v1[0], v1[1]); w.w = cvt_pk_bf16(v1[2], v1[3]); *(u32x4*)(xb + bj * HALF) = w; }
                ss += __shfl_xor(ss, 16); ss += __shfl_xor(ss, 32);
                if (fq == 0) ssq[(size_t)row * 16 + u.pn * 4 + wc] = ss; }
            asm volatile("" ::: "memory"); }
    }
};
struct EpiBf16S {
    static constexpr bool PERM = true, AFTER_DRAIN = false;
    bf16_t* O; int ldc; const float* rstd; float scale; int act;
    __device__ __forceinline__ void operator()(const f32x4 (&acc)[2][2][4][2], const Unit& u, int wr, int wc, int fr_, int fq_) const {
        int tq = threadIdx.x; asm volatile("" : "+v"(tq)); const int fr = tq & 15, fq = (tq >> 4) & 3;
        const int col0 = u.pn * BM + wc * 32 + 8 * fq, rowb = u.pm * BM + wr * 64 + fr;
        float rs[2][4];
#pragma unroll
        for (int ai = 0; ai < 2; ++ai)
#pragma unroll
            for (int m = 0; m < 4; ++m) rs[ai][m] = rstd[rowb + ai * HALF + m * 16];
#pragma unroll
        for (int ai = 0; ai < 2; ++ai)
#pragma unroll
            for (int m = 0; m < 4; ++m) { const int row = rowb + ai * HALF + m * 16; const float r1 = rs[ai][m];
                bf16_t* rowp = O + (size_t)row * ldc + col0;
#pragma unroll
                for (int bj = 0; bj < 2; ++bj) { f32x4 v0 = acc[ai][bj][m][0] * r1, v1 = acc[ai][bj][m][1] * r1;
                    if (act == 1) { v0 = __builtin_elementwise_max(v0, (f32x4){0.f, 0.f, 0.f, 0.f}); v1 = __builtin_elementwise_max(v1, (f32x4){0.f, 0.f, 0.f, 0.f}); v0 = v0 * v0; v1 = v1 * v1; }
                    v0 = v0 * scale; v1 = v1 * scale;
                    u32x4 w; w.x = cvt_pk_bf16(v0[0], v0[1]); w.y = cvt_pk_bf16(v0[2], v0[3]); w.z = cvt_pk_bf16(v1[0], v1[1]); w.w = cvt_pk_bf16(v1[2], v1[3]);
                    *(u32x4*)(rowp + bj * HALF) = w; } }
    }
};
struct EpiPart {
    static constexpr bool PERM = true, AFTER_DRAIN = false;
    float* part;
    __device__ __forceinline__ void operator()(const f32x4 (&acc)[2][2][4][2], const Unit& u, int wr, int wc, int fr_, int fq_) const {
        int tq = threadIdx.x; asm volatile("" : "+v"(tq)); const int fr = tq & 15, fq = (tq >> 4) & 3;
        const int col0 = u.pn * BM + wc * 32 + 8 * fq;
#pragma unroll
        for (int ai = 0; ai < 2; ++ai)
#pragma unroll
            for (int m = 0; m < 4; ++m) { const int row = (u.pm - 64) * BM + ai * HALF + wr * 64 + m * 16 + fr;
                float* rp = part + ((size_t)u.ks * 512 + row) * 1024 + col0;
#pragma unroll
                for (int bj = 0; bj < 2; ++bj)
#pragma unroll
                    for (int n = 0; n < 2; ++n) *(f32x4*)(rp + bj * HALF + n * 4) = acc[ai][bj][m][n];
                asm volatile("" ::: "memory"); }
    }
};
template <class Epi, class Sched, bool ALIGN_EPI = false, bool SP2 = false>
__device__ __forceinline__ void gemm_phase(PG8_LAS unsigned char* lds, const Gemm g, const Sched& S, const Epi& E) {
    int tid_ = threadIdx.x; asm volatile("" : "+v"(tid_));
    const int tid = tid_, wid = __builtin_amdgcn_readfirstlane(tid >> 6), lane = tid & 63, wr = wid >> 2, wc = wid & 3, fr = lane & 15, fq = lane >> 4;
    const int K = g.ld ? g.ld : g.K, nt = g.K / BK;
    unsigned voffA[2], voffB[2];
#pragma unroll
    for (int i = 0; i < 2; ++i) { int R, C; stage_rc(tid * 16 + i * 8192, R, C); const int Rb = Epi::PERM ? ((R & ~31) + perm32(R & 31)) : R;
        voffA[i] = (unsigned)(R * K + C) * 2u; voffB[i] = (unsigned)(Rb * K + C) * 2u; }
    const size_t kstep = (size_t)(BK * 2);
    const size_t hstep = (size_t)HALF * K * 2;
    const size_t tstep = 2 * hstep;
    const unsigned ldsw = (unsigned)wid * 1024u;
    const int aoff = lds_byte(wr * 64 + fr, fq * 8), boff = lds_byte(wc * 32 + fr, fq * 8);
#define PG8_SA(b, h) (((b) * 2 + (h)) * HTB)
#define PG8_SB(b, h) ((4 + (b) * 2 + (h)) * HTB)
#define PG8_STAGE(bufoff, gbase, voff) do { _Pragma("unroll") for (int _i = 0; _i < 2; ++_i) \
        __builtin_amdgcn_global_load_lds((const unsigned*)((const char*)(gbase) + (voff)[_i]), (PG8_LAS unsigned*)(lds + (bufoff) + ldsw + _i * 8192), 16, 0, 0); } while (0)
#define PG8_LDA(dst, b, h) do { _Pragma("unroll") for (int m = 0; m < 4; ++m) _Pragma("unroll") for (int k = 0; k < 2; ++k) dst[m][k] = *(const PG8_LAS bf16x8*)(lds + PG8_SA(b, h) + aoff + m * 2048 + k * 1024); } while (0)
#define PG8_LDB(dst, b, h) do { _Pragma("unroll") for (int n = 0; n < 2; ++n) _Pragma("unroll") for (int k = 0; k < 2; ++k) dst[n][k] = *(const PG8_LAS bf16x8*)(lds + PG8_SB(b, h) + boff + n * 2048 + k * 1024); } while (0)
#define PG8_MMA(ai, bj, At, Bt) do { __builtin_amdgcn_s_setprio(1); _Pragma("unroll") for (int m = 0; m < 4; ++m) _Pragma("unroll") for (int n = 0; n < 2; ++n) _Pragma("unroll") for (int k = 0; k < 2; ++k) \
        acc[ai][bj][m][n] = __builtin_amdgcn_mfma_f32_16x16x32_bf16(Bt[n][k], At[m][k], acc[ai][bj][m][n], 0, 0, 0); __builtin_amdgcn_s_setprio(0); } while (0)
#define PG8_WAIT_V(n) asm volatile("s_waitcnt vmcnt(" #n ")" ::: "memory")
#define PG8_WAIT_L(n) asm volatile("s_waitcnt lgkmcnt(" #n ")" ::: "memory")
#define PG8_BAR __builtin_amdgcn_s_barrier()
#define PG8_SCHED __builtin_amdgcn_sched_barrier(0)
    Unit cur, nxt; int ui = 0;
    if (!S.next(0, cur)) return;
    f32x4 acc[2][2][4][2];
#pragma unroll
    for (int a = 0; a < 2; ++a)
#pragma unroll
        for (int b = 0; b < 2; ++b)
#pragma unroll
            for (int m = 0; m < 4; ++m)
#pragma unroll
                for (int n = 0; n < 2; ++n) acc[a][b][m][n] = (f32x4){0.f, 0.f, 0.f, 0.f};
    bf16x8 At[4][2], B0[2][2], B1[2][2];
    const size_t sstep = (size_t)g.K * 2;
    const char* cA = (const char*)g.A + (size_t)cur.pm * tstep + (size_t)cur.ks * sstep; const char* cB = (const char*)g.Bt + (size_t)cur.pn * tstep + (size_t)cur.ks * sstep;
    S.a_ready(cur);
    if constexpr (SP2) {
        PG8_STAGE(PG8_SB(0, 0), cB, voffB); PG8_STAGE(PG8_SB(0, 1), cB + hstep, voffB); PG8_STAGE(PG8_SA(0, 0), cA, voffA); PG8_STAGE(PG8_SA(0, 1), cA + hstep, voffA);
        if (wr == 1) PG8_BAR;
        PG8_WAIT_V(2); PG8_BAR;
        PG8_STAGE(PG8_SB(1, 0), cB + kstep, voffB); PG8_STAGE(PG8_SA(1, 0), cA + kstep, voffA); PG8_STAGE(PG8_SB(1, 1), cB + hstep + kstep, voffB);
        PG8_WAIT_V(6); PG8_BAR;
    } else {
        PG8_STAGE(PG8_SB(0, 0), cB, voffB); PG8_STAGE(PG8_SA(0, 0), cA, voffA); PG8_STAGE(PG8_SB(0, 1), cB + hstep, voffB); PG8_STAGE(PG8_SA(0, 1), cA + hstep, voffA);
        if (wr == 1) PG8_BAR;
        PG8_WAIT_V(4); PG8_BAR;
        PG8_STAGE(PG8_SB(1, 0), cB + kstep, voffB); PG8_STAGE(PG8_SA(1, 0), cA + kstep, voffA); PG8_STAGE(PG8_SB(1, 1), cB + hstep + kstep, voffB);
        PG8_WAIT_V(6); PG8_BAR;
    }
    for (;;) {
        const bool has_next = S.next(ui + 1, nxt);
        const char* nA = has_next ? (const char*)g.A + (size_t)nxt.pm * tstep + (size_t)nxt.ks * sstep : cA; const char* nB = has_next ? (const char*)g.Bt + (size_t)nxt.pn * tstep + (size_t)nxt.ks * sstep : cB;
        for (int t = 0; t < nt; t += 2) {
            const bool last = (t == nt - 2);
            const char* a1 = cA + (size_t)(t + 1) * kstep;
            const char* a2 = last ? nA : cA + (size_t)(t + 2) * kstep; const char* b2 = last ? nB : cB + (size_t)(t + 2) * kstep;
            const char* a3 = a2 + kstep; const char* b3 = b2 + kstep;
            if (last && has_next) S.a_ready(nxt);
            if constexpr (SP2) {
            PG8_LDB(B0, 0, 0); PG8_LDB(B1, 0, 1); PG8_SCHED; PG8_LDA(At, 0, 0); PG8_STAGE(PG8_SA(1, 1), a1 + hstep, voffA);
            PG8_WAIT_V(8); PG8_WAIT_L(0); PG8_BAR; PG8_MMA(0, 0, At, B0); PG8_MMA(0, 1, At, B1); PG8_BAR; PG8_SCHED;
            PG8_LDA(At, 0, 1); PG8_STAGE(PG8_SB(0, 0), b2, voffB); PG8_STAGE(PG8_SB(0, 1), b2 + hstep, voffB); PG8_STAGE(PG8_SA(0, 0), a2, voffA);
            PG8_WAIT_V(8); PG8_WAIT_L(0); PG8_BAR; PG8_MMA(1, 0, At, B0); PG8_MMA(1, 1, At, B1); PG8_BAR; PG8_SCHED;
            PG8_LDB(B0, 1, 0); PG8_LDB(B1, 1, 1); PG8_SCHED; PG8_LDA(At, 1, 0); PG8_STAGE(PG8_SA(0, 1), a2 + hstep, voffA);
            PG8_WAIT_V(8); PG8_WAIT_L(0); PG8_BAR; PG8_MMA(0, 0, At, B0); PG8_MMA(0, 1, At, B1); PG8_BAR; PG8_SCHED;
            PG8_LDA(At, 1, 1); PG8_STAGE(PG8_SB(1, 0), b3, voffB); PG8_STAGE(PG8_SB(1, 1), b3 + hstep, voffB); PG8_STAGE(PG8_SA(1, 0), a3, voffA);
            PG8_WAIT_V(8); PG8_WAIT_L(0); PG8_BAR; PG8_MMA(1, 0, At, B0); PG8_MMA(1, 1, At, B1); PG8_BAR; PG8_SCHED;
            } else {
            PG8_LDB(B0, 0, 0); PG8_SCHED; PG8_LDA(At, 0, 0); PG8_STAGE(PG8_SA(1, 1), a1 + hstep, voffA);
            PG8_WAIT_L(8); PG8_BAR; PG8_WAIT_L(0); PG8_MMA(0, 0, At, B0); PG8_BAR; PG8_SCHED;
            PG8_LDB(B1, 0, 1); PG8_STAGE(PG8_SB(0, 0), b2, voffB);
            PG8_BAR; PG8_WAIT_L(0); PG8_MMA(0, 1, At, B1); PG8_BAR;
            PG8_LDA(At, 0, 1); PG8_STAGE(PG8_SA(0, 0), a2, voffA);
            PG8_BAR; PG8_WAIT_L(0); PG8_MMA(1, 0, At, B0); PG8_BAR; PG8_SCHED;
            PG8_STAGE(PG8_SB(0, 1), b2 + hstep, voffB);
            PG8_WAIT_V(6); PG8_BAR; PG8_MMA(1, 1, At, B1); PG8_BAR;
            PG8_LDB(B0, 1, 0); PG8_SCHED; PG8_LDA(At, 1, 0); PG8_STAGE(PG8_SA(0, 1), a2 + hstep, voffA);
            PG8_WAIT_L(8); PG8_BAR; PG8_WAIT_L(0); PG8_MMA(0, 0, At, B0); PG8_BAR; PG8_SCHED;
            PG8_LDB(B1, 1, 1); PG8_STAGE(PG8_SB(1, 0), b3, voffB);
            PG8_BAR; PG8_WAIT_L(0); PG8_MMA(0, 1, At, B1); PG8_BAR;
            PG8_LDA(At, 1, 1); PG8_STAGE(PG8_SA(1, 0), a3, voffA);
            PG8_BAR; PG8_WAIT_L(0); PG8_MMA(1, 0, At, B0); PG8_BAR; PG8_SCHED;
            PG8_STAGE(PG8_SB(1, 1), b3 + hstep, voffB);
            PG8_WAIT_V(6); PG8_BAR; PG8_MMA(1, 1, At, B1); PG8_BAR;
            }
        }
        if constexpr (ALIGN_EPI) { if (wr == 0) PG8_BAR; }
        if constexpr (!Epi::AFTER_DRAIN) { E(acc, cur, wr, wc, fr, fq); S.done(cur); }
        if (!has_next) break;
#pragma unroll
        for (int a = 0; a < 2; ++a)
#pragma unroll
            for (int b = 0; b < 2; ++b)
#pragma unroll
                for (int m = 0; m < 4; ++m)
#pragma unroll
                    for (int n = 0; n < 2; ++n) acc[a][b][m][n] = (f32x4){0.f, 0.f, 0.f, 0.f};
        cur = nxt; cA = nA; cB = nB; ++ui;
        if constexpr (ALIGN_EPI) { if (wr == 1) PG8_BAR; }
    }
    PG8_WAIT_V(0);
    if constexpr (!ALIGN_EPI) { if (wr == 0) PG8_BAR; }
    PG8_BAR;
    if constexpr (Epi::AFTER_DRAIN) { E.fused(acc, cur, wr, wc, fr, fq, lds, wid, lane); S.done(cur); }
#undef PG8_SA
#undef PG8_SB
#undef PG8_STAGE
#undef PG8_LDA
#undef PG8_LDB
#undef PG8_MMA
#undef PG8_WAIT_V
#undef PG8_WAIT_L
#undef PG8_BAR
#undef PG8_SCHED
}
}
using namespace pg8;
#define LAS __attribute__((address_space(3)))
typedef LAS unsigned char* ldsp;
typedef float f32x16 __attribute__((ext_vector_type(16)));
#define LDS_WAIT() asm volatile("s_waitcnt lgkmcnt(0)" ::: "memory")

constexpr int M_ALL = 16896;
constexpr int PLD = 3584;
constexpr size_t MiB = 1u << 20;
constexpr size_t WS_W0 = 2 * MiB, WS_WL = 32 * MiB;
constexpr size_t W_IN = 0, W_OUT = 7 * MiB, W_MQ = 9 * MiB, W_MO = 10 * MiB, W_1 = 11 * MiB, W_2 = 19 * MiB;
constexpr size_t WS_WMKV = 66 * MiB;
constexpr size_t WS_XB = 80 * MiB, WS_X = 128 * MiB, WS_SSQ = 196 * MiB, WS_MEMB = 198 * MiB, WS_MEMSSQ = 199 * MiB, WS_RSTD = 199 * MiB + 65536, WS_MEMRSTD = 199 * MiB + 196608;
constexpr size_t WS_PROJ = 256 * MiB, WS_OSB = 512 * MiB, WS_MIX = 560 * MiB, WS_DS = 608 * MiB, WS_DD = 672 * MiB;
constexpr size_t WS_QM = 688 * MiB, WS_OM = 720 * MiB, WS_H = 768 * MiB, WS_PART = 904 * MiB, WS_VT = 940 * MiB, WS_KB = 960 * MiB, WS_MKB = 980 * MiB, WS_MVT = 982 * MiB;
constexpr int LDS_BYTES = 147456;
constexpr size_t WS_BAR = 65536;
constexpr size_t WS_CTR = 65536 + 16384;
constexpr int LDS_BARST = 131072 + 1024;

__device__ __forceinline__ float wave_sum(float v) {
#pragma unroll
    for (int o = 1; o < 64; o <<= 1) v += __shfl_xor(v, o);
    return v;
}
typedef float f32x2_t __attribute__((ext_vector_type(2))); typedef __bf16 bf16x2_t __attribute__((ext_vector_type(2)));
__device__ __forceinline__ unsigned pk2(float lo, float hi) { const f32x2_t v = {lo, hi}; const bf16x2_t b = __builtin_convertvector(v, bf16x2_t); return __builtin_bit_cast(unsigned, b); }
__device__ __forceinline__ unsigned f2bf(float f) { return pk2(f, f) & 0xffffu; }
__device__ __forceinline__ bf16x8 pack8(float a, float b, float c, float d, float e, float f, float g, float h) { return __builtin_bit_cast(bf16x8, (u32x4){pk2(a, b), pk2(c, d), pk2(e, f), pk2(g, h)}); }
__device__ __forceinline__ float fexp(float x) { return __builtin_amdgcn_exp2f(x * 1.4426950408889634f); }
__device__ __forceinline__ float flog(float x) { return __builtin_amdgcn_logf(x) * 0.6931471805599453f; }
__device__ __forceinline__ int crow(int i, int hi) { return (i & 3) + 8 * (i >> 2) + 4 * hi; }
#define MFMA32(a, b, c) __builtin_amdgcn_mfma_f32_32x32x16_bf16((a), (b), (c), 0, 0, 0)
#define MFMA16(a, b, c) __builtin_amdgcn_mfma_f32_16x16x32_bf16((a), (b), (c), 0, 0, 0)

__device__ __forceinline__ void transpose_item(const float* W, int K, int N, bf16_t* WT, int row_off, const float* gain, LAS float* scr, int item, int lane) {
    const int nblk = N / 32, kb = item / nblk, nb = item % nblk, k0 = 64 * kb, n0 = 32 * nb;
    float wv[32], gv[32];
#pragma unroll
    for (int i = 0; i < 32; ++i) { const int kk = 2 * i + (lane >> 5); wv[i] = W[(size_t)(k0 + kk) * N + n0 + (lane & 31)]; gv[i] = gain ? gain[k0 + kk] : 1.f; }
#pragma unroll
    for (int i = 0; i < 32; ++i) { const int kk = 2 * i + (lane >> 5); scr[kk * 33 + (lane & 31)] = wv[i] * gv[i]; }
    LDS_WAIT(); asm volatile("" ::: "memory");
    const int c = lane & 7;
#pragma unroll
    for (int j = 0; j < 4; ++j) { const int n = (lane >> 3) + 8 * j; const LAS float* s = scr + (8 * c) * 33 + n;
        u32x4 o; o.x = pk2(s[0 * 33], s[1 * 33]); o.y = pk2(s[2 * 33], s[3 * 33]); o.z = pk2(s[4 * 33], s[5 * 33]); o.w = pk2(s[6 * 33], s[7 * 33]);
        *(u32x4*)(WT + (size_t)(row_off + n0 + n) * K + k0 + 8 * c) = o; }
    LDS_WAIT(); asm volatile("" ::: "memory");
}
__device__ __forceinline__ void row_prep2(const float* srcA, bf16_t* dstA, float* sqA, float* rsA, const float* srcB, bf16_t* dstB, float* sqB, float* rsB, bool hasB, int lane) {
    const f32x4* xa = (const f32x4*)srcA + lane; const f32x4* xb = (const f32x4*)srcB + lane; f32x4 va[4], vb[4]; float sa = 0.f, sb = 0.f;
#pragma unroll
    for (int j = 0; j < 4; ++j) { va[j] = xa[64 * j]; vb[j] = xb[64 * j]; }
#pragma unroll
    for (int j = 0; j < 4; ++j) { sa += (va[j][0] * va[j][0] + va[j][1] * va[j][1]) + (va[j][2] * va[j][2] + va[j][3] * va[j][3]); sb += (vb[j][0] * vb[j][0] + vb[j][1] * vb[j][1]) + (vb[j][2] * vb[j][2] + vb[j][3] * vb[j][3]); }
    sa = wave_sum(sa); sb = wave_sum(sb);
    u32x2* oa = (u32x2*)dstA + lane; u32x2* ob = (u32x2*)dstB + lane;
#pragma unroll
    for (int j = 0; j < 4; ++j) { u32x2 w; w.x = pk2(va[j][0], va[j][1]); w.y = pk2(va[j][2], va[j][3]); oa[64 * j] = w;
        if (hasB) { u32x2 w2; w2.x = pk2(vb[j][0], vb[j][1]); w2.y = pk2(vb[j][2], vb[j][3]); ob[64 * j] = w2; } }
    if (lane < 16) { sqA[lane] = lane == 0 ? sa : 0.f; if (hasB) sqB[lane] = lane == 0 ? sb : 0.f; }
    if (lane == 0) { *rsA = rsqrtf(sa * (1.0f / 1024.0f) + 1e-6f); if (hasB) *rsB = rsqrtf(sb * (1.0f / 1024.0f) + 1e-6f); }
}
template <bool SAMPLE> __device__ __forceinline__ void sb_item(int item, int layer, const float* PROJ, const float* KP, const float* VP, const float* KS, const float* VS,
                                        const float* CK, const float* CV, const bf16_t* VT, const bf16_t* KB, float* OSB, int lane) {
    const int r32 = lane & 31, hi = lane >> 5;
    int qrow, qpos, ptop, split, h, qmin; bool qvalid; const float *kA, *vA, *kB, *vB;
    const bf16_t* VTh = VT; const bf16_t* KBh = KB;
    if (!SAMPLE) { const int b = item >> 11, rem = item & 2047, qt = rem & 255; h = rem >> 8; VTh = VT + ((size_t)(b * 8 + h) * 2048 * 64 + r32) * 4; KBh = KB + ((size_t)(b * 8 + h) * 256 * 8 * 32 + hi * 32 + r32) * 8;
        qrow = b * 8192 + qt * 32 + r32; qpos = qt * 32 + r32; qvalid = true; ptop = qt * 32; split = 1 << 30; qmin = qt * 32;
        kA = KP + (size_t)(b * 8192) * 512 + h * 64; vA = VP + (size_t)(b * 8192) * 512 + h * 64; kB = kA; vB = vA;
    } else { const int it = item - 4096, s = it >> 3; h = it & 7;
        qrow = NPROMPT + s * 16 + (r32 & 15); qpos = 2048 + (r32 & 15); qvalid = r32 < 16; ptop = 2032; split = 2048; qmin = 2048;
        kA = CK + (size_t)((layer * 32 + s) * 2048) * 512 + h * 64; vA = CV + (size_t)((layer * 32 + s) * 2048) * 512 + h * 64;
        kB = KS + ((long)(s * 16) - 2048) * 512 + h * 64; vB = VS + ((long)(s * 16) - 2048) * 512 + h * 64; }
    bf16x8 qh[4];
    { const bf16_t* qp = (const bf16_t*)PROJ + (size_t)qrow * PLD + h * 64 + 8 * hi;
#pragma unroll
      for (int ds = 0; ds < 4; ++ds) qh[ds] = *(const bf16x8*)(qp + 16 * ds); }
    f32x16 oacc[2];
#pragma unroll
    for (int i = 0; i < 16; ++i) { oacc[0][i] = 0.f; oacc[1][i] = 0.f; }
    float carry = 0.f;
    f32x4 kraw[8]; float vraw[2][2][8]; u32x2 vpk[2][2][2]; bf16x8 kq[4];
#define SB_LOAD_TILE(P0) do { if (SAMPLE) { const int pr_ = (P0) + r32, prc_ = pr_ < 0 ? 0 : pr_; const float* kp_ = (prc_ >= split ? kB : kA) + (long)prc_ * 512 + 8 * hi; \
        _Pragma("unroll") for (int ds = 0; ds < 4; ++ds) { kraw[2 * ds] = *(const f32x4*)(kp_ + 16 * ds); kraw[2 * ds + 1] = *(const f32x4*)(kp_ + 16 * ds + 4); } } \
        else { const int pq_ = (P0) < 0 ? 0 : (P0); _Pragma("unroll") for (int ds = 0; ds < 4; ++ds) kq[ds] = *(const bf16x8*)(KBh + ((size_t)(pq_ >> 5) * 8 + 2 * ds) * 32 * 8); } \
        if (SAMPLE) { _Pragma("unroll") for (int t = 0; t < 2; ++t) _Pragma("unroll") for (int j = 0; j < 8; ++j) { const int pk_ = (P0) + 16 * t + 8 * (j >> 2) + 4 * hi + (j & 3), pkc_ = pk_ < 0 ? 0 : pk_; \
            const float* vp_ = (pkc_ >= split ? vB : vA) + (long)pkc_ * 512 + r32; vraw[t][0][j] = vp_[0]; vraw[t][1][j] = vp_[32]; } } \
        else { const int pc_ = (P0) < 0 ? 0 : (P0); _Pragma("unroll") for (int t = 0; t < 2; ++t) _Pragma("unroll") for (int dt = 0; dt < 2; ++dt) { const bf16_t* vq_ = VTh + ((size_t)((pc_ >> 2) + 4 * t + hi) * 64 + dt * 32) * 4; \
            vpk[t][dt][0] = *(const u32x2*)vq_; vpk[t][dt][1] = *(const u32x2*)(vq_ + 2 * 64 * 4); } } } while (0)
    SB_LOAD_TILE(ptop);
    for (int p0 = ptop; p0 > -32; p0 -= 32) {
        bf16x8 kf[4], va[2][2];
#pragma unroll
        for (int ds = 0; ds < 4; ++ds) { if (SAMPLE) kf[ds] = pack8(kraw[2 * ds][0], kraw[2 * ds][1], kraw[2 * ds][2], kraw[2 * ds][3], kraw[2 * ds + 1][0], kraw[2 * ds + 1][1], kraw[2 * ds + 1][2], kraw[2 * ds + 1][3]); else kf[ds] = kq[ds]; }
#pragma unroll
        for (int t = 0; t < 2; ++t)
#pragma unroll
            for (int dt = 0; dt < 2; ++dt) { if (SAMPLE) va[t][dt] = pack8(vraw[t][dt][0], vraw[t][dt][1], vraw[t][dt][2], vraw[t][dt][3], vraw[t][dt][4], vraw[t][dt][5], vraw[t][dt][6], vraw[t][dt][7]);
                else va[t][dt] = __builtin_bit_cast(bf16x8, (u32x4){vpk[t][dt][0].x, vpk[t][dt][0].y, vpk[t][dt][1].x, vpk[t][dt][1].y}); }
        SB_LOAD_TILE(p0 - 32);
        asm volatile("" ::: "memory");
        f32x16 acc;
#pragma unroll
        for (int i = 0; i < 16; ++i) acc[i] = 0.f;
#pragma unroll
        for (int ds = 0; ds < 4; ++ds) acc = MFMA32(kf[ds], qh[ds], acc);
        float L[16], ls[16];
        if (p0 >= 0 && p0 + 32 <= qmin) {
#pragma unroll
            for (int i = 0; i < 16; ++i) { const float z = acc[i]; const float sp = fmaxf(z, 0.f) + flog(1.f + fexp(-fabsf(z))); L[i] = -sp; ls[i] = z - sp; }
        } else {
#pragma unroll
            for (int i = 0; i < 16; ++i) { const int kpos = p0 + crow(i, hi); const bool valid = (kpos < qpos) && (kpos >= 0); const float z = acc[i];
                const float sp = fmaxf(z, 0.f) + flog(1.f + fexp(-fabsf(z)));
                L[i] = valid ? -sp : 0.f; ls[i] = valid ? (z - sp) : -1e30f; }
        }
        float G[4], PG[4], T[4];
#pragma unroll
        for (int g = 0; g < 4; ++g) { G[g] = (L[4 * g] + L[4 * g + 1]) + (L[4 * g + 2] + L[4 * g + 3]); PG[g] = __shfl_xor(G[g], 32); T[g] = G[g] + PG[g]; }
        float A[4]; A[3] = 0.f; A[2] = T[3]; A[1] = T[3] + T[2]; A[0] = A[1] + T[1];
        float P[16];
#pragma unroll
        for (int g = 0; g < 4; ++g) { const float e3 = carry + A[g] + (hi == 0 ? PG[g] : 0.f), e2 = e3 + L[4 * g + 3], e1 = e2 + L[4 * g + 2], e0 = e1 + L[4 * g + 1];
            P[4 * g + 3] = fexp(ls[4 * g + 3] + e3); P[4 * g + 2] = fexp(ls[4 * g + 2] + e2); P[4 * g + 1] = fexp(ls[4 * g + 1] + e1); P[4 * g] = fexp(ls[4 * g] + e0); }
        carry += (T[0] + T[1]) + (T[2] + T[3]);
#pragma unroll
        for (int t = 0; t < 2; ++t) { const bf16x8 pb = pack8(P[8 * t], P[8 * t + 1], P[8 * t + 2], P[8 * t + 3], P[8 * t + 4], P[8 * t + 5], P[8 * t + 6], P[8 * t + 7]);
            oacc[0] = MFMA32(va[t][0], pb, oacc[0]); oacc[1] = MFMA32(va[t][1], pb, oacc[1]); }
        if (__all(carry < -110.0f)) break;
    }
    if (qvalid) { float* op = OSB + (size_t)qrow * 512 + h * 64 + 4 * hi;
#pragma unroll
        for (int dt = 0; dt < 2; ++dt)
#pragma unroll
            for (int g = 0; g < 4; ++g) *(f32x4*)(op + dt * 32 + 8 * g) = (f32x4){oacc[dt][4 * g], oacc[dt][4 * g + 1], oacc[dt][4 * g + 2], oacc[dt][4 * g + 3]}; }
}

__device__ __forceinline__ void hg_load(const float* PROJ, int row0, int tvalid, int h, int tg, int k, int coff, float (&zr)[16]) {
#pragma unroll
    for (int j = 0; j < 16; ++j) { const int t = 16 * tg + j, tc = t < tvalid ? t : 0; zr[j] = __uint_as_float((unsigned)((const bf16_t*)PROJ)[(size_t)(row0 + tc) * PLD + coff + h * 128 + k] << 16); }
}
__device__ __forceinline__ void hg_prep(const float (&zr)[16], const float (&qr)[16], int tvalid, float lbv, int tg, float (&loc)[16], float (&kk)[16], float (&qv)[16]) {
    float run = 0.f;
#pragma unroll
    for (int j = 0; j < 16; ++j) { const int t = 16 * tg + j; const bool ok = t < tvalid; const float z = ok ? zr[j] : 0.f, q = ok ? qr[j] : 0.f;
        const float ez = fexp(-fabsf(z)), inv = __builtin_amdgcn_rcpf(1.f + ez);
        const float sig = z >= 0.f ? inv : ez * inv, nsig = z >= 0.f ? ez * inv : inv;
        float lf = (lbv > 0.f) ? flog(lbv + (1.f - lbv) * sig) : (fminf(z, 0.f) - flog(1.f + ez));
        if (!ok) lf = 0.f;
        run += lf; loc[j] = run; kk[j] = ok ? (1.f - lbv) * nsig : 0.f; qv[j] = q * 0.08838834764831845f; }
}
__device__ __forceinline__ void hg_h1(ldsp lds, const float* PROJ, const float (&zr)[16], int row0, int tvalid, int h, float lbv, float* dsOut, float* ddOut, const float* s0, int tid, int lane, int wave) {
    const int tg = tid >> 7, k = tid & 127;
    float loc[16], kk[16], qv[16], iv[16];
#pragma unroll
    for (int j = 0; j < 16; ++j) { const int ta = 16 * tg + j, tc = ta < tvalid ? ta : 0; const float x = __uint_as_float((unsigned)((const bf16_t*)PROJ)[(size_t)(row0 + tc) * PLD + 2560 + h * 128 + k] << 16); iv[j] = ta < tvalid ? x : 0.f; }
    hg_prep(zr, zr, tvalid, lbv, tg, loc, kk, qv);
    LAS float* TOT = (LAS float*)lds; LAS float* DK = (LAS float*)(lds + 2048);
    TOT[tg * 128 + k] = loc[15];
    __syncthreads();
    const float t0 = TOT[k], t1 = TOT[128 + k], t2 = TOT[256 + k], t3 = TOT[384 + k];
    const float r1 = t0, r2 = r1 + t1, r3 = r2 + t2, r4 = r3 + t3;
    const float rtg = tg == 0 ? 0.f : (tg == 1 ? r1 : (tg == 2 ? r2 : r3));
    { unsigned w[8];
#pragma unroll
      for (int jj = 0; jj < 8; ++jj) w[jj] = pk2(kk[2 * jj] * fexp(r4 - rtg - loc[2 * jj]), kk[2 * jj + 1] * fexp(r4 - rtg - loc[2 * jj + 1]));
      *(LAS u32x4*)(lds + 4096 + k * 144 + tg * 32) = (u32x4){w[0], w[1], w[2], w[3]}; *(LAS u32x4*)(lds + 4096 + k * 144 + tg * 32 + 16) = (u32x4){w[4], w[5], w[6], w[7]};
#pragma unroll
      for (int jj = 0; jj < 8; ++jj) w[jj] = pk2(iv[2 * jj], iv[2 * jj + 1]);
      *(LAS u32x4*)(lds + 22528 + k * 144 + tg * 32) = (u32x4){w[0], w[1], w[2], w[3]}; *(LAS u32x4*)(lds + 22528 + k * 144 + tg * 32 + 16) = (u32x4){w[4], w[5], w[6], w[7]}; }
    if (tg == 0) { const float dk = fexp(r4); DK[k] = dk; if (ddOut) ddOut[k] = dk; }
    __syncthreads();
    const int r32 = lane & 31, hi = lane >> 5, km = wave & 3, vn0 = (wave >> 2) * 2;
#pragma unroll
    for (int vv = 0; vv < 2; ++vv) { f32x16 acc;
#pragma unroll
        for (int i = 0; i < 16; ++i) acc[i] = 0.f;
#pragma unroll
        for (int ks = 0; ks < 4; ++ks) { const bf16x8 a = *(LAS bf16x8*)(lds + 4096 + (32 * km + r32) * 144 + ks * 32 + hi * 16);
            const bf16x8 b = *(LAS bf16x8*)(lds + 22528 + (32 * (vn0 + vv) + r32) * 144 + ks * 32 + hi * 16); acc = MFMA32(a, b, acc); }
        const int v = 32 * (vn0 + vv) + r32;
#pragma unroll
        for (int i = 0; i < 16; ++i) { if (s0) { const int kr = 32 * km + crow(i, hi); dsOut[kr * 128 + v] = acc[i] + DK[kr] * s0[kr * 128 + v]; } }
        if (!s0) { bf16_t* db = (bf16_t*)dsOut + v * 128 + 32 * km + 4 * hi;
#pragma unroll
            for (int g = 0; g < 4; ++g) *(u32x2*)(db + 8 * g) = (u32x2){pk2(acc[4 * g], acc[4 * g + 1]), pk2(acc[4 * g + 2], acc[4 * g + 3])}; } }
    __syncthreads();
}
__device__ __forceinline__ void hg_h3(ldsp lds, const float* PROJ, const float (&zr)[16], int row0, int tvalid, int h, float lbv, const float* Ssrc, bool sbf, const float* hgain, bf16_t* MIX, int tid, int lane, int wave) {
    constexpr int QE = 2048, KE = 19456, ST = 62976, IV = 97792, PM = 116224, OST = 19456;
    const int tg = tid >> 7, k = tid & 127;
    float loc[16], kk[16], qv[16];
    f32x4 gv[4], gav[4];
    float qr[16]; hg_load(PROJ, row0, tvalid, h, tg, k, 1536, qr);
    hg_prep(zr, qr, tvalid, lbv, tg, loc, kk, qv);
    LAS float* TOT = (LAS float*)lds;
    TOT[tg * 128 + k] = loc[15];
    for (int i = tid; i < 2304; i += 512) ((LAS unsigned*)(lds + PM))[i] = 0u;
    if (sbf) {
#pragma unroll
        for (int jj = 0; jj < 4; ++jj) { const int cidx = tid + 512 * jj, v = cidx >> 4, kc = cidx & 15;
            *(LAS u32x4*)(lds + ST + v * 272 + kc * 16) = *(const u32x4*)((const bf16_t*)Ssrc + v * 128 + kc * 8); }
    } else {
#pragma unroll
        for (int jj = 0; jj < 16; ++jj) { const int kp = 2 * ((tid >> 7) + 4 * jj), v = tid & 127;
            *(LAS unsigned*)(lds + ST + v * 272 + kp * 2) = pk2(Ssrc[kp * 128 + v], Ssrc[(kp + 1) * 128 + v]); } }
    { unsigned w[8];
#pragma unroll
      for (int jj = 0; jj < 8; ++jj) { const int ta = 16 * tg + 2 * jj, t0 = ta < tvalid ? ta : 0, t1 = (ta + 1) < tvalid ? ta + 1 : 0;
          const float x0 = __uint_as_float((unsigned)((const bf16_t*)PROJ)[(size_t)(row0 + t0) * PLD + 2560 + h * 128 + k] << 16), x1 = __uint_as_float((unsigned)((const bf16_t*)PROJ)[(size_t)(row0 + t1) * PLD + 2560 + h * 128 + k] << 16);
          w[jj] = pk2(ta < tvalid ? x0 : 0.f, (ta + 1) < tvalid ? x1 : 0.f); }
      *(LAS u32x4*)(lds + IV + k * 144 + tg * 32) = (u32x4){w[0], w[1], w[2], w[3]}; *(LAS u32x4*)(lds + IV + k * 144 + tg * 32 + 16) = (u32x4){w[4], w[5], w[6], w[7]}; }
    __syncthreads();
    { const int t = tid >> 3, v0 = (tid & 7) * 16; const int tc = t < tvalid ? t : 0; const bf16_t* gp = (const bf16_t*)PROJ + (size_t)(row0 + tc) * PLD + 3072 + h * 128 + v0; const float* hg = hgain + h * 128 + v0;
      const u32x4 g0 = *(const u32x4*)gp, g1 = *(const u32x4*)(gp + 8);
      gv[0] = (f32x4){__uint_as_float(g0.x << 16), __uint_as_float(g0.x & 0xffff0000u), __uint_as_float(g0.y << 16), __uint_as_float(g0.y & 0xffff0000u)};
      gv[1] = (f32x4){__uint_as_float(g0.z << 16), __uint_as_float(g0.z & 0xffff0000u), __uint_as_float(g0.w << 16), __uint_as_float(g0.w & 0xffff0000u)};
      gv[2] = (f32x4){__uint_as_float(g1.x << 16), __uint_as_float(g1.x & 0xffff0000u), __uint_as_float(g1.y << 16), __uint_as_float(g1.y & 0xffff0000u)};
      gv[3] = (f32x4){__uint_as_float(g1.z << 16), __uint_as_float(g1.z & 0xffff0000u), __uint_as_float(g1.w << 16), __uint_as_float(g1.w & 0xffff0000u)};
#pragma unroll
      for (int c = 0; c < 4; ++c) gav[c] = *(const f32x4*)(hg + 4 * c); }
    const float t0 = TOT[k], t1 = TOT[128 + k], t2 = TOT[256 + k];
    const float r1 = t0, r2 = r1 + t1, r3 = r2 + t2;
    const float rtg = tg == 0 ? 0.f : (tg == 1 ? r1 : (tg == 2 ? r2 : r3));
#pragma unroll
    for (int j = 0; j < 16; ++j) *(LAS unsigned short*)(lds + QE + (16 * tg + j) * 272 + k * 2) = (unsigned short)f2bf(qv[j] * fexp(loc[j]));
#pragma unroll
    for (int i = 0; i < 4; ++i) { if (i >= tg) { const float ri = i == 0 ? 0.f : (i == 1 ? r1 : (i == 2 ? r2 : r3)); const int rb = 8 * i * (i + 1);
#pragma unroll
        for (int j = 0; j < 16; ++j) *(LAS unsigned short*)(lds + KE + (rb + 16 * tg + j) * 272 + k * 2) = (unsigned short)f2bf(kk[j] * fexp(fminf(ri - rtg - loc[j], 80.f))); } }
    __syncthreads();
    { const int c16 = lane & 15, q4 = lane >> 4;
      for (int tix = wave; tix < 10; tix += 8) { const int i = tix < 1 ? 0 : (tix < 3 ? 1 : (tix < 6 ? 2 : 3)), j = tix - i * (i + 1) / 2, rb = 8 * i * (i + 1);
          f32x4 acc = {0.f, 0.f, 0.f, 0.f};
#pragma unroll
          for (int ks = 0; ks < 4; ++ks) { const bf16x8 a = *(LAS bf16x8*)(lds + QE + (16 * i + c16) * 272 + ks * 64 + q4 * 16);
              const bf16x8 b = *(LAS bf16x8*)(lds + KE + (rb + 16 * j + c16) * 272 + ks * 64 + q4 * 16); acc = MFMA16(a, b, acc); }
#pragma unroll
          for (int ii = 0; ii < 4; ++ii) { const int tl = 4 * q4 + ii; float pv = acc[ii]; if (i == j && c16 > tl) pv = 0.f;
              *(LAS unsigned short*)(lds + PM + (16 * i + tl) * 144 + (16 * j + c16) * 2) = (unsigned short)f2bf(pv); } } }
    __syncthreads();
#pragma unroll
    for (int j = 0; j < 16; ++j) *(LAS unsigned short*)(lds + QE + (16 * tg + j) * 272 + k * 2) = (unsigned short)f2bf(qv[j] * fexp(rtg + loc[j]));
    __syncthreads();
    { const int r32 = lane & 31, hi = lane >> 5, tm = wave & 1, vn = wave >> 1; f32x16 acc;
#pragma unroll
      for (int i = 0; i < 16; ++i) acc[i] = 0.f;
#pragma unroll
      for (int ks = 0; ks < 8; ++ks) { const bf16x8 a = *(LAS bf16x8*)(lds + QE + (32 * tm + r32) * 272 + ks * 32 + hi * 16);
          const bf16x8 b = *(LAS bf16x8*)(lds + ST + (32 * vn + r32) * 272 + ks * 32 + hi * 16); acc = MFMA32(a, b, acc); }
#pragma unroll
      for (int ks = 0; ks < 4; ++ks) { const bf16x8 a = *(LAS bf16x8*)(lds + PM + (32 * tm + r32) * 144 + ks * 32 + hi * 16);
          const bf16x8 b = *(LAS bf16x8*)(lds + IV + (32 * vn + r32) * 144 + ks * 32 + hi * 16); acc = MFMA32(a, b, acc); }
#pragma unroll
      for (int i = 0; i < 16; ++i) *(LAS float*)(lds + OST + (32 * tm + crow(i, hi)) * 528 + (32 * vn + r32) * 4) = acc[i]; }
    __syncthreads();
    { const int t = tid >> 3, v0 = (tid & 7) * 16; f32x4 o[4]; float ss = 0.f;
#pragma unroll
      for (int c = 0; c < 4; ++c) { o[c] = *(LAS f32x4*)(lds + OST + t * 528 + (v0 + 4 * c) * 4); ss += (o[c][0] * o[c][0] + o[c][1] * o[c][1]) + (o[c][2] * o[c][2] + o[c][3] * o[c][3]); }
      ss += __shfl_xor(ss, 1); ss += __shfl_xor(ss, 2); ss += __shfl_xor(ss, 4);
      const float rs = rsqrtf(ss * (1.0f / 128.0f) + 1e-6f);
      if (t < tvalid) { const size_t row = (size_t)(row0 + t); unsigned w[8];
#pragma unroll
          for (int c = 0; c < 4; ++c) { const f32x4 g = gv[c], ga = gav[c]; f32x4 r;
#pragma unroll
              for (int e = 0; e < 4; ++e) r[e] = o[c][e] * rs * ga[e] * (g[e] * __builtin_amdgcn_rcpf(1.f + fexp(-g[e])));
              w[2 * c] = pk2(r[0], r[1]); w[2 * c + 1] = pk2(r[2], r[3]); }
          bf16_t* mp = MIX + row * 1024 + 512 + h * 128 + v0;
          *(u32x4*)mp = (u32x4){w[0], w[1], w[2], w[3]}; *(u32x4*)(mp + 8) = (u32x4){w[4], w[5], w[6], w[7]}; } }
    __syncthreads();
}

__device__ __forceinline__ void xattn_item(ldsp lds, const bf16_t* QM, const float* Kg, const float* Vg, const bf16_t* Kb, const bf16_t* Vtb, int row0, int tvalid, int hm, bf16_t* OM, int tid, int lane, int wave) {
    constexpr int KM = 0, QS = 69632, PMX = 87040, RMO = 120832, RSO = 121344, VT = 0;
    if (Kb) {
#pragma unroll
        for (int jj = 0; jj < 8; ++jj) { const int cidx = tid + 512 * jj, m = cidx >> 4, dc = cidx & 15; *(LAS u32x4*)(lds + KM + m * 272 + dc * 16) = *(const u32x4*)(Kb + m * 128 + dc * 8); }
    } else {
#pragma unroll
        for (int jj = 0; jj < 8; ++jj) { const int cidx = tid + 512 * jj, m = cidx >> 4, dc = cidx & 15; const float* p = Kg + (size_t)m * 512 + dc * 8;
            const f32x4 a = *(const f32x4*)p, b = *(const f32x4*)(p + 4);
            *(LAS u32x4*)(lds + KM + m * 272 + dc * 16) = (u32x4){pk2(a[0], a[1]), pk2(a[2], a[3]), pk2(b[0], b[1]), pk2(b[2], b[3])}; } }
#pragma unroll
    for (int jj = 0; jj < 2; ++jj) { const int cidx = tid + 512 * jj, t = cidx >> 4, dc = cidx & 15; u32x4 w = {0u, 0u, 0u, 0u};
        if (t < tvalid) w = *(const u32x4*)(QM + (size_t)(row0 + t) * 512 + hm * 128 + dc * 8);
        *(LAS u32x4*)(lds + QS + t * 272 + dc * 16) = w; }
    float vr0[32], vr1[32]; u32x4 vq[8];
    if (Vtb) {
#pragma unroll
        for (int jj = 0; jj < 8; ++jj) { const int cidx = tid + 512 * jj, d = cidx >> 5, mc = cidx & 31; vq[jj] = *(const u32x4*)(Vtb + d * 256 + mc * 8); }
    } else {
#pragma unroll
        for (int jj = 0; jj < 32; ++jj) { const int idx = tid + 512 * jj, d = idx & 127, mp = idx >> 7; vr0[jj] = Vg[(size_t)(2 * mp) * 512 + d]; vr1[jj] = Vg[(size_t)(2 * mp + 1) * 512 + d]; } }
    __syncthreads();
    const int tgp = wave & 3, mh = wave >> 2, c16 = lane & 15, q4 = lane >> 4, tok = 16 * tgp + c16;
    LAS float* RM = (LAS float*)(lds + RMO); LAS float* RS = (LAS float*)(lds + RSO);
    f32x4 sacc[8];
    { bf16x8 bq[4];
#pragma unroll
      for (int ks = 0; ks < 4; ++ks) bq[ks] = *(LAS bf16x8*)(lds + QS + tok * 272 + ks * 64 + q4 * 16);
#pragma unroll
      for (int j = 0; j < 8; ++j) { f32x4 acc = {0.f, 0.f, 0.f, 0.f};
#pragma unroll
          for (int ks = 0; ks < 4; ++ks) { const bf16x8 a = *(LAS bf16x8*)(lds + KM + (128 * mh + 16 * j + c16) * 272 + ks * 64 + q4 * 16); acc = MFMA16(a, bq[ks], acc); }
          sacc[j] = acc; } }
    float mx = -3.0e38f;
#pragma unroll
    for (int j = 0; j < 8; ++j) mx = fmaxf(fmaxf(mx, fmaxf(sacc[j][0], sacc[j][1])), fmaxf(sacc[j][2], sacc[j][3]));
    mx = fmaxf(mx, __shfl_xor(mx, 16)); mx = fmaxf(mx, __shfl_xor(mx, 32));
    if (q4 == 0) RM[mh * 64 + tok] = mx;
    __syncthreads();
    { const float m = fmaxf(RM[tok], RM[64 + tok]); float sum = 0.f;
#pragma unroll
      for (int j = 0; j < 8; ++j) { const float p0 = fexp(sacc[j][0] - m), p1 = fexp(sacc[j][1] - m), p2 = fexp(sacc[j][2] - m), p3 = fexp(sacc[j][3] - m);
          sum += (p0 + p1) + (p2 + p3);
          *(LAS u32x2*)(lds + PMX + tok * 528 + (128 * mh + 16 * j + 4 * q4) * 2) = (u32x2){pk2(p0, p1), pk2(p2, p3)}; }
      sum += __shfl_xor(sum, 16); sum += __shfl_xor(sum, 32);
      if (q4 == 0) RS[mh * 64 + tok] = sum; }
    __syncthreads();
    if (Vtb) {
#pragma unroll
        for (int jj = 0; jj < 8; ++jj) { const int cidx = tid + 512 * jj, d = cidx >> 5, mc = cidx & 31; *(LAS u32x4*)(lds + VT + d * 528 + mc * 16) = vq[jj]; }
    } else {
#pragma unroll
        for (int jj = 0; jj < 32; ++jj) { const int idx = tid + 512 * jj, d = idx & 127, mp = idx >> 7;
            *(LAS unsigned*)(lds + VT + d * 528 + mp * 4) = pk2(vr0[jj], vr1[jj]); } }
    __syncthreads();
    { const int r32 = lane & 31, hi = lane >> 5, tm = wave & 1, dn = wave >> 1; f32x16 acc;
#pragma unroll
      for (int i = 0; i < 16; ++i) acc[i] = 0.f;
#pragma unroll
      for (int ks = 0; ks < 16; ++ks) { const bf16x8 a = *(LAS bf16x8*)(lds + PMX + (32 * tm + r32) * 528 + ks * 32 + hi * 16);
          const bf16x8 b = *(LAS bf16x8*)(lds + VT + (32 * dn + r32) * 528 + ks * 32 + hi * 16); acc = MFMA32(a, b, acc); }
#pragma unroll
      for (int i = 0; i < 16; ++i) { const int tk = 32 * tm + crow(i, hi); const float inv = __builtin_amdgcn_rcpf(RS[tk] + RS[64 + tk]);
          if (tk < tvalid) OM[(size_t)(row0 + tk) * 512 + hm * 128 + 32 * dn + r32] = (bf16_t)f2bf(acc[i] * inv); } }
    __syncthreads();
}
#define XB_TMO      128
#define XB_XCNT(j)  (256  + 64 * (j))
#define XB_XSUB(j)  (1280 + 64 * (j))
#define XB_XGEN(j)  (2304 + 64 * (j))
#define XB_TOP      3328
#define XB_TOPGEN   3392
#define XCD_BAR_WORDS 3456
#define XB_SPIN_CAP (1u << 18)

__device__ __forceinline__ unsigned xb_ld(unsigned* p)              { return __hip_atomic_load(p, __ATOMIC_RELAXED, __HIP_MEMORY_SCOPE_AGENT); }
__device__ __forceinline__ unsigned xb_add(unsigned* p, unsigned v) { return __hip_atomic_fetch_add(p, v, __ATOMIC_RELAXED, __HIP_MEMORY_SCOPE_AGENT); }
__device__ __forceinline__ unsigned xb_xcc_id() { return (unsigned)__builtin_amdgcn_s_getreg((3 << 11) | 20) & 0xFu; }
#define XB_SPIN(cond, bar) do { unsigned _sp = 0; while (cond) { __builtin_amdgcn_s_sleep(1); \
    if ((++_sp & 255u) == 0u) { if (xb_ld(&(bar)[XB_TMO])) break; if (_sp > XB_SPIN_CAP) { atomicAdd(&(bar)[XB_TMO], 1u); break; } } } } while (0)

struct XcdBarrier {
    unsigned* bar; unsigned x;
    volatile LAS unsigned* st;
};

__device__ __forceinline__ XcdBarrier xcd_barrier_post(unsigned* bar, volatile LAS unsigned* st) {
    XcdBarrier b; b.bar = bar; b.x = xb_xcc_id(); b.st = st;
    if (threadIdx.x == 0) (void)xb_add(&bar[XB_XCNT(b.x)], 1u);
    return b;
}
__device__ __forceinline__ void xcd_barrier_complete(unsigned* bar, unsigned x, unsigned& nloc, unsigned& nx) {
    const unsigned G = gridDim.x * gridDim.y * gridDim.z;
    unsigned sum, cnt, mine, sp = 0u;
    for (;;) {
        sum = 0u; cnt = 0u; mine = 0u;
#pragma unroll
        for (unsigned j = 0; j < 16; ++j) { const unsigned c = xb_ld(&bar[XB_XCNT(j)]); sum += c; cnt += (c > 0u) ? 1u : 0u; mine = (j == x) ? c : mine; }
        if (sum == G) break;
        __builtin_amdgcn_s_sleep(1);
        if ((++sp & 255u) == 0u) { if (xb_ld(&bar[XB_TMO])) break; if (sp > XB_SPIN_CAP) { atomicAdd(&bar[XB_TMO], 1u); break; } }
    }
    nloc = mine > 0u ? mine : 1u; nx = cnt > 0u ? cnt : 1u;
}

__device__ __forceinline__ void xcd_barrier(const XcdBarrier& b) {
    asm volatile("s_waitcnt vmcnt(0)" ::: "memory");
    __syncthreads();
    if (threadIdx.x == 0) {
        unsigned* bar = b.bar;
        __builtin_amdgcn_s_waitcnt(0);
        unsigned nloc = b.st[0], nx = b.st[1];
        if (nloc == 0u) { xcd_barrier_complete(bar, b.x, nloc, nx); b.st[0] = nloc; b.st[1] = nx; }
        const unsigned old = xb_add(&bar[XB_XSUB(b.x)], 1u);
        const unsigned gen = old / nloc;
        if (old + 1u == (gen + 1u) * nloc) {
            __builtin_amdgcn_fence(__ATOMIC_RELEASE, "agent");
            asm volatile("s_waitcnt vmcnt(0)" ::: "memory");
            const unsigned og = xb_add(&bar[XB_TOP], 1u);
            const unsigned tg = og / nx;
            if (og + 1u == (tg + 1u) * nx) xb_add(&bar[XB_TOPGEN], 1u);
            else XB_SPIN(xb_ld(&bar[XB_TOPGEN]) == tg, bar);
            __builtin_amdgcn_fence(__ATOMIC_ACQUIRE, "agent");
            xb_add(&bar[XB_XGEN(b.x)], 1u);
            asm volatile("s_waitcnt vmcnt(0)" ::: "memory");
        } else {
            XB_SPIN(xb_ld(&bar[XB_XGEN(b.x)]) == gen, bar);
            __builtin_amdgcn_fence(__ATOMIC_ACQUIRE, "agent");
            asm volatile("s_waitcnt vmcnt(0)" ::: "memory");
        }
    }
    __syncthreads();
}

__device__ __forceinline__ const float* gptr_(unsigned long long v) { return (const float*)(const __attribute__((address_space(1))) float*)v; }
#define GPTR(p) gptr_(p)
#define FPTR(p) ((const float*)(p))
#define OPQ(x) asm volatile("" : "+s"(x))
#define OPQP(T, x) do { unsigned long long xi_ = (unsigned long long)(x); asm volatile("" : "+s"(xi_)); x = (T*)(__attribute__((address_space(1))) T*)xi_; } while (0)
struct Args { const float* in[24]; float* out; unsigned char* ws; };
__global__ void __launch_bounds__(512, 2) mega_fwd(Args args) {
    extern __shared__ __attribute__((aligned(16))) unsigned char lds_raw[];
    cg::grid_group grid = cg::this_grid();
    ldsp lds = (ldsp)lds_raw;
    unsigned char* const ws = args.ws; float* const out = args.out;
#define WAVE_IDS int tid = threadIdx.x; asm volatile("" : "+v"(tid)); const int lane = tid & 63, wave = __builtin_amdgcn_readfirstlane(tid >> 6), G = gridDim.x, bid = blockIdx.x, gw = bid * 8 + wave, NGW = G * 8; (void)lane; (void)gw; (void)NGW

    {
        WAVE_IDS;
        if (bid == 0) for (int i = tid; i < XCD_BAR_WORDS; i += 512) ((unsigned*)(ws + WS_BAR))[i] = 0u;
        if (bid == 0 && tid < 8) ((unsigned*)(ws + WS_CTR))[tid] = 0u;
        if (tid < 2) ((LAS unsigned*)(lds + LDS_BARST))[tid] = 0u;
        if (bid == 0 && tid == 0) { const float** tab = (const float**)ws;
#pragma unroll
            for (int i = 0; i < 24; ++i) tab[i] = args.in[i]; }
        bf16_t* XB = (bf16_t*)(ws + WS_XB); float* SSQ = (float*)(ws + WS_SSQ); bf16_t* MEMB = (bf16_t*)(ws + WS_MEMB); float* MEMSSQ = (float*)(ws + WS_MEMSSQ); bf16_t* WMKV = (bf16_t*)(ws + WS_WMKV);
        LAS float* scr = (LAS float*)(lds + wave * 16384);
#define CONV_ITEM(PTR, L_, R_, WSB) do { const int l = (L_); int r = (R_); unsigned char* wl = (WSB) + WS_W0 + (size_t)l * WS_WL; bf16_t* wmkv = (bf16_t*)((WSB) + WS_WMKV); \
            if (r < 1792) { transpose_item(PTR(10) + (size_t)l * 1024 * 3584, 1024, 3584, (bf16_t*)(wl + W_IN), 0, PTR(9) + l * 1024, scr, r, lane); break; } r -= 1792; \
            if (r < 512)  { transpose_item(PTR(13) + (size_t)l * 1024 * 1024, 1024, 1024, (bf16_t*)(wl + W_OUT), 0, nullptr, scr, r, lane); break; } r -= 512; \
            if (r < 256)  { transpose_item(PTR(16) + (size_t)l * 1024 * 512, 1024, 512, (bf16_t*)(wl + W_MQ), 0, PTR(14) + l * 1024, scr, r, lane); break; } r -= 256; \
            if (r < 256)  { transpose_item(PTR(17) + (size_t)l * 1024 * 512, 1024, 512, wmkv + (size_t)l * 1024 * 1024, 0, PTR(15) + l * 1024, scr, r, lane); break; } r -= 256; \
            if (r < 256)  { transpose_item(PTR(18) + (size_t)l * 1024 * 512, 1024, 512, wmkv + (size_t)l * 1024 * 1024, 512, PTR(15) + l * 1024, scr, r, lane); break; } r -= 256; \
            if (r < 256)  { transpose_item(PTR(19) + (size_t)l * 512 * 1024, 512, 1024, (bf16_t*)(wl + W_MO), 0, nullptr, scr, r, lane); break; } r -= 256; \
            if (r < 2048) { transpose_item(PTR(21) + (size_t)l * 1024 * 4096, 1024, 4096, (bf16_t*)(wl + W_1), 0, PTR(20) + l * 1024, scr, r, lane); break; } r -= 2048; \
            transpose_item(PTR(22) + (size_t)l * 4096 * 1024, 4096, 1024, (bf16_t*)(wl + W_2), 0, nullptr, scr, r, lane); } while (0)
#define ARGP(i) args.in[i]
        const bool defer = (G == 256);
        for (int it = gw; it < (defer ? 3328 + 512 : 14848); it += NGW) {
            if (defer) { if (it < 3328) CONV_ITEM(ARGP, 0, it, ws); else CONV_ITEM(ARGP, 1, 2560 + (it - 3328), ws); }
            else { if (it < 7424) CONV_ITEM(ARGP, 0, it, ws); else CONV_ITEM(ARGP, 1, it - 7424, ws); } }
#undef ARGP
#define ROW_PTRS(m, S, D, Q, R) do { if ((m) < NPROMPT) { S = args.in[0] + (size_t)(m) * 1024; D = XB + (size_t)(m) * 1024; Q = SSQ + (size_t)(m) * 16; R = (float*)(ws + WS_RSTD) + (m); } \
            else if ((m) < M_ALL) { S = args.in[1] + (size_t)((m) - NPROMPT) * 1024; D = XB + (size_t)(m) * 1024; Q = SSQ + (size_t)(m) * 16; R = (float*)(ws + WS_RSTD) + (m); } \
            else { S = args.in[2] + (size_t)((m) - M_ALL) * 1024; D = MEMB + (size_t)((m) - M_ALL) * 1024; Q = MEMSSQ + (size_t)((m) - M_ALL) * 16; R = (float*)(ws + WS_MEMRSTD) + ((m) - M_ALL); } } while (0)
        for (int m0 = gw; m0 < M_ALL + 512; m0 += 2 * NGW) { const bool hasB = m0 + NGW < M_ALL + 512; const int m1 = hasB ? m0 + NGW : m0;
            const float *sA, *sB; bf16_t *dA, *dB; float *qA, *qB, *rA, *rB;
            ROW_PTRS(m0, sA, dA, qA, rA); ROW_PTRS(m1, sB, dB, qB, rB);
            row_prep2(sA, dA, qA, rA, sB, dB, qB, rB, hasB, lane); }
#undef ROW_PTRS
    }
    grid.sync();
    (void)xcd_barrier_post((unsigned*)(ws + WS_BAR), (volatile LAS unsigned*)(lds + LDS_BARST));
#define GRID_BAR() do { XcdBarrier b_; b_.bar = (unsigned*)(ws + WS_BAR); b_.x = xb_xcc_id(); b_.st = (volatile LAS unsigned*)(lds + LDS_BARST); xcd_barrier(b_); } while (0)

#pragma nounroll
    for (int l = 0; l < 2; ++l) {
#pragma nounroll
        for (int q = 0; q < (l == 0 ? 2 : 1); ++q) {
            WAVE_IDS; unsigned char* w_ = ws; float* o_ = out; int l_ = l; OPQP(unsigned char, w_); OPQP(float, o_); OPQ(l_);
            Gemm g; EpiF32 E;
            if (q == 0) { g = Gemm{(const bf16_t*)(w_ + WS_XB), (const bf16_t*)(w_ + WS_W0 + (size_t)l_ * WS_WL + W_IN), M_ALL, 3584, 1024};
                E = EpiF32{0, (const float*)(w_ + WS_RSTD), (float*)(w_ + WS_PROJ), o_, l_, (bf16_t*)(w_ + WS_VT), (bf16_t*)(w_ + WS_KB)}; }
            else { g = Gemm{(const bf16_t*)(w_ + WS_MEMB), (const bf16_t*)(w_ + WS_WMKV), 512, 2048, 1024};
                E = EpiF32{1, (const float*)(w_ + WS_MEMRSTD), nullptr, o_, l_, (bf16_t*)(w_ + WS_MVT), (bf16_t*)(w_ + WS_MKB)}; }
            StaticOrder S; S.init(g.M, g.N, G, q == 0 ? bid : (bid + 16) % G);
            gemm_phase<EpiF32, StaticOrder, true, true>(lds, g, S, E);
        }
        if (l == 0 && gridDim.x == 256 && blockIdx.x >= 156 && blockIdx.x < 240) {
            WAVE_IDS; unsigned char* w_ = ws; OPQP(unsigned char, w_);
            const unsigned long long* tabc = (const unsigned long long*)w_; LAS float* scr = (LAS float*)(lds + wave * 16384);
#define TABP(i) FPTR(tabc[i])
            for (int j = (bid - 156) * 8 + wave; j < 4096; j += 84 * 8) CONV_ITEM(TABP, 0, 3328 + j, w_);
#undef TABP
        }
        GRID_BAR();
#pragma nounroll
        for (int ph = 0; ph < 3; ++ph) {
            WAVE_IDS; unsigned char* w_ = ws; float* o_ = out; int l_ = l; OPQP(unsigned char, w_); OPQP(float, o_); OPQ(l_);
            const unsigned long long* tab = (const unsigned long long*)w_;
            float* PROJ = (float*)(w_ + WS_PROJ); float* OSB = (float*)(w_ + WS_OSB); bf16_t* MIX = (bf16_t*)(w_ + WS_MIX); float* DS = (float*)(w_ + WS_DS); float* DD = (float*)(w_ + WS_DD);
            if (ph != 1) {
                const int nit = ph == 0 ? 1152 : 1024;
                const float* state_hgrn = GPTR(tab[5]); const float* lb_logits = GPTR(tab[8]); const float* hgain = GPTR(tab[12]) + l_ * 512;
#define HG_DECODE(IT, ROW0, TV, H) do { if ((IT) < 1024) { const int bh_ = (IT) >> 7; H = bh_ & 3; ROW0 = (bh_ >> 2) * 8192 + ((IT) & 127) * 64; TV = 64; } \
                    else { const int si_ = (IT) - 1024; H = si_ & 3; ROW0 = NPROMPT + 16 * (si_ >> 2); TV = 16; } } while (0)
#define HG_MAP(Q) (ph == 0 ? ((Q) < 128 ? 1024 + (Q) : (Q) - 128) : (Q))
                volatile LAS unsigned* LW = (volatile LAS unsigned*)(lds + LDS_BARST);
                unsigned* ctr = (unsigned*)(w_ + WS_CTR) + 2 * l_;
                unsigned nextq = 0; int cur;
                if (ph == 0) { if (tid == 0) LW[4] = atomicAdd(ctr, 1u); __syncthreads(); cur = (int)LW[4]; if (tid == 0) nextq = atomicAdd(ctr, 1u); }
                else cur = bid;
                while (cur < nit) {
                    const int it = HG_MAP(cur); int nxt;
                    if (ph == 0) { __syncthreads(); if (tid == 0) LW[4] = nextq; __syncthreads(); nxt = (int)LW[4]; if (tid == 0 && nxt < nit) nextq = atomicAdd(ctr, 1u); }
                    else nxt = cur + G;
                    int row0, tvalid, h; HG_DECODE(it, row0, tvalid, h);
                    float* dsOut; float* ddOut; const float* s0; const float* Ssrc;
                    if (it < 1024) { const int bh = it >> 7, c = it & 127; dsOut = DS + (size_t)(bh * 128 + c) * 16384; ddOut = DD + (size_t)(bh * 128 + c) * 128; s0 = nullptr; Ssrc = dsOut; }
                    else { const int si = it - 1024, s = si >> 2; s0 = state_hgrn + (size_t)((l_ * 32 + s) * 4 + h) * 16384; Ssrc = s0; dsOut = o_ + O_HS + (size_t)((l_ * 32 + s) * 4 + h) * 16384; ddOut = nullptr; }
                    int t2 = tid; asm volatile("" : "+v"(t2)); const int lane2 = t2 & 63, tg2 = t2 >> 7, k2 = t2 & 127;
                    const int ch = h * 128 + k2;
                    const float lbv = l_ == 0 ? 0.f : __builtin_amdgcn_rcpf(1.f + fexp(lb_logits[ch] - lb_logits[512 + ch]));
                    { float zc[16]; hg_load(PROJ, row0, tvalid, h, tg2, k2, 2048, zc);
                      if (ph == 0) hg_h1(lds, PROJ, zc, row0, tvalid, h, lbv, dsOut, ddOut, s0, t2, lane2, wave);
                      if (ph == 2 || it >= 1024) hg_h3(lds, PROJ, zc, row0, tvalid, h, lbv, Ssrc, it < 1024, hgain, MIX, t2, lane2, wave); }
                    cur = nxt;
                }
#undef HG_DECODE
#undef HG_MAP
                if (ph == 0) { unsigned char* w2 = ws; float* o2 = out; int l2 = l; OPQP(unsigned char, w2); OPQP(float, o2); OPQ(l2);
                    const unsigned long long* tab2 = (const unsigned long long*)w2; unsigned* ctr2 = (unsigned*)(w2 + WS_CTR) + 2 * l2 + 1;
                    unsigned wq = 0; if (lane == 0) wq = atomicAdd(ctr2, 1u); int w = __builtin_amdgcn_readfirstlane(wq);
                    while (w < 4352) { unsigned wn = 0; if (lane == 0) wn = atomicAdd(ctr2, 1u);
                        int lane2 = lane; asm volatile("" : "+v"(lane2));
                        if (w < 256) sb_item<true>(4096 + w, l2, (const float*)(w2 + WS_PROJ), o2 + O_KP + (size_t)l2 * NPROMPT * 512, o2 + O_VP + (size_t)l2 * NPROMPT * 512,
                                                    o2 + O_KS + (size_t)l2 * 262144, o2 + O_VS + (size_t)l2 * 262144, GPTR(tab2[3]), GPTR(tab2[4]), (const bf16_t*)(w2 + WS_VT), (const bf16_t*)(w2 + WS_KB), (float*)(w2 + WS_OSB), lane2);
                        else sb_item<false>(w - 256, l2, (const float*)(w2 + WS_PROJ), o2 + O_KP + (size_t)l2 * NPROMPT * 512, o2 + O_VP + (size_t)l2 * NPROMPT * 512,
                                                    o2 + O_KS + (size_t)l2 * 262144, o2 + O_VS + (size_t)l2 * 262144, GPTR(tab2[3]), GPTR(tab2[4]), (const bf16_t*)(w2 + WS_VT), (const bf16_t*)(w2 + WS_KB), (float*)(w2 + WS_OSB), lane2);
                        w = __builtin_amdgcn_readfirstlane(wn); } }
            } else {
                if (wave < 4) {
                    for (int p = bid * 256 + tid; p < 65536; p += G * 256) { const int e = 2 * p, bh = e >> 14, rem = e & 16383, k = rem & 127, v = rem >> 7;
                        unsigned* dsp = (unsigned*)(DS + (size_t)(bh * 128) * 16384) + (rem >> 1); const float* ddp = DD + (size_t)(bh * 128) * 128 + k;
                        float S0 = 0.f, S1 = 0.f;
                        for (int c = 0; c < 128; c += 16) { unsigned x[16]; f32x2_t d[16];
#pragma unroll
                            for (int u = 0; u < 16; ++u) { x[u] = dsp[(size_t)(c + u) * 16384]; d[u] = *(const f32x2_t*)(ddp + (c + u) * 128); }
#pragma unroll
                            for (int u = 0; u < 16; ++u) { dsp[(size_t)(c + u) * 16384] = pk2(S0, S1);
                                S0 = d[u].x * S0 + __uint_as_float(x[u] << 16); S1 = d[u].y * S1 + __uint_as_float(x[u] & 0xffff0000u); } }
                        float* op = o_ + O_HP + (size_t)l_ * 131072 + (size_t)bh * 16384 + k * 128 + v; op[0] = S0; op[128] = S1; }
                } else {
                    const float* sbg = GPTR(tab[11]) + l_ * 512; const int NW4 = G * 4;
                    const f32x4 ga = *(const f32x4*)(sbg + lane * 8), gb = *(const f32x4*)(sbg + lane * 8 + 4);
                    int m = bid * 4 + (wave - 4); f32x4 a = {0.f, 0.f, 0.f, 0.f}, b = a;
                    if (m < M_ALL) { const f32x4* op = (const f32x4*)(OSB + (size_t)m * 512 + lane * 8); a = op[0]; b = op[1]; }
                    while (m < M_ALL) { const int mn = m + NW4; f32x4 an = a, bn = b;
                        if (mn < M_ALL) { const f32x4* op = (const f32x4*)(OSB + (size_t)mn * 512 + lane * 8); an = op[0]; bn = op[1]; }
                        float ss = ((a[0] * a[0] + a[1] * a[1]) + (a[2] * a[2] + a[3] * a[3])) + ((b[0] * b[0] + b[1] * b[1]) + (b[2] * b[2] + b[3] * b[3]));
                        ss = wave_sum(ss); const float rs = rsqrtf(ss * (1.0f / 512.0f) + 1e-6f);
                        *(u32x4*)(MIX + (size_t)m * 1024 + lane * 8) = (u32x4){pk2(a[0] * rs * ga[0], a[1] * rs * ga[1]), pk2(a[2] * rs * ga[2], a[3] * rs * ga[3]),
                                                                              pk2(b[0] * rs * gb[0], b[1] * rs * gb[1]), pk2(b[2] * rs * gb[2], b[3] * rs * gb[3])};
                        a = an; b = bn; m = mn; } }
            }
            GRID_BAR();
        }
#pragma nounroll
        for (int st = 0; st < 3; ++st) {
            { WAVE_IDS; unsigned char* w_ = ws; int l_ = l; OPQP(unsigned char, w_); OPQ(l_);
              const unsigned long long* tab = (const unsigned long long*)w_; unsigned char* wl = w_ + WS_W0 + (size_t)l_ * WS_WL;
              float* X = (float*)(w_ + WS_X);
              const bf16_t* A = (const bf16_t*)(w_ + (st == 0 ? WS_MIX : (st == 1 ? WS_OM : WS_H))); const bf16_t* Bt = (const bf16_t*)(wl + (st == 0 ? W_OUT : (st == 1 ? W_MO : W_2)));
              const int K = st == 0 ? 1024 : (st == 1 ? 512 : 4096);
              { Gemm g{A, Bt, NPROMPT, 1024, K, 0};
                EpiResid E{(st == 0 && l_ == 0) ? FPTR(tab[0]) : X, nullptr, X, (bf16_t*)(w_ + WS_XB), (float*)(w_ + WS_SSQ)};
                StaticOrder S; S.init(NPROMPT, 1024, G, bid);
                gemm_phase<EpiResid, StaticOrder, true, true>(lds, g, S, E); }
              { Gemm g{A, Bt, M_ALL, 1024, 256, K};
                EpiPart E{(float*)(w_ + WS_PART)};
                SplitOrder S; S.init(2, 1024, K / 256, G, bid, 64);
                gemm_phase<EpiPart, SplitOrder, true, true>(lds, g, S, E); } }
            GRID_BAR();
            { WAVE_IDS; unsigned char* w_ = ws; int l_ = l; OPQP(unsigned char, w_); OPQ(l_);
              const unsigned long long* tab = (const unsigned long long*)w_; const int nS = (st == 0 ? 1024 : (st == 1 ? 512 : 4096)) / 256;
              float* X = (float*)(w_ + WS_X); bf16_t* XB = (bf16_t*)(w_ + WS_XB); float* SSQ = (float*)(w_ + WS_SSQ); const float* PART = (const float*)(w_ + WS_PART);
              const float* bs = (st == 0 && l_ == 0) ? FPTR(tab[1]) : X + (size_t)NPROMPT * 1024;
              LAS float* red = (LAS float*)lds;
              for (int mb = bid; mb < 256; mb += G) { const int m = mb * 2 + (wave >> 2), cq = wave & 3, col = cq * 256 + lane * 4;
                  f32x4 v = *(const f32x4*)(bs + (size_t)m * 1024 + col); f32x4 pp[16];
#pragma unroll
                  for (int ks = 0; ks < 16; ++ks) { const int kc = ks < nS ? ks : 0; pp[ks] = *(const f32x4*)(PART + ((size_t)kc * 512 + m) * 1024 + col); }
#pragma unroll
                  for (int ks = 0; ks < 16; ++ks) { const float on = ks < nS ? 1.f : 0.f; v += pp[ks] * on; }
                  *(f32x4*)(X + (size_t)(NPROMPT + m) * 1024 + col) = v;
                  u32x2 w; w.x = pk2(v[0], v[1]); w.y = pk2(v[2], v[3]); *(u32x2*)(XB + (size_t)(NPROMPT + m) * 1024 + col) = w;
                  float s = wave_sum((v[0] * v[0] + v[1] * v[1]) + (v[2] * v[2] + v[3] * v[3]));
                  if (lane == 0) red[wave] = s;
                  __syncthreads();
                  if (cq == 0 && lane == 0) ((float*)(w_ + WS_RSTD))[NPROMPT + m] = rsqrtf(((red[wave] + red[wave + 1]) + (red[wave + 2] + red[wave + 3])) * (1.0f / 1024.0f) + 1e-6f);
                  __syncthreads(); }
              if (tid < 64) for (int r = bid * 64 + tid; r < NPROMPT; r += G * 64) ((float*)(w_ + WS_RSTD))[r] = row_rstd(SSQ, r); }
            GRID_BAR();
            if (st < 2) {
                WAVE_IDS; unsigned char* w_ = ws; int l_ = l; OPQP(unsigned char, w_); OPQ(l_); unsigned char* wl = w_ + WS_W0 + (size_t)l_ * WS_WL;
                Gemm g; EpiBf16S E;
                if (st == 0) { g = Gemm{(const bf16_t*)(w_ + WS_XB), (const bf16_t*)(wl + W_MQ), M_ALL, 512, 1024}; E = EpiBf16S{(bf16_t*)(w_ + WS_QM), 512, (const float*)(w_ + WS_RSTD), 0.08838834764831845f, 0}; }
                else { g = Gemm{(const bf16_t*)(w_ + WS_XB), (const bf16_t*)(wl + W_1), M_ALL, 4096, 1024}; E = EpiBf16S{(bf16_t*)(w_ + WS_H), 4096, (const float*)(w_ + WS_RSTD), 1.0f, 1}; }
                StaticOrder S; S.init(M_ALL, g.N, G, bid);
                gemm_phase<EpiBf16S, StaticOrder, true, true>(lds, g, S, E);
                if (st == 0 && l_ == 0 && bid >= 132 && G == 256) {
                    const unsigned long long* tabc = (const unsigned long long*)w_; LAS float* scr = (LAS float*)(lds + wave * 16384);
#define TABP(i) FPTR(tabc[i])
                    for (int j = (bid - 132) * 8 + wave; j < 6912; j += 124 * 8) CONV_ITEM(TABP, 1, j < 2560 ? j : j + 512, w_);
#undef TABP
                }
                GRID_BAR();
            }
            if (st == 0) {
                WAVE_IDS; unsigned char* w_ = ws; float* o_ = out; int l_ = l; OPQP(unsigned char, w_); OPQP(float, o_); OPQ(l_);
                const unsigned long long* tab = (const unsigned long long*)w_; const float* cache_mk = GPTR(tab[6]); const float* cache_mv = GPTR(tab[7]);
                const bf16_t* QM = (const bf16_t*)(w_ + WS_QM); bf16_t* OM = (bf16_t*)(w_ + WS_OM);
                for (int it = bid; it < 1152; it += G) {
                    int row0, tvalid, hm; const float* Kg; const float* Vg; const bf16_t* Kb = nullptr; const bf16_t* Vtb = nullptr;
                    if (it < 1024) { const int tt = it >> 2; hm = it & 3; row0 = tt * 64; tvalid = 64; const int b = tt >> 7;
                        Kb = (const bf16_t*)(w_ + WS_MKB) + (size_t)((l_ * 2 + b) * 4 + hm) * 32768; Vtb = (const bf16_t*)(w_ + WS_MVT) + (size_t)((l_ * 2 + b) * 4 + hm) * 32768;
                        Kg = o_ + O_MKP + (size_t)(l_ * 2 + b) * 131072 + hm * 128; Vg = o_ + O_MVP + (size_t)(l_ * 2 + b) * 131072 + hm * 128; }
                    else { const int si = it - 1024, s = si >> 2; hm = si & 3; row0 = NPROMPT + 16 * s; tvalid = 16;
                        Kg = cache_mk + (size_t)(l_ * 32 + s) * 131072 + hm * 128; Vg = cache_mv + (size_t)(l_ * 32 + s) * 131072 + hm * 128; }
                    int t2 = tid; asm volatile("" : "+v"(t2));
                    xattn_item(lds, QM, Kg, Vg, Kb, Vtb, row0, tvalid, hm, OM, t2, t2 & 63, wave);
                }
                GRID_BAR();
            }
        }
    }
    { WAVE_IDS; unsigned char* w_ = ws; float* o_ = out; OPQP(unsigned char, w_); OPQP(float, o_);
      const float* nf = GPTR(((const unsigned long long*)w_)[23]); const float* X = (const float*)(w_ + WS_X);
      for (int m0 = gw; m0 < M_ALL; m0 += 2 * NGW) { const int m1 = (m0 + NGW < M_ALL) ? m0 + NGW : m0;
          const f32x4* xa = (const f32x4*)(X + (size_t)m0 * 1024) + lane; const f32x4* xb = (const f32x4*)(X + (size_t)m1 * 1024) + lane; f32x4 va[4], vb[4]; float sa = 0.f, sb = 0.f;
#pragma unroll
          for (int j = 0; j < 4; ++j) { va[j] = xa[64 * j]; vb[j] = xb[64 * j]; }
#pragma unroll
          for (int j = 0; j < 4; ++j) { sa += (va[j][0] * va[j][0] + va[j][1] * va[j][1]) + (va[j][2] * va[j][2] + va[j][3] * va[j][3]); sb += (vb[j][0] * vb[j][0] + vb[j][1] * vb[j][1]) + (vb[j][2] * vb[j][2] + vb[j][3] * vb[j][3]); }
          sa = wave_sum(sa); sb = wave_sum(sb); const float ra = rsqrtf(sa * (1.0f / 1024.0f) + 1e-6f), rb = rsqrtf(sb * (1.0f / 1024.0f) + 1e-6f);
          f32x4* ya = (f32x4*)(o_ + (m0 < NPROMPT ? O_YP + (size_t)m0 * 1024 : O_YS + (size_t)(m0 - NPROMPT) * 1024)) + lane;
          f32x4* yb = (f32x4*)(o_ + (m1 < NPROMPT ? O_YP + (size_t)m1 * 1024 : O_YS + (size_t)(m1 - NPROMPT) * 1024)) + lane;
#pragma unroll
          for (int j = 0; j < 4; ++j) { const f32x4 g = *((const f32x4*)nf + lane + 64 * j); ya[64 * j] = va[j] * ra * g; if (m1 != m0) yb[64 * j] = vb[j] * rb * g; } } }
}

extern "C" void kernel_launch(void* const* d_in, const int* in_sizes, int n_in, void* d_out, int out_size, void* d_ws, size_t ws_size, hipStream_t stream) {
    static int grid = 0;
    if (grid == 0) {
        int dev = 0, cus = 0, per_cu = 0;
        (void)hipGetDevice(&dev); (void)hipDeviceGetAttribute(&cus, hipDeviceAttributeMultiprocessorCount, dev);
        if (hipFuncSetAttribute((const void*)mega_fwd, hipFuncAttributeMaxDynamicSharedMemorySize, LDS_BYTES) != hipSuccess) fprintf(stderr, "kernel_launch: hipFuncSetAttribute failed\n");
        if (hipOccupancyMaxActiveBlocksPerMultiprocessor(&per_cu, (const void*)mega_fwd, 512, LDS_BYTES) != hipSuccess || per_cu < 1) { fprintf(stderr, "kernel_launch: occupancy query says %d\n", per_cu); per_cu = 1; }
        (void)hipGetLastError();
        if (cus <= 0) cus = 256;
        grid = cus;
    }
    Args a{};
    for (int i = 0; i < 24; ++i) a.in[i] = (const float*)d_in[i];
    a.out = (float*)d_out; a.ws = (unsigned char*)d_ws;
    void* kargs[] = {&a};
    const hipError_t e = hipLaunchCooperativeKernel((const void*)mega_fwd, dim3(grid), dim3(512), kargs, LDS_BYTES, stream);
    if (e != hipSuccess) fprintf(stderr, "kernel_launch: cooperative launch failed: %s (grid %d)\n", hipGetErrorString(e), grid);
}
```

```cpp
#include <hip/hip_runtime.h>
#include <hip/hip_cooperative_groups.h>
#include <cstdio>
#include <cstdint>
namespace cg = cooperative_groups;
namespace pg8 {
#define PG8_LAS __attribute__((address_space(3)))
typedef unsigned short bf16_t;
typedef short bf16x8 __attribute__((ext_vector_type(8)));
typedef float f32x4 __attribute__((ext_vector_type(4)));
typedef unsigned u32x4 __attribute__((ext_vector_type(4)));
constexpr int BM = 256, BK = 64, HALF = 128, HTB = HALF * BK * 2  , STAGE_BYTES = 8 * HTB, NXCD = 8, WGM = 8;

__host__ __device__ __forceinline__ int lds_byte(int r, int c) { const int st = (r >> 4) * 2 + (c >> 5), rr = r & 15, cc = c & 31, ob = rr * 64 + cc * 2; return st * 1024 + (ob ^ (((ob >> 9) & 1) << 5)); }
__host__ __device__ __forceinline__ void stage_rc(int b, int& R, int& C) { const int st = b / 1024, sb = b % 1024, swz = sb ^ (((sb >> 9) & 1) << 5); R = (st >> 1) * 16 + swz / 64; C = (st & 1) * 32 + (swz % 64) / 2; }
__host__ __device__ __forceinline__ int perm32(int rho) { const int n = rho >> 4, i = rho & 15; return 8 * (i >> 2) + 4 * n + (i & 3); }

struct Unit { int pm, pn, ks; };
struct Gemm { const bf16_t* A; const bf16_t* Bt; int M, N, K, ld; };

struct StaticOrder {
    int nM, nN, nwg, G, c;
    __host__ __device__ void init(int M, int N, int G_, int c_) { nM = M / BM; nN = N / BM; nwg = nM * nN; G = G_; c = c_; }
    __host__ __device__ bool next(int i, Unit& u) const {
        const long L = (long)i * G + c; if (L >= nwg) return false;
        int wgid = (int)L; { const int q = nwg / NXCD, r = nwg % NXCD, xcd = wgid % NXCD, off = wgid / NXCD; wgid = (xcd < r ? xcd * (q + 1) : r * (q + 1) + (xcd - r) * q) + off; }
        const int nig = WGM * nN, gid = wgid / nig, fm = gid * WGM, gsz = (nM - fm) < WGM ? (nM - fm) : WGM;
        u.pm = fm + ((wgid % nig) % gsz); u.pn = (wgid % nig) / gsz; u.ks = 0; return true;
    }
    __device__ __forceinline__ void a_ready(const Unit&) const {}
    __device__ __forceinline__ void done(const Unit&) const {}
};
struct SplitOrder {
    int nN, nS, nwg, G, c, pm0;
    __host__ __device__ void init(int nMs, int N, int nS_, int G_, int c_, int pm0_) { nN = N / BM; nS = nS_; nwg = nMs * nN * nS; G = G_; c = c_; pm0 = pm0_; }
    __host__ __device__ bool next(int i, Unit& u) const { const long L = (long)i * G + c; if (L >= nwg) return false; const int t = (int)L / nS; u.ks = (int)L % nS; u.pn = t % nN; u.pm = pm0 + t / nN; return true; }
    __device__ __forceinline__ void a_ready(const Unit&) const {}
    __device__ __forceinline__ void done(const Unit&) const {}
};
__device__ __forceinline__ unsigned cvt_pk_bf16(float lo, float hi) { unsigned r; asm volatile("v_cvt_pk_bf16_f32 %0, %1, %2" : "=v"(r) : "v"(lo), "v"(hi)); return r; }
typedef float f32x2 __attribute__((ext_vector_type(2)));
typedef unsigned u32x2 __attribute__((ext_vector_type(2)));
constexpr int NPROMPT = 16384;
constexpr size_t O_YP = 0, O_YS = 16777216, O_KP = 17301504, O_VP = 34078720, O_HP = 50855936, O_MKP = 51118080, O_MVP = 51642368,
                 O_KS = 52166656, O_VS = 52690944, O_HS = 53215232;
__device__ __forceinline__ float row_rstd(const float* ssq, int row) {
    const f32x4* p = (const f32x4*)(ssq + (size_t)row * 16);
    const f32x4 a = p[0], b = p[1], c = p[2], d = p[3];
    const float s = (((a[0] + a[1]) + (a[2] + a[3])) + ((b[0] + b[1]) + (b[2] + b[3]))) + (((c[0] + c[1]) + (c[2] + c[3])) + ((d[0] + d[1]) + (d[2] + d[3])));
    return rsqrtf(s * (1.0f / 1024.0f) + 1e-6f);
}
struct EpiF32 {
    static constexpr bool PERM = true, AFTER_DRAIN = false;
    int mode; const float* rstd; float* proj; float* outp; int l; bf16_t* vt; bf16_t* kb;
    __device__ __forceinline__ void operator()(const f32x4 (&acc)[2][2][4][2], const Unit& u, int wr, int wc, int fr_, int fq_) const {
        int tq = threadIdx.x; asm volatile("" : "+v"(tq)); const int fr = tq & 15, fq = (tq >> 4) & 3;
        float* base; int pitch, colt, rsub = 0; const int pn = u.pn;
        if (mode == 0) {
            if (pn >= 2 && pn < 6) { const size_t isv = pn >= 4 ? 1 : 0; colt = (pn & 1) * 256; pitch = 512;
                if (u.pm < 64) base = outp + (O_KP + isv * (O_VP - O_KP) + (size_t)l * NPROMPT * 512);
                else { base = outp + (O_KS + isv * (O_VS - O_KS) + (size_t)l * 262144); rsub = NPROMPT; } }
            else { base = proj; pitch = 3584; colt = pn * 256; }
        } else { const size_t sel = (size_t)(pn >> 1); base = outp + (O_MKP + (sel & 1) * (O_MVP - O_MKP) + (sel >> 1) * 262144); pitch = 512; colt = (pn & 1) * 256; }
        const int col0 = colt + wc * 32 + 8 * fq, rowb = u.pm * BM + wr * 64 + fr;
        float rs[2][4];
#pragma unroll
        for (int ai = 0; ai < 2; ++ai)
#pragma unroll
            for (int m = 0; m < 4; ++m) rs[ai][m] = rstd[rowb + ai * HALF + m * 16];
#pragma unroll
        for (int ai = 0; ai < 2; ++ai)
#pragma unroll
            for (int m = 0; m < 4; ++m) { const int row = rowb + ai * HALF + m * 16;
                if (base == proj && mode == 0) {
                    const float sc = rs[ai][m] * (pn < 2 ? 0.125f : 1.0f); bf16_t* bp_ = (bf16_t*)proj + (size_t)row * 3584 + col0;
#pragma unroll
                    for (int bj = 0; bj < 2; ++bj) { const f32x4 v0 = acc[ai][bj][m][0] * sc, v1 = acc[ai][bj][m][1] * sc;
                        u32x4 w; w.x = cvt_pk_bf16(v0[0], v0[1]); w.y = cvt_pk_bf16(v0[2], v0[3]); w.z = cvt_pk_bf16(v1[0], v1[1]); w.w = cvt_pk_bf16(v1[2], v1[3]); *(u32x4*)(bp_ + bj * HALF) = w; }
                } else {
                float* rp = base + (size_t)(row - rsub) * pitch + col0;
#pragma unroll
                for (int bj = 0; bj < 2; ++bj)
#pragma unroll
                    for (int n = 0; n < 2; ++n) *(f32x4*)(rp + bj * HALF + n * 4) = acc[ai][bj][m][n] * rs[ai][m]; } }
        if (mode == 1) {
            const int sel = pn >> 1, lyr = sel >> 1, isv = sel & 1, bb = u.pm;
#pragma unroll
            for (int ai = 0; ai < 2; ++ai)
#pragma unroll
                for (int m = 0; m < 4; ++m) { const int row = rowb + ai * HALF + m * 16, mm = row & 255;
#pragma unroll
                    for (int bj = 0; bj < 2; ++bj) { const f32x4 v0 = acc[ai][bj][m][0] * rs[ai][m], v1 = acc[ai][bj][m][1] * rs[ai][m]; const int c = col0 + bj * HALF, hh = c >> 7, d0 = c & 127;
                        const unsigned p0 = cvt_pk_bf16(v0[0], v0[1]), p1 = cvt_pk_bf16(v0[2], v0[3]), p2 = cvt_pk_bf16(v1[0], v1[1]), p3 = cvt_pk_bf16(v1[2], v1[3]);
                        const size_t hb = (size_t)((lyr * 2 + bb) * 4 + hh) * 32768;
                        if (!isv) { u32x4 w; w.x = p0; w.y = p1; w.z = p2; w.w = p3; *(u32x4*)(kb + hb + (size_t)mm * 128 + d0) = w; }
                        else { bf16_t* q = vt + hb + (size_t)d0 * 256 + mm;
                            q[0] = (bf16_t)(p0 & 0xffffu); q[256] = (bf16_t)(p0 >> 16); q[512] = (bf16_t)(p1 & 0xffffu); q[768] = (bf16_t)(p1 >> 16);
                            q[1024] = (bf16_t)(p2 & 0xffffu); q[1280] = (bf16_t)(p2 >> 16); q[1536] = (bf16_t)(p3 & 0xffffu); q[1792] = (bf16_t)(p3 >> 16); } } }
        }
        if (mode == 0 && pn >= 2 && pn < 4 && u.pm < 64) {
#pragma unroll
            for (int ai = 0; ai < 2; ++ai)
#pragma unroll
                for (int m = 0; m < 4; ++m) { const int row = rowb + ai * HALF + m * 16, t = row & 8191;
#pragma unroll
                    for (int bj = 0; bj < 2; ++bj) { const f32x4 v0 = acc[ai][bj][m][0] * rs[ai][m], v1 = acc[ai][bj][m][1] * rs[ai][m]; const int c = col0 + bj * HALF, hh = c >> 6, d0 = c & 63;
                        u32x4 w; w.x = cvt_pk_bf16(v0[0], v0[1]); w.y = cvt_pk_bf16(v0[2], v0[3]); w.z = cvt_pk_bf16(v1[0], v1[1]); w.w = cvt_pk_bf16(v1[2], v1[3]);
                        *(u32x4*)(kb + ((((size_t)((row >> 13) * 8 + hh) * 256 + (t >> 5)) * 8 + (d0 >> 3)) * 32 + (t & 31)) * 8) = w; } }
        }
        if (mode == 0 && pn >= 4 && pn < 6 && u.pm < 64) {
            const int qi = fr & 3;
#pragma unroll
            for (int ai = 0; ai < 2; ++ai)
#pragma unroll
                for (int m = 0; m < 4; ++m) { const int row = rowb + ai * HALF + m * 16, t0 = (row & 8191) & ~3; const size_t tb = ((size_t)(row >> 13) * 8 * 2048 * 64 + (size_t)(t0 >> 2) * 64) * 4;
#pragma unroll
                    for (int bj = 0; bj < 2; ++bj)
#pragma unroll
                        for (int n = 0; n < 2; ++n) { const f32x4 v = acc[ai][bj][m][n] * rs[ai][m]; const int c = col0 + bj * HALF + n * 4;
                            const unsigned p01 = cvt_pk_bf16(v[0], v[1]), p23 = cvt_pk_bf16(v[2], v[3]);
                            const unsigned snd1 = (qi & 2) ? p01 : p23, kep1 = (qi & 2) ? p23 : p01, rcv1 = (unsigned)__shfl_xor((int)snd1, 2);
                            const unsigned q0 = (qi & 2) ? rcv1 : kep1, q2 = (qi & 2) ? kep1 : rcv1;
                            const unsigned los = (q0 & 0xffffu) | (q2 << 16), his = (q0 >> 16) | (q2 & 0xffff0000u);
                            const unsigned rcv2 = (unsigned)__shfl_xor((int)((qi & 1) ? los : his), 1), mine = (qi & 1) ? his : los;
                            u32x2 w;
                            if (qi & 1) { w.x = (rcv2 & 0xffffu) | (mine << 16); w.y = (rcv2 >> 16) | (mine & 0xffff0000u); }
                            else { w.x = (mine & 0xffffu) | (rcv2 << 16); w.y = (mine >> 16) | (rcv2 & 0xffff0000u); }
                            const int cc = c + (qi & 2) + (qi & 1), hh = cc >> 6, dd = cc & 63;
                            *(u32x2*)(vt + tb + ((size_t)hh * 2048 * 64 + dd) * 4) = w; } }
        }
    }
};
struct EpiResid {
    static constexpr bool PERM = true, AFTER_DRAIN = false;
    const float* bp; const float* bs; float* X; bf16_t* XB; float* ssq;
    __device__ __forceinline__ void operator()(const f32x4 (&acc)[2][2][4][2], const Unit& u, int wr, int wc, int fr_, int fq_) const {
        int tq = threadIdx.x; asm volatile("" : "+v"(tq)); const int fr = tq & 15, fq = (tq >> 4) & 3;
        const int col0 = u.pn * BM + wc * 32 + 8 * fq;
#pragma unroll
        for (int ai = 0; ai < 2; ++ai) {
            f32x4 res[4][2][2];
            if (bp) {
#pragma unroll
                for (int m = 0; m < 4; ++m) { const int row = u.pm * BM + ai * HALF + wr * 64 + m * 16 + fr; const float* br = bp + (size_t)row * 1024 + col0;
#pragma unroll
                    for (int bj = 0; bj < 2; ++bj) { res[m][bj][0] = *(const f32x4*)(br + bj * HALF); res[m][bj][1] = *(const f32x4*)(br + bj * HALF + 4); } }
            } else { u32x4 rb[4][2];
#pragma unroll
                for (int m = 0; m < 4; ++m) { const int row = u.pm * BM + ai * HALF + wr * 64 + m * 16 + fr; const bf16_t* br = XB + (size_t)row * 1024 + col0;
#pragma unroll
                    for (int bj = 0; bj < 2; ++bj) rb[m][bj] = *(const u32x4*)(br + bj * HALF); }
#pragma unroll
                for (int m = 0; m < 4; ++m)
#pragma unroll
                    for (int bj = 0; bj < 2; ++bj) { const u32x4 r = rb[m][bj];
                        res[m][bj][0] = (f32x4){__uint_as_float(r.x << 16), __uint_as_float(r.x & 0xffff0000u), __uint_as_float(r.y << 16), __uint_as_float(r.y & 0xffff0000u)};
                        res[m][bj][1] = (f32x4){__uint_as_float(r.z << 16), __uint_as_float(r.z & 0xffff0000u), __uint_as_float(r.w << 16), __uint_as_float(r.w & 0xffff0000u)}; } }
            asm volatile("" ::: "memory");
#pragma unroll
            for (int m = 0; m < 4; ++m) { const int row = u.pm * BM + ai * HALF + wr * 64 + m * 16 + fr;
                bf16_t* xb = XB + (size_t)row * 1024 + col0; float ss = 0.f;
#pragma unroll
                for (int bj = 0; bj < 2; ++bj) { const f32x4 v0 = acc[ai][bj][m][0] + res[m][bj][0], v1 = acc[ai][bj][m][1] + res[m][bj][1];
                    if (X) { float* xr = X + (size_t)row * 1024 + col0; *(f32x4*)(xr + bj * HALF) = v0; *(f32x4*)(xr + bj * HALF + 4) = v1; }
                    ss += ((v0[0] * v0[0] + v0[1] * v0[1]) + (v0[2] * v0[2] + v0[3] * v0[3])) + ((v1[0] * v1[0] + v1[1] * v1[1]) + (v1[2] * v1[2] + v1[3] * v1[3]));
                    u32x4 w; w.x = cvt_pk_bf16(v0[0], v0[1]); w.y = cvt_pk_bf16(v0[2], v0[3]); w.z = cvt_pk_bf16(v1[0], v1[1]); w.w = cvt_pk_bf16(v1[2], v1[3]); *(u32x4*)(xb + bj * HALF) = w; }
                ss += __shfl_xor(ss, 16); ss += __shfl_xor(ss, 32);
                if (fq == 0) ssq[(size_t)row * 16 + u.pn * 4 + wc] = ss; }
            asm volatile("" ::: "memory"); }
    }
};
struct EpiBf16S {
    static constexpr bool PERM = true, AFTER_DRAIN = false;
    bf16_t* O; int ldc; const float* rstd; float scale; int act;
    __device__ __forceinline__ void operator()(const f32x4 (&acc)[2][2][4][2], const Unit& u, int wr, int wc, int fr_, int fq_) const {
        int tq = threadIdx.x; asm volatile("" : "+v"(tq)); const int fr = tq & 15, fq = (tq >> 4) & 3;
        const int col0 = u.pn * BM + wc * 32 + 8 * fq, rowb = u.pm * BM + wr * 64 + fr;
        float rs[2][4];
#pragma unroll
        for (int ai = 0; ai < 2; ++ai)
#pragma unroll
            for (int m = 0; m < 4; ++m) rs[ai][m] = rstd[rowb + ai * HALF + m * 16];
#pragma unroll
        for (int ai = 0; ai < 2; ++ai)
#pragma unroll
            for (int m = 0; m < 4; ++m) { const int row = rowb + ai * HALF + m * 16; const float r1 = rs[ai][m];
                bf16_t* rowp = O + (size_t)row * ldc + col0;
#pragma unroll
                for (int bj = 0; bj < 2; ++bj) { f32x4 v0 = acc[ai][bj][m][0] * r1, v1 = acc[ai][bj][m][1] * r1;
                    if (act == 1) { v0 = __builtin_elementwise_max(v0, (f32x4){0.f, 0.f, 0.f, 0.f}); v1 = __builtin_elementwise_max(v1, (f32x4){0.f, 0.f, 0.f, 0.f}); v0 = v0 * v0; v1 = v1 * v1; }
                    v0 = v0 * scale; v1 = v1 * scale;
                    u32x4 w; w.x = cvt_pk_bf16(v0[0], v0[1]); w.y = cvt_pk_bf16(v0[2], v0[3]); w.z = cvt_pk_bf16(v1[0], v1[1]); w.w = cvt_pk_bf16(v1[2], v1[3]);
                    *(u32x4*)(rowp + bj * HALF) = w; } }
    }
};
struct EpiPart {
    static constexpr bool PERM = true, AFTER_DRAIN = false;
    float* part;
    __device__ __forceinline__ void operator()(const f32x4 (&acc)[2][2][4][2], const Unit& u, int wr, int wc, int fr_, int fq_) const {
        int tq = threadIdx.x; asm volatile("" : "+v"(tq)); const int fr = tq & 15, fq = (tq >> 4) & 3;
        const int col0 = u.pn * BM + wc * 32 + 8 * fq;
#pragma unroll
        for (int ai = 0; ai < 2; ++ai)
#pragma unroll
            for (int m = 0; m < 4; ++m) { const int row = (u.pm - 64) * BM + ai * HALF + wr * 64 + m * 16 + fr;
                float* rp = part + ((size_t)u.ks * 512 + row) * 1024 + col0;
#pragma unroll
                for (int bj = 0; bj < 2; ++bj)
#pragma unroll
                    for (int n = 0; n < 2; ++n) *(f32x4*)(rp + bj * HALF + n * 4) = acc[ai][bj][m][n];
                asm volatile("" ::: "memory"); }
    }
};
template <class Epi, class Sched, bool ALIGN_EPI = false, bool SP2 = false>
__device__ __forceinline__ void gemm_phase(PG8_LAS unsigned char* lds, const Gemm g, const Sched& S, const Epi& E) {
    int tid_ = threadIdx.x; asm volatile("" : "+v"(tid_));
    const int tid = tid_, wid = __builtin_amdgcn_readfirstlane(tid >> 6), lane = tid & 63, wr = wid >> 2, wc = wid & 3, fr = lane & 15, fq = lane >> 4;
    const int K = g.ld ? g.ld : g.K, nt = g.K / BK;
    unsigned voffA[2], voffB[2];
#pragma unroll
    for (int i = 0; i < 2; ++i) { int R, C; stage_rc(tid * 16 + i * 8192, R, C); const int Rb = Epi::PERM ? ((R & ~31) + perm32(R & 31)) : R;
        voffA[i] = (unsigned)(R * K + C) * 2u; voffB[i] = (unsigned)(Rb * K + C) * 2u; }
    const size_t kstep = (size_t)(BK * 2);
    const size_t hstep = (size_t)HALF * K * 2;
    const size_t tstep = 2 * hstep;
    const unsigned ldsw = (unsigned)wid * 1024u;
    const int aoff = lds_byte(wr * 64 + fr, fq * 8), boff = lds_byte(wc * 32 + fr, fq * 8);
#define PG8_SA(b, h) (((b) * 2 + (h)) * HTB)
#define PG8_SB(b, h) ((4 + (b) * 2 + (h)) * HTB)
#define PG8_STAGE(bufoff, gbase, voff) do { _Pragma("unroll") for (int _i = 0; _i < 2; ++_i) \
        __builtin_amdgcn_global_load_lds((const unsigned*)((const char*)(gbase) + (voff)[_i]), (PG8_LAS unsigned*)(lds + (bufoff) + ldsw + _i * 8192), 16, 0, 0); } while (0)
#define PG8_LDA(dst, b, h) do { _Pragma("unroll") for (int m = 0; m < 4; ++m) _Pragma("unroll") for (int k = 0; k < 2; ++k) dst[m][k] = *(const PG8_LAS bf16x8*)(lds + PG8_SA(b, h) + aoff + m * 2048 + k * 1024); } while (0)
#define PG8_LDB(dst, b, h) do { _Pragma("unroll") for (int n = 0; n < 2; ++n) _Pragma("unroll") for (int k = 0; k < 2; ++k) dst[n][k] = *(const PG8_LAS bf16x8*)(lds + PG8_SB(b, h) + boff + n * 2048 + k * 1024); } while (0)
#define PG8_MMA(ai, bj, At, Bt) do { __builtin_amdgcn_s_setprio(1); _Pragma("unroll") for (int m = 0; m < 4; ++m) _Pragma("unroll") for (int n = 0; n < 2; ++n) _Pragma("unroll") for (int k = 0; k < 2; ++k) \
        acc[ai][bj][m][n] = __builtin_amdgcn_mfma_f32_16x16x32_bf16(Bt[n][k], At[m][k], acc[ai][bj][m][n], 0, 0, 0); __builtin_amdgcn_s_setprio(0); } while (0)
#define PG8_WAIT_V(n) asm volatile("s_waitcnt vmcnt(" #n ")" ::: "memory")
#define PG8_WAIT_L(n) asm volatile("s_waitcnt lgkmcnt(" #n ")" ::: "memory")
#define PG8_BAR __builtin_amdgcn_s_barrier()
#define PG8_SCHED __builtin_amdgcn_sched_barrier(0)
    Unit cur, nxt; int ui = 0;
    if (!S.next(0, cur)) return;
    f32x4 acc[2][2][4][2];
#pragma unroll
    for (int a = 0; a < 2; ++a)
#pragma unroll
        for (int b = 0; b < 2; ++b)
#pragma unroll
            for (int m = 0; m < 4; ++m)
#pragma unroll
                for (int n = 0; n < 2; ++n) acc[a][b][m][n] = (f32x4){0.f, 0.f, 0.f, 0.f};
    bf16x8 At[4][2], B0[2][2], B1[2][2];
    const size_t sstep = (size_t)g.K * 2;
    const char* cA = (const char*)g.A + (size_t)cur.pm * tstep + (size_t)cur.ks * sstep; const char* cB = (const char*)g.Bt + (size_t)cur.pn * tstep + (size_t)cur.ks * sstep;
    S.a_ready(cur);
    if constexpr (SP2) {
        PG8_STAGE(PG8_SB(0, 0), cB, voffB); PG8_STAGE(PG8_SB(0, 1), cB + hstep, voffB); PG8_STAGE(PG8_SA(0, 0), cA, voffA); PG8_STAGE(PG8_SA(0, 1), cA + hstep, voffA);
        if (wr == 1) PG8_BAR;
        PG8_WAIT_V(2); PG8_BAR;
        PG8_STAGE(PG8_SB(1, 0), cB + kstep, voffB); PG8_STAGE(PG8_SA(1, 0), cA + kstep, voffA); PG8_STAGE(PG8_SB(1, 1), cB + hstep + kstep, voffB);
        PG8_WAIT_V(6); PG8_BAR;
    } else {
        PG8_STAGE(PG8_SB(0, 0), cB, voffB); PG8_STAGE(PG8_SA(0, 0), cA, voffA); PG8_STAGE(PG8_SB(0, 1), cB + hstep, voffB); PG8_STAGE(PG8_SA(0, 1), cA + hstep, voffA);
        if (wr == 1) PG8_BAR;
        PG8_WAIT_V(4); PG8_BAR;
        PG8_STAGE(PG8_SB(1, 0), cB + kstep, voffB); PG8_STAGE(PG8_SA(1, 0), cA + kstep, voffA); PG8_STAGE(PG8_SB(1, 1), cB + hstep + kstep, voffB);
        PG8_WAIT_V(6); PG8_BAR;
    }
    for (;;) {
        const bool has_next = S.next(ui + 1, nxt);
        const char* nA = has_next ? (const char*)g.A + (size_t)nxt.pm * tstep + (size_t)nxt.ks * sstep : cA; const char* nB = has_next ? (const char*)g.Bt + (size_t)nxt.pn * tstep + (size_t)nxt.ks * sstep : cB;
        for (int t = 0; t < nt; t += 2) {
            const bool last = (t == nt - 2);
            const char* a1 = cA + (size_t)(t + 1) * kstep;
            const char* a2 = last ? nA : cA + (size_t)(t + 2) * kstep; const char* b2 = last ? nB : cB + (size_t)(t + 2) * kstep;
            const char* a3 = a2 + kstep; const char* b3 = b2 + kstep;
            if (last && has_next) S.a_ready(nxt);
            if constexpr (SP2) {
            PG8_LDB(B0, 0, 0); PG8_LDB(B1, 0, 1); PG8_SCHED; PG8_LDA(At, 0, 0); PG8_STAGE(PG8_SA(1, 1), a1 + hstep, voffA);
            PG8_WAIT_V(8); PG8_WAIT_L(0); PG8_BAR; PG8_MMA(0, 0, At, B0); PG8_MMA(0, 1, At, B1); PG8_BAR; PG8_SCHED;
            PG8_LDA(At, 0, 1); PG8_STAGE(PG8_SB(0, 0), b2, voffB); PG8_STAGE(PG8_SB(0, 1), b2 + hstep, voffB); PG8_STAGE(PG8_SA(0, 0), a2, voffA);
            PG8_WAIT_V(8); PG8_WAIT_L(0); PG8_BAR; PG8_MMA(1, 0, At, B0); PG8_MMA(1, 1, At, B1); PG8_BAR; PG8_SCHED;
            PG8_LDB(B0, 1, 0); PG8_LDB(B1, 1, 1); PG8_SCHED; PG8_LDA(At, 1, 0); PG8_STAGE(PG8_SA(0, 1), a2 + hstep, voffA);
            PG8_WAIT_V(8); PG8_WAIT_L(0); PG8_BAR; PG8_MMA(0, 0, At, B0); PG8_MMA(0, 1, At, B1); PG8_BAR; PG8_SCHED;
            PG8_LDA(At, 1, 1); PG8_STAGE(PG8_SB(1, 0), b3, voffB); PG8_STAGE(PG8_SB(1, 1), b3 + hstep, voffB); PG8_STAGE(PG8_SA(1, 0), a3, voffA);
            PG8_WAIT_V(8); PG8_WAIT_L(0); PG8_BAR; PG8_MMA(1, 0, At, B0); PG8_MMA(1, 1, At, B1); PG8_BAR; PG8_SCHED;
            } else {
            PG8_LDB(B0, 0, 0); PG8_SCHED; PG8_LDA(At, 0, 0); PG8_STAGE(PG8_SA(1, 1), a1 + hstep, voffA);
            PG8_WAIT_L(8); PG8_BAR; PG8_WAIT_L(0); PG8_MMA(0, 0, At, B0); PG8_BAR; PG8_SCHED;
            PG8_LDB(B1, 0, 1); PG8_STAGE(PG8_SB(0, 0), b2, voffB);
            PG8_BAR; PG8_WAIT_L(0); PG8_MMA(0, 1, At, B1); PG8_BAR;
            PG8_LDA(At, 0, 1); PG8_STAGE(PG8_SA(0, 0), a2, voffA);
            PG8_BAR; PG8_WAIT_L(0); PG8_MMA(1, 0, At, B0); PG8_BAR; PG8_SCHED;
            PG8_STAGE(PG8_SB(0, 1), b2 + hstep, voffB);
            PG8_WAIT_V(6); PG8_BAR; PG8_MMA(1, 1, At, B1); PG8_BAR;
            PG8_LDB(B0, 1, 0); PG8_SCHED; PG8_LDA(At, 1, 0); PG8_STAGE(PG8_SA(0, 1), a2 + hstep, voffA);
            PG8_WAIT_L(8); PG8_BAR; PG8_WAIT_L(0); PG8_MMA(0, 0, At, B0); PG8_BAR; PG8_SCHED;
            PG8_LDB(B1, 1, 1); PG8_STAGE(PG8_SB(1, 0), b3, voffB);
            PG8_BAR; PG8_WAIT_L(0); PG8_MMA(0, 1, At, B1); PG8_BAR;
            PG8_LDA(At, 1, 1); PG8_STAGE(PG8_SA(1, 0), a3, voffA);
            PG8_BAR; PG8_WAIT_L(0); PG8_MMA(1, 0, At, B0); PG8_BAR; PG8_SCHED;
            PG8_STAGE(PG8_SB(1, 1), b3 + hstep, voffB);
            PG8_WAIT_V(6); PG8_BAR; PG8_MMA(1, 1, At, B1); PG8_BAR;
            }
        }
        if constexpr (ALIGN_EPI) { if (wr == 0) PG8_BAR; }
        if constexpr (!Epi::AFTER_DRAIN) { E(acc, cur, wr, wc, fr, fq); S.done(cur); }
        if (!has_next) break;
#pragma unroll
        for (int a = 0; a < 2; ++a)
#pragma unroll
            for (int b = 0; b < 2; ++b)
#pragma unroll
                for (int m = 0; m < 4; ++m)
#pragma unroll
                    for (int n = 0; n < 2; ++n) acc[a][b][m][n] = (f32x4){0.f, 0.f, 0.f, 0.f};
        cur = nxt; cA = nA; cB = nB; ++ui;
        if constexpr (ALIGN_EPI) { if (wr == 1) PG8_BAR; }
    }
    PG8_WAIT_V(0);
    if constexpr (!ALIGN_EPI) { if (wr == 0) PG8_BAR; }
    PG8_BAR;
    if constexpr (Epi::AFTER_DRAIN) { E.fused(acc, cur, wr, wc, fr, fq, lds, wid, lane); S.done(cur); }
#undef PG8_SA
#undef PG8_SB
#undef PG8_STAGE
#undef PG8_LDA
#undef PG8_LDB
#undef PG8_MMA
#undef PG8_WAIT_V
#undef PG8_WAIT_L
#undef PG8_BAR
#undef PG8_SCHED
}
}
using namespace pg8;
#define LAS __attribute__((address_space(3)))
typedef LAS unsigned char* ldsp;
typedef float f32x16 __attribute__((ext_vector_type(16)));
#define LDS_WAIT() asm volatile("s_waitcnt lgkmcnt(0)" ::: "memory")

constexpr int M_ALL = 16896;
constexpr int PLD = 3584;
constexpr size_t MiB = 1u << 20;
constexpr size_t WS_W0 = 2 * MiB, WS_WL = 32 * MiB;
constexpr size_t W_IN = 0, W_OUT = 7 * MiB, W_MQ = 9 * MiB, W_MO = 10 * MiB, W_1 = 11 * MiB, W_2 = 19 * MiB;
constexpr size_t WS_WMKV = 66 * MiB;
constexpr size_t WS_XB = 80 * MiB, WS_X = 128 * MiB, WS_SSQ = 196 * MiB, WS_MEMB = 198 * MiB, WS_MEMSSQ = 199 * MiB, WS_RSTD = 199 * MiB + 65536, WS_MEMRSTD = 199 * MiB + 196608;
constexpr size_t WS_PROJ = 256 * MiB, WS_OSB = 512 * MiB, WS_MIX = 560 * MiB, WS_DS = 608 * MiB, WS_DD = 672 * MiB;
constexpr size_t WS_QM = 688 * MiB, WS_OM = 720 * MiB, WS_H = 768 * MiB, WS_PART = 904 * MiB, WS_VT = 940 * MiB, WS_KB = 960 * MiB, WS_MKB = 980 * MiB, WS_MVT = 982 * MiB;
constexpr int LDS_BYTES = 147456;
constexpr size_t WS_BAR = 65536;
constexpr size_t WS_CTR = 65536 + 16384;
constexpr int LDS_BARST = 131072 + 1024;

__device__ __forceinline__ float wave_sum(float v) {
#pragma unroll
    for (int o = 1; o < 64; o <<= 1) v += __shfl_xor(v, o);
    return v;
}
typedef float f32x2_t __attribute__((ext_vector_type(2))); typedef __bf16 bf16x2_t __attribute__((ext_vector_type(2)));
__device__ __forceinline__ unsigned pk2(float lo, float hi) { const f32x2_t v = {lo, hi}; const bf16x2_t b = __builtin_convertvector(v, bf16x2_t); return __builtin_bit_cast(unsigned, b); }
__device__ __forceinline__ unsigned f2bf(float f) { return pk2(f, f) & 0xffffu; }
__device__ __forceinline__ bf16x8 pack8(float a, float b, float c, float d, float e, float f, float g, float h) { return __builtin_bit_cast(bf16x8, (u32x4){pk2(a, b), pk2(c, d), pk2(e, f), pk2(g, h)}); }
__device__ __forceinline__ float fexp(float x) { return __builtin_amdgcn_exp2f(x * 1.4426950408889634f); }
__device__ __forceinline__ float flog(float x) { return __builtin_amdgcn_logf(x) * 0.6931471805599453f; }
__device__ __forceinline__ int crow(int i, int hi) { return (i & 3) + 8 * (i >> 2) + 4 * hi; }
#define MFMA32(a, b, c) __builtin_amdgcn_mfma_f32_32x32x16_bf16((a), (b), (c), 0, 0, 0)
#define MFMA16(a, b, c) __builtin_amdgcn_mfma_f32_16x16x32_bf16((a), (b), (c), 0, 0, 0)

__device__ __forceinline__ void transpose_item(const float* W, int K, int N, bf16_t* WT, int row_off, const float* gain, LAS float* scr, int item, int lane) {
    const int nblk = N / 32, kb = item / nblk, nb = item % nblk, k0 = 64 * kb, n0 = 32 * nb;
    float wv[32], gv[32];
#pragma unroll
    for (int i = 0; i < 32; ++i) { const int kk = 2 * i + (lane >> 5); wv[i] = W[(size_t)(k0 + kk) * N + n0 + (lane & 31)]; gv[i] = gain ? gain[k0 + kk] : 1.f; }
#pragma unroll
    for (int i = 0; i < 32; ++i) { const int kk = 2 * i + (lane >> 5); scr[kk * 33 + (lane & 31)] = wv[i] * gv[i]; }
    LDS_WAIT(); asm volatile("" ::: "memory");
    const int c = lane & 7;
#pragma unroll
    for (int j = 0; j < 4; ++j) { const int n = (lane >> 3) + 8 * j; const LAS float* s = scr + (8 * c) * 33 + n;
        u32x4 o; o.x = pk2(s[0 * 33], s[1 * 33]); o.y = pk2(s[2 * 33], s[3 * 33]); o.z = pk2(s[4 * 33], s[5 * 33]); o.w = pk2(s[6 * 33], s[7 * 33]);
        *(u32x4*)(WT + (size_t)(row_off + n0 + n) * K + k0 + 8 * c) = o; }
    LDS_WAIT(); asm volatile("" ::: "memory");
}
__device__ __forceinline__ void row_prep2(const float* srcA, bf16_t* dstA, float* sqA, float* rsA, const float* srcB, bf16_t* dstB, float* sqB, float* rsB, bool hasB, int lane) {
    const f32x4* xa = (const f32x4*)srcA + lane; const f32x4* xb = (const f32x4*)srcB + lane; f32x4 va[4], vb[4]; float sa = 0.f, sb = 0.f;
#pragma unroll
    for (int j = 0; j < 4; ++j) { va[j] = xa[64 * j]; vb[j] = xb[64 * j]; }
#pragma unroll
    for (int j = 0; j < 4; ++j) { sa += (va[j][0] * va[j][0] + va[j][1] * va[j][1]) + (va[j][2] * va[j][2] + va[j][3] * va[j][3]); sb += (vb[j][0] * vb[j][0] + vb[j][1] * vb[j][1]) + (vb[j][2] * vb[j][2] + vb[j][3] * vb[j][3]); }
    sa = wave_sum(sa); sb = wave_sum(sb);
    u32x2* oa = (u32x2*)dstA + lane; u32x2* ob = (u32x2*)dstB + lane;
#pragma unroll
    for (int j = 0; j < 4; ++j) { u32x2 w; w.x = pk2(va[j][0], va[j][1]); w.y = pk2(va[j][2], va[j][3]); oa[64 * j] = w;
        if (hasB) { u32x2 w2; w2.x = pk2(vb[j][0], vb[j][1]); w2.y = pk2(vb[j][2], vb[j][3]); ob[64 * j] = w2; } }
    if (lane < 16) { sqA[lane] = lane == 0 ? sa : 0.f; if (hasB) sqB[lane] = lane == 0 ? sb : 0.f; }
    if (lane == 0) { *rsA = rsqrtf(sa * (1.0f / 1024.0f) + 1e-6f); if (hasB) *rsB = rsqrtf(sb * (1.0f / 1024.0f) + 1e-6f); }
}
template <bool SAMPLE> __device__ __forceinline__ void sb_item(int item, int layer, const float* PROJ, const float* KP, const float* VP, const float* KS, const float* VS,
                                        const float* CK, const float* CV, const bf16_t* VT, const bf16_t* KB, float* OSB, int lane) {
    const int r32 = lane & 31, hi = lane >> 5;
    int qrow, qpos, ptop, split, h, qmin; bool qvalid; const float *kA, *vA, *kB, *vB;
    const bf16_t* VTh = VT; const bf16_t* KBh = KB;
    if (!SAMPLE) { const int b = item >> 11, rem = item & 2047, qt = rem & 255; h = rem >> 8; VTh = VT + ((size_t)(b * 8 + h) * 2048 * 64 + r32) * 4; KBh = KB + ((size_t)(b * 8 + h) * 256 * 8 * 32 + hi * 32 + r32) * 8;
        qrow = b * 8192 + qt * 32 + r32; qpos = qt * 32 + r32; qvalid = true; ptop = qt * 32; split = 1 << 30; qmin = qt * 32;
        kA = KP + (size_t)(b * 8192) * 512 + h * 64; vA = VP + (size_t)(b * 8192) * 512 + h * 64; kB = kA; vB = vA;
    } else { const int it = item - 4096, s = it >> 3; h = it & 7;
        qrow = NPROMPT + s * 16 + (r32 & 15); qpos = 2048 + (r32 & 15); qvalid = r32 < 16; ptop = 2032; split = 2048; qmin = 2048;
        kA = CK + (size_t)((layer * 32 + s) * 2048) * 512 + h * 64; vA = CV + (size_t)((layer * 32 + s) * 2048) * 512 + h * 64;
        kB = KS + ((long)(s * 16) - 2048) * 512 + h * 64; vB = VS + ((long)(s * 16) - 2048) * 512 + h * 64; }
    bf16x8 qh[4];
    { const bf16_t* qp = (const bf16_t*)PROJ + (size_t)qrow * PLD + h * 64 + 8 * hi;
#pragma unroll
      for (int ds = 0; ds < 4; ++ds) qh[ds] = *(const bf16x8*)(qp + 16 * ds); }
    f32x16 oacc[2];
#pragma unroll
    for (int i = 0; i < 16; ++i) { oacc[0][i] = 0.f; oacc[1][i] = 0.f; }
    float carry = 0.f;
    f32x4 kraw[8]; float vraw[2][2][8]; u32x2 vpk[2][2][2]; bf16x8 kq[4];
#define SB_LOAD_TILE(P0) do { if (SAMPLE) { const int pr_ = (P0) + r32, prc_ = pr_ < 0 ? 0 : pr_; const float* kp_ = (prc_ >= split ? kB : kA) + (long)prc_ * 512 + 8 * hi; \
        _Pragma("unroll") for (int ds = 0; ds < 4; ++ds) { kraw[2 * ds] = *(const f32x4*)(kp_ + 16 * ds); kraw[2 * ds + 1] = *(const f32x4*)(kp_ + 16 * ds + 4); } } \
        else { const int pq_ = (P0) < 0 ? 0 : (P0); _Pragma("unroll") for (int ds = 0; ds < 4; ++ds) kq[ds] = *(const bf16x8*)(KBh + ((size_t)(pq_ >> 5) * 8 + 2 * ds) * 32 * 8); } \
        if (SAMPLE) { _Pragma("unroll") for (int t = 0; t < 2; ++t) _Pragma("unroll") for (int j = 0; j < 8; ++j) { const int pk_ = (P0) + 16 * t + 8 * (j >> 2) + 4 * hi + (j & 3), pkc_ = pk_ < 0 ? 0 : pk_; \
            const float* vp_ = (pkc_ >= split ? vB : vA) + (long)pkc_ * 512 + r32; vraw[t][0][j] = vp_[0]; vraw[t][1][j] = vp_[32]; } } \
        else { const int pc_ = (P0) < 0 ? 0 : (P0); _Pragma("unroll") for (int t = 0; t < 2; ++t) _Pragma("unroll") for (int dt = 0; dt < 2; ++dt) { const bf16_t* vq_ = VTh + ((size_t)((pc_ >> 2) + 4 * t + hi) * 64 + dt * 32) * 4; \
            vpk[t][dt][0] = *(const u32x2*)vq_; vpk[t][dt][1] = *(const u32x2*)(vq_ + 2 * 64 * 4); } } } while (0)
    SB_LOAD_TILE(ptop);
    for (int p0 = ptop; p0 > -32; p0 -= 32) {
        bf16x8 kf[4], va[2][2];
#pragma unroll
        for (int ds = 0; ds < 4; ++ds) { if (SAMPLE) kf[ds] = pack8(kraw[2 * ds][0], kraw[2 * ds][1], kraw[2 * ds][2], kraw[2 * ds][3], kraw[2 * ds + 1][0], kraw[2 * ds + 1][1], kraw[2 * ds + 1][2], kraw[2 * ds + 1][3]); else kf[ds] = kq[ds]; }
#pragma unroll
        for (int t = 0; t < 2; ++t)
#pragma unroll
            for (int dt = 0; dt < 2; ++dt) { if (SAMPLE) va[t][dt] = pack8(vraw[t][dt][0], vraw[t][dt][1], vraw[t][dt][2], vraw[t][dt][3], vraw[t][dt][4], vraw[t][dt][5], vraw[t][dt][6], vraw[t][dt][7]);
                else va[t][dt] = __builtin_bit_cast(bf16x8, (u32x4){vpk[t][dt][0].x, vpk[t][dt][0].y, vpk[t][dt][1].x, vpk[t][dt][1].y}); }
        SB_LOAD_TILE(p0 - 32);
        asm volatile("" ::: "memory");
        f32x16 acc;
#pragma unroll
        for (int i = 0; i < 16; ++i) acc[i] = 0.f;
#pragma unroll
        for (int ds = 0; ds < 4; ++ds) acc = MFMA32(kf[ds], qh[ds], acc);
        float L[16], ls[16];
        if (p0 >= 0 && p0 + 32 <= qmin) {
#pragma unroll
            for (int i = 0; i < 16; ++i) { const float z = acc[i]; const float sp = fmaxf(z, 0.f) + flog(1.f + fexp(-fabsf(z))); L[i] = -sp; ls[i] = z - sp; }
        } else {
#pragma unroll
            for (int i = 0; i < 16; ++i) { const int kpos = p0 + crow(i, hi); const bool valid = (kpos < qpos) && (kpos >= 0); const float z = acc[i];
                const float sp = fmaxf(z, 0.f) + flog(1.f + fexp(-fabsf(z)));
                L[i] = valid ? -sp : 0.f; ls[i] = valid ? (z - sp) : -1e30f; }
        }
        float G[4], PG[4], T[4];
#pragma unroll
        for (int g = 0; g < 4; ++g) { G[g] = (L[4 * g] + L[4 * g + 1]) + (L[4 * g + 2] + L[4 * g + 3]); PG[g] = __shfl_xor(G[g], 32); T[g] = G[g] + PG[g]; }
        float A[4]; A[3] = 0.f; A[2] = T[3]; A[1] = T[3] + T[2]; A[0] = A[1] + T[1];
        float P[16];
#pragma unroll
        for (int g = 0; g < 4; ++g) { const float e3 = carry + A[g] + (hi == 0 ? PG[g] : 0.f), e2 = e3 + L[4 * g + 3], e1 = e2 + L[4 * g + 2], e0 = e1 + L[4 * g + 1];
            P[4 * g + 3] = fexp(ls[4 * g + 3] + e3); P[4 * g + 2] = fexp(ls[4 * g + 2] + e2); P[4 * g + 1] = fexp(ls[4 * g + 1] + e1); P[4 * g] = fexp(ls[4 * g] + e0); }
        carry += (T[0] + T[1]) + (T[2] + T[3]);
#pragma unroll
        for (int t = 0; t < 2; ++t) { const bf16x8 pb = pack8(P[8 * t], P[8 * t + 1], P[8 * t + 2], P[8 * t + 3], P[8 * t + 4], P[8 * t + 5], P[8 * t + 6], P[8 * t + 7]);
            oacc[0] = MFMA32(va[t][0], pb, oacc[0]); oacc[1] = MFMA32(va[t][1], pb, oacc[1]); }
        if (__all(carry < -110.0f)) break;
    }
    if (qvalid) { float* op = OSB + (size_t)qrow * 512 + h * 64 + 4 * hi;
#pragma unroll
        for (int dt = 0; dt < 2; ++dt)
#pragma unroll
            for (int g = 0; g < 4; ++g) *(f32x4*)(op + dt * 32 + 8 * g) = (f32x4){oacc[dt][4 * g], oacc[dt][4 * g + 1], oacc[dt][4 * g + 2], oacc[dt][4 * g + 3]}; }
}

__device__ __forceinline__ void hg_load(const float* PROJ, int row0, int tvalid, int h, int tg, int k, int coff, float (&zr)[16]) {
#pragma unroll
    for (int j = 0; j < 16; ++j) { const int t = 16 * tg + j, tc = t < tvalid ? t : 0; zr[j] = __uint_as_float((unsigned)((const bf16_t*)PROJ)[(size_t)(row0 + tc) * PLD + coff + h * 128 + k] << 16); }
}
__device__ __forceinline__ void hg_prep(const float (&zr)[16], const float (&qr)[16], int tvalid, float lbv, int tg, float (&loc)[16], float (&kk)[16], float (&qv)[16]) {
    float run = 0.f;
#pragma unroll
    for (int j = 0; j < 16; ++j) { const int t = 16 * tg + j; const bool ok = t < tvalid; const float z = ok ? zr[j] : 0.f, q = ok ? qr[j] : 0.f;
        const float ez = fexp(-fabsf(z)), inv = __builtin_amdgcn_rcpf(1.f + ez);
        const float sig = z >= 0.f ? inv : ez * inv, nsig = z >= 0.f ? ez * inv : inv;
        float lf = (lbv > 0.f) ? flog(lbv + (1.f - lbv) * sig) : (fminf(z, 0.f) - flog(1.f + ez));
        if (!ok) lf = 0.f;
        run += lf; loc[j] = run; kk[j] = ok ? (1.f - lbv) * nsig : 0.f; qv[j] = q * 0.08838834764831845f; }
}
__device__ __forceinline__ void hg_h1(ldsp lds, const float* PROJ, const float (&zr)[16], int row0, int tvalid, int h, float lbv, float* dsOut, float* ddOut, const float* s0, int tid, int lane, int wave) {
    const int tg = tid >> 7, k = tid & 127;
    float loc[16], kk[16], qv[16], iv[16];
#pragma unroll
    for (int j = 0; j < 16; ++j) { const int ta = 16 * tg + j, tc = ta < tvalid ? ta : 0; const float x = __uint_as_float((unsigned)((const bf16_t*)PROJ)[(size_t)(row0 + tc) * PLD + 2560 + h * 128 + k] << 16); iv[j] = ta < tvalid ? x : 0.f; }
    hg_prep(zr, zr, tvalid, lbv, tg, loc, kk, qv);
    LAS float* TOT = (LAS float*)lds; LAS float* DK = (LAS float*)(lds + 2048);
    TOT[tg * 128 + k] = loc[15];
    __syncthreads();
    const float t0 = TOT[k], t1 = TOT[128 + k], t2 = TOT[256 + k], t3 = TOT[384 + k];
    const float r1 = t0, r2 = r1 + t1, r3 = r2 + t2, r4 = r3 + t3;
    const float rtg = tg == 0 ? 0.f : (tg == 1 ? r1 : (tg == 2 ? r2 : r3));
    { unsigned w[8];
#pragma unroll
      for (int jj = 0; jj < 8; ++jj) w[jj] = pk2(kk[2 * jj] * fexp(r4 - rtg - loc[2 * jj]), kk[2 * jj + 1] * fexp(r4 - rtg - loc[2 * jj + 1]));
      *(LAS u32x4*)(lds + 4096 + k * 144 + tg * 32) = (u32x4){w[0], w[1], w[2], w[3]}; *(LAS u32x4*)(lds + 4096 + k * 144 + tg * 32 + 16) = (u32x4){w[4], w[5], w[6], w[7]};
#pragma unroll
      for (int jj = 0; jj < 8; ++jj) w[jj] = pk2(iv[2 * jj], iv[2 * jj + 1]);
      *(LAS u32x4*)(lds + 22528 + k * 144 + tg * 32) = (u32x4){w[0], w[1], w[2], w[3]}; *(LAS u32x4*)(lds + 22528 + k * 144 + tg * 32 + 16) = (u32x4){w[4], w[5], w[6], w[7]}; }
    if (tg == 0) { const float dk = fexp(r4); DK[k] = dk; if (ddOut) ddOut[k] = dk; }
    __syncthreads();
    const int r32 = lane & 31, hi = lane >> 5, km = wave & 3, vn0 = (wave >> 2) * 2;
#pragma unroll
    for (int vv = 0; vv < 2; ++vv) { f32x16 acc;
#pragma unroll
        for (int i = 0; i < 16; ++i) acc[i] = 0.f;
#pragma unroll
        for (int ks = 0; ks < 4; ++ks) { const bf16x8 a = *(LAS bf16x8*)(lds + 4096 + (32 * km + r32) * 144 + ks * 32 + hi * 16);
            const bf16x8 b = *(LAS bf16x8*)(lds + 22528 + (32 * (vn0 + vv) + r32) * 144 + ks * 32 + hi * 16); acc = MFMA32(a, b, acc); }
        const int v = 32 * (vn0 + vv) + r32;
#pragma unroll
        for (int i = 0; i < 16; ++i) { if (s0) { const int kr = 32 * km + crow(i, hi); dsOut[kr * 128 + v] = acc[i] + DK[kr] * s0[kr * 128 + v]; } }
        if (!s0) { bf16_t* db = (bf16_t*)dsOut + v * 128 + 32 * km + 4 * hi;
#pragma unroll
            for (int g = 0; g < 4; ++g) *(u32x2*)(db + 8 * g) = (u32x2){pk2(acc[4 * g], acc[4 * g + 1]), pk2(acc[4 * g + 2], acc[4 * g + 3])}; } }
    __syncthreads();
}
__device__ __forceinline__ void hg_h3(ldsp lds, const float* PROJ, const float (&zr)[16], int row0, int tvalid, int h, float lbv, const float* Ssrc, bool sbf, const float* hgain, bf16_t* MIX, int tid, int lane, int wave) {
    constexpr int QE = 2048, KE = 19456, ST = 62976, IV = 97792, PM = 116224, OST = 19456;
    const int tg = tid >> 7, k = tid & 127;
    float loc[16], kk[16], qv[16];
    f32x4 gv[4], gav[4];
    float qr[16]; hg_load(PROJ, row0, tvalid, h, tg, k, 1536, qr);
    hg_prep(zr, qr, tvalid, lbv, tg, loc, kk, qv);
    LAS float* TOT = (LAS float*)lds;
    TOT[tg * 128 + k] = loc[15];
    for (int i = tid; i < 2304; i += 512) ((LAS unsigned*)(lds + PM))[i] = 0u;
    if (sbf) {
#pragma unroll
        for (int jj = 0; jj < 4; ++jj) { const int cidx = tid + 512 * jj, v = cidx >> 4, kc = cidx & 15;
            *(LAS u32x4*)(lds + ST + v * 272 + kc * 16) = *(const u32x4*)((const bf16_t*)Ssrc + v * 128 + kc * 8); }
    } else {
#pragma unroll
        for (int jj = 0; jj < 16; ++jj) { const int kp = 2 * ((tid >> 7) + 4 * jj), v = tid & 127;
            *(LAS unsigned*)(lds + ST + v * 272 + kp * 2) = pk2(Ssrc[kp * 128 + v], Ssrc[(kp + 1) * 128 + v]); } }
    { unsigned w[8];
#pragma unroll
      for (int jj = 0; jj < 8; ++jj) { const int ta = 16 * tg + 2 * jj, t0 = ta < tvalid ? ta : 0, t1 = (ta + 1) < tvalid ? ta + 1 : 0;
          const float x0 = __uint_as_float((unsigned)((const bf16_t*)PROJ)[(size_t)(row0 + t0) * PLD + 2560 + h * 128 + k] << 16), x1 = __uint_as_float((unsigned)((const bf16_t*)PROJ)[(size_t)(row0 + t1) * PLD + 2560 + h * 128 + k] << 16);
          w[jj] = pk2(ta < tvalid ? x0 : 0.f, (ta + 1) < tvalid ? x1 : 0.f); }
      *(LAS u32x4*)(lds + IV + k * 144 + tg * 32) = (u32x4){w[0], w[1], w[2], w[3]}; *(LAS u32x4*)(lds + IV + k * 144 + tg * 32 + 16) = (u32x4){w[4], w[5], w[6], w[7]}; }
    __syncthreads();
    { const int t = tid >> 3, v0 = (tid & 7) * 16; const int tc = t < tvalid ? t : 0; const bf16_t* gp = (const bf16_t*)PROJ + (size_t)(row0 + tc) * PLD + 3072 + h * 128 + v0; const float* hg = hgain + h * 128 + v0;
      const u32x4 g0 = *(const u32x4*)gp, g1 = *(const u32x4*)(gp + 8);
      gv[0] = (f32x4){__uint_as_float(g0.x << 16), __uint_as_float(g0.x & 0xffff0000u), __uint_as_float(g0.y << 16), __uint_as_float(g0.y & 0xffff0000u)};
      gv[1] = (f32x4){__uint_as_float(g0.z << 16), __uint_as_float(g0.z & 0xffff0000u), __uint_as_float(g0.w << 16), __uint_as_float(g0.w & 0xffff0000u)};
      gv[2] = (f32x4){__uint_as_float(g1.x << 16), __uint_as_float(g1.x & 0xffff0000u), __uint_as_float(g1.y << 16), __uint_as_float(g1.y & 0xffff0000u)};
      gv[3] = (f32x4){__uint_as_float(g1.z << 16), __uint_as_float(g1.z & 0xffff0000u), __uint_as_float(g1.w << 16), __uint_as_float(g1.w & 0xffff0000u)};
#pragma unroll
      for (int c = 0; c < 4; ++c) gav[c] = *(const f32x4*)(hg + 4 * c); }
    const float t0 = TOT[k], t1 = TOT[128 + k], t2 = TOT[256 + k];
    const float r1 = t0, r2 = r1 + t1, r3 = r2 + t2;
    const float rtg = tg == 0 ? 0.f : (tg == 1 ? r1 : (tg == 2 ? r2 : r3));
#pragma unroll
    for (int j = 0; j < 16; ++j) *(LAS unsigned short*)(lds + QE + (16 * tg + j) * 272 + k * 2) = (unsigned short)f2bf(qv[j] * fexp(loc[j]));
#pragma unroll
    for (int i = 0; i < 4; ++i) { if (i >= tg) { const float ri = i == 0 ? 0.f : (i == 1 ? r1 : (i == 2 ? r2 : r3)); const int rb = 8 * i * (i + 1);
#pragma unroll
        for (int j = 0; j < 16; ++j) *(LAS unsigned short*)(lds + KE + (rb + 16 * tg + j) * 272 + k * 2) = (unsigned short)f2bf(kk[j] * fexp(fminf(ri - rtg - loc[j], 80.f))); } }
    __syncthreads();
    { const int c16 = lane & 15, q4 = lane >> 4;
      for (int tix = wave; tix < 10; tix += 8) { const int i = tix < 1 ? 0 : (tix < 3 ? 1 : (tix < 6 ? 2 : 3)), j = tix - i * (i + 1) / 2, rb = 8 * i * (i + 1);
          f32x4 acc = {0.f, 0.f, 0.f, 0.f};
#pragma unroll
          for (int ks = 0; ks < 4; ++ks) { const bf16x8 a = *(LAS bf16x8*)(lds + QE + (16 * i + c16) * 272 + ks * 64 + q4 * 16);
              const bf16x8 b = *(LAS bf16x8*)(lds + KE + (rb + 16 * j + c16) * 272 + ks * 64 + q4 * 16); acc = MFMA16(a, b, acc); }
#pragma unroll
          for (int ii = 0; ii < 4; ++ii) { const int tl = 4 * q4 + ii; float pv = acc[ii]; if (i == j && c16 > tl) pv = 0.f;
              *(LAS unsigned short*)(lds + PM + (16 * i + tl) * 144 + (16 * j + c16) * 2) = (unsigned short)f2bf(pv); } } }
    __syncthreads();
#pragma unroll
    for (int j = 0; j < 16; ++j) *(LAS unsigned short*)(lds + QE + (16 * tg + j) * 272 + k * 2) = (unsigned short)f2bf(qv[j] * fexp(rtg + loc[j]));
    __syncthreads();
    { const int r32 = lane & 31, hi = lane >> 5, tm = wave & 1, vn = wave >> 1; f32x16 acc;
#pragma unroll
      for (int i = 0; i < 16; ++i) acc[i] = 0.f;
#pragma unroll
      for (int ks = 0; ks < 8; ++ks) { const bf16x8 a = *(LAS bf16x8*)(lds + QE + (32 * tm + r32) * 272 + ks * 32 + hi * 16);
          const bf16x8 b = *(LAS bf16x8*)(lds + ST + (32 * vn + r32) * 272 + ks * 32 + hi * 16); acc = MFMA32(a, b, acc); }
#pragma unroll
      for (int ks = 0; ks < 4; ++ks) { const bf16x8 a = *(LAS bf16x8*)(lds + PM + (32 * tm + r32) * 144 + ks * 32 + hi * 16);
          const bf16x8 b = *(LAS bf16x8*)(lds + IV + (32 * vn + r32) * 144 + ks * 32 + hi * 16); acc = MFMA32(a, b, acc); }
#pragma unroll
      for (int i = 0; i < 16; ++i) *(LAS float*)(lds + OST + (32 * tm + crow(i, hi)) * 528 + (32 * vn + r32) * 4) = acc[i]; }
    __syncthreads();
    { const int t = tid >> 3, v0 = (tid & 7) * 16; f32x4 o[4]; float ss = 0.f;
#pragma unroll
      for (int c = 0; c < 4; ++c) { o[c] = *(LAS f32x4*)(lds + OST + t * 528 + (v0 + 4 * c) * 4); ss += (o[c][0] * o[c][0] + o[c][1] * o[c][1]) + (o[c][2] * o[c][2] + o[c][3] * o[c][3]); }
      ss += __shfl_xor(ss, 1); ss += __shfl_xor(ss, 2); ss += __shfl_xor(ss, 4);
      const float rs = rsqrtf(ss * (1.0f / 128.0f) + 1e-6f);
      if (t < tvalid) { const size_t row = (size_t)(row0 + t); unsigned w[8];
#pragma unroll
          for (int c = 0; c < 4; ++c) { const f32x4 g = gv[c], ga = gav[c]; f32x4 r;
#pragma unroll
              for (int e = 0; e < 4; ++e) r[e] = o[c][e] * rs * ga[e] * (g[e] * __builtin_amdgcn_rcpf(1.f + fexp(-g[e])));
              w[2 * c] = pk2(r[0], r[1]); w[2 * c + 1] = pk2(r[2], r[3]); }
          bf16_t* mp = MIX + row * 1024 + 512 + h * 128 + v0;
          *(u32x4*)mp = (u32x4){w[0], w[1], w[2], w[3]}; *(u32x4*)(mp + 8) = (u32x4){w[4], w[5], w[6], w[7]}; } }
    __syncthreads();
}

__device__ __forceinline__ void xattn_item(ldsp lds, const bf16_t* QM, const float* Kg, const float* Vg, const bf16_t* Kb, const bf16_t* Vtb, int row0, int tvalid, int hm, bf16_t* OM, int tid, int lane, int wave) {
    constexpr int KM = 0, QS = 69632, PMX = 87040, RMO = 120832, RSO = 121344, VT = 0;
    if (Kb) {
#pragma unroll
        for (int jj = 0; jj < 8; ++jj) { const int cidx = tid + 512 * jj, m = cidx >> 4, dc = cidx & 15; *(LAS u32x4*)(lds + KM + m * 272 + dc * 16) = *(const u32x4*)(Kb + m * 128 + dc * 8); }
    } else {
#pragma unroll
        for (int jj = 0; jj < 8; ++jj) { const int cidx = tid + 512 * jj, m = cidx >> 4, dc = cidx & 15; const float* p = Kg + (size_t)m * 512 + dc * 8;
            const f32x4 a = *(const f32x4*)p, b = *(const f32x4*)(p + 4);
            *(LAS u32x4*)(lds + KM + m * 272 + dc * 16) = (u32x4){pk2(a[0], a[1]), pk2(a[2], a[3]), pk2(b[0], b[1]), pk2(b[2], b[3])}; } }
#pragma unroll
    for (int jj = 0; jj < 2; ++jj) { const int cidx = tid + 512 * jj, t = cidx >> 4, dc = cidx & 15; u32x4 w = {0u, 0u, 0u, 0u};
        if (t < tvalid) w = *(const u32x4*)(QM + (size_t)(row0 + t) * 512 + hm * 128 + dc * 8);
        *(LAS u32x4*)(lds + QS + t * 272 + dc * 16) = w; }
    float vr0[32], vr1[32]; u32x4 vq[8];
    if (Vtb) {
#pragma unroll
        for (int jj = 0; jj < 8; ++jj) { const int cidx = tid + 512 * jj, d = cidx >> 5, mc = cidx & 31; vq[jj] = *(const u32x4*)(Vtb + d * 256 + mc * 8); }
    } else {
#pragma unroll
        for (int jj = 0; jj < 32; ++jj) { const int idx = tid + 512 * jj, d = idx & 127, mp = idx >> 7; vr0[jj] = Vg[(size_t)(2 * mp) * 512 + d]; vr1[jj] = Vg[(size_t)(2 * mp + 1) * 512 + d]; } }
    __syncthreads();
    const int tgp = wave & 3, mh = wave >> 2, c16 = lane & 15, q4 = lane >> 4, tok = 16 * tgp + c16;
    LAS float* RM = (LAS float*)(lds + RMO); LAS float* RS = (LAS float*)(lds + RSO);
    f32x4 sacc[8];
    { bf16x8 bq[4];
#pragma unroll
      for (int ks = 0; ks < 4; ++ks) bq[ks] = *(LAS bf16x8*)(lds + QS + tok * 272 + ks * 64 + q4 * 16);
#pragma unroll
      for (int j = 0; j < 8; ++j) { f32x4 acc = {0.f, 0.f, 0.f, 0.f};
#pragma unroll
          for (int ks = 0; ks < 4; ++ks) { const bf16x8 a = *(LAS bf16x8*)(lds + KM + (128 * mh + 16 * j + c16) * 272 + ks * 64 + q4 * 16); acc = MFMA16(a, bq[ks], acc); }
          sacc[j] = acc; } }
    float mx = -3.0e38f;
#pragma unroll
    for (int j = 0; j < 8; ++j) mx = fmaxf(fmaxf(mx, fmaxf(sacc[j][0], sacc[j][1])), fmaxf(sacc[j][2], sacc[j][3]));
    mx = fmaxf(mx, __shfl_xor(mx, 16)); mx = fmaxf(mx, __shfl_xor(mx, 32));
    if (q4 == 0) RM[mh * 64 + tok] = mx;
    __syncthreads();
    { const float m = fmaxf(RM[tok], RM[64 + tok]); float sum = 0.f;
#pragma unroll
      for (int j = 0; j < 8; ++j) { const float p0 = fexp(sacc[j][0] - m), p1 = fexp(sacc[j][1] - m), p2 = fexp(sacc[j][2] - m), p3 = fexp(sacc[j][3] - m);
          sum += (p0 + p1) + (p2 + p3);
          *(LAS u32x2*)(lds + PMX + tok * 528 + (128 * mh + 16 * j + 4 * q4) * 2) = (u32x2){pk2(p0, p1), pk2(p2, p3)}; }
      sum += __shfl_xor(sum, 16); sum += __shfl_xor(sum, 32);
      if (q4 == 0) RS[mh * 64 + tok] = sum; }
    __syncthreads();
    if (Vtb) {
#pragma unroll
        for (int jj = 0; jj < 8; ++jj) { const int cidx = tid + 512 * jj, d = cidx >> 5, mc = cidx & 31; *(LAS u32x4*)(lds + VT + d * 528 + mc * 16) = vq[jj]; }
    } else {
#pragma unroll
        for (int jj = 0; jj < 32; ++jj) { const int idx = tid + 512 * jj, d = idx & 127, mp = idx >> 7;
            *(LAS unsigned*)(lds + VT + d * 528 + mp * 4) = pk2(vr0[jj], vr1[jj]); } }
    __syncthreads();
    { const int r32 = lane & 31, hi = lane >> 5, tm = wave & 1, dn = wave >> 1; f32x16 acc;
#pragma unroll
      for (int i = 0; i < 16; ++i) acc[i] = 0.f;
#pragma unroll
      for (int ks = 0; ks < 16; ++ks) { const bf16x8 a = *(LAS bf16x8*)(lds + PMX + (32 * tm + r32) * 528 + ks * 32 + hi * 16);
          const bf16x8 b = *(LAS bf16x8*)(lds + VT + (32 * dn + r32) * 528 + ks * 32 + hi * 16); acc = MFMA32(a, b, acc); }
#pragma unroll
      for (int i = 0; i < 16; ++i) { const int tk = 32 * tm + crow(i, hi); const float inv = __builtin_amdgcn_rcpf(RS[tk] + RS[64 + tk]);
          if (tk < tvalid) OM[(size_t)(row0 + tk) * 512 + hm * 128 + 32 * dn + r32] = (bf16_t)f2bf(acc[i] * inv); } }
    __syncthreads();
}
#define XB_TMO      128
#define XB_XCNT(j)  (256  + 64 * (j))
#define XB_XSUB(j)  (1280 + 64 * (j))
#define XB_XGEN(j)  (2304 + 64 * (j))
#define XB_TOP      3328
#define XB_TOPGEN   3392
#define XCD_BAR_WORDS 3456
#define XB_SPIN_CAP (1u << 18)

__device__ __forceinline__ unsigned xb_ld(unsigned* p)              { return __hip_atomic_load(p, __ATOMIC_RELAXED, __HIP_MEMORY_SCOPE_AGENT); }
__device__ __forceinline__ unsigned xb_add(unsigned* p, unsigned v) { return __hip_atomic_fetch_add(p, v, __ATOMIC_RELAXED, __HIP_MEMORY_SCOPE_AGENT); }
__device__ __forceinline__ unsigned xb_xcc_id() { return (unsigned)__builtin_amdgcn_s_getreg((3 << 11) | 20) & 0xFu; }
#define XB_SPIN(cond, bar) do { unsigned _sp = 0; while (cond) { __builtin_amdgcn_s_sleep(1); \
    if ((++_sp & 255u) == 0u) { if (xb_ld(&(bar)[XB_TMO])) break; if (_sp > XB_SPIN_CAP) { atomicAdd(&(bar)[XB_TMO], 1u); break; } } } } while (0)

struct XcdBarrier {
    unsigned* bar; unsigned x;
    volatile LAS unsigned* st;
};

__device__ __forceinline__ XcdBarrier xcd_barrier_post(unsigned* bar, volatile LAS unsigned* st) {
    XcdBarrier b; b.bar = bar; b.x = xb_xcc_id(); b.st = st;
    if (threadIdx.x == 0) (void)xb_add(&bar[XB_XCNT(b.x)], 1u);
    return b;
}
__device__ __forceinline__ void xcd_barrier_complete(unsigned* bar, unsigned x, unsigned& nloc, unsigned& nx) {
    const unsigned G = gridDim.x * gridDim.y * gridDim.z;
    unsigned sum, cnt, mine, sp = 0u;
    for (;;) {
        sum = 0u; cnt = 0u; mine = 0u;
#pragma unroll
        for (unsigned j = 0; j < 16; ++j) { const unsigned c = xb_ld(&bar[XB_XCNT(j)]); sum += c; cnt += (c > 0u) ? 1u : 0u; mine = (j == x) ? c : mine; }
        if (sum == G) break;
        __builtin_amdgcn_s_sleep(1);
        if ((++sp & 255u) == 0u) { if (xb_ld(&bar[XB_TMO])) break; if (sp > XB_SPIN_CAP) { atomicAdd(&bar[XB_TMO], 1u); break; } }
    }
    nloc = mine > 0u ? mine : 1u; nx = cnt > 0u ? cnt : 1u;
}

__device__ __forceinline__ void xcd_barrier(const XcdBarrier& b) {
    asm volatile("s_waitcnt vmcnt(0)" ::: "memory");
    __syncthreads();
    if (threadIdx.x == 0) {
        unsigned* bar = b.bar;
        __builtin_amdgcn_s_waitcnt(0);
        unsigned nloc = b.st[0], nx = b.st[1];
        if (nloc == 0u) { xcd_barrier_complete(bar, b.x, nloc, nx); b.st[0] = nloc; b.st[1] = nx; }
        const unsigned old = xb_add(&bar[XB_XSUB(b.x)], 1u);
        const unsigned gen = old / nloc;
        if (old + 1u == (gen + 1u) * nloc) {
            __builtin_amdgcn_fence(__ATOMIC_RELEASE, "agent");
            asm volatile("s_waitcnt vmcnt(0)" ::: "memory");
            const unsigned og = xb_add(&bar[XB_TOP], 1u);
            const unsigned tg = og / nx;
            if (og + 1u == (tg + 1u) * nx) xb_add(&bar[XB_TOPGEN], 1u);
            else XB_SPIN(xb_ld(&bar[XB_TOPGEN]) == tg, bar);
            __builtin_amdgcn_fence(__ATOMIC_ACQUIRE, "agent");
            xb_add(&bar[XB_XGEN(b.x)], 1u);
            asm volatile("s_waitcnt vmcnt(0)" ::: "memory");
        } else {
            XB_SPIN(xb_ld(&bar[XB_XGEN(b.x)]) == gen, bar);
            __builtin_amdgcn_fence(__ATOMIC_ACQUIRE, "agent");
            asm volatile("s_waitcnt vmcnt(0)" ::: "memory");
        }
    }
    __syncthreads();
}

__device__ __forceinline__ const float* gptr_(unsigned long long v) { return (const float*)(const __attribute__((address_space(1))) float*)v; }
#define GPTR(p) gptr_(p)
#define FPTR(p) ((const float*)(p))
#define OPQ(x) asm volatile("" : "+s"(x))
#define OPQP(T, x) do { unsigned long long xi_ = (unsigned long long)(x); asm volatile("" : "+s"(xi_)); x = (T*)(__attribute__((address_space(1))) T*)xi_; } while (0)
struct Args { const float* in[24]; float* out; unsigned char* ws; };
__global__ void __launch_bounds__(512, 2) mega_fwd(Args args) {
    extern __shared__ __attribute__((aligned(16))) unsigned char lds_raw[];
    cg::grid_group grid = cg::this_grid();
    ldsp lds = (ldsp)lds_raw;
    unsigned char* const ws = args.ws; float* const out = args.out;
#define WAVE_IDS int tid = threadIdx.x; asm volatile("" : "+v"(tid)); const int lane = tid & 63, wave = __builtin_amdgcn_readfirstlane(tid >> 6), G = gridDim.x, bid = blockIdx.x, gw = bid * 8 + wave, NGW = G * 8; (void)lane; (void)gw; (void)NGW

    {
        WAVE_IDS;
        if (bid == 0) for (int i = tid; i < XCD_BAR_WORDS; i += 512) ((unsigned*)(ws + WS_BAR))[i] = 0u;
        if (bid == 0 && tid < 8) ((unsigned*)(ws + WS_CTR))[tid] = 0u;
        if (tid < 2) ((LAS unsigned*)(lds + LDS_BARST))[tid] = 0u;
        if (bid == 0 && tid == 0) { const float** tab = (const float**)ws;
#pragma unroll
            for (int i = 0; i < 24; ++i) tab[i] = args.in[i]; }
        bf16_t* XB = (bf16_t*)(ws + WS_XB); float* SSQ = (float*)(ws + WS_SSQ); bf16_t* MEMB = (bf16_t*)(ws + WS_MEMB); float* MEMSSQ = (float*)(ws + WS_MEMSSQ); bf16_t* WMKV = (bf16_t*)(ws + WS_WMKV);
        LAS float* scr = (LAS float*)(lds + wave * 16384);
#define CONV_ITEM(PTR, L_, R_, WSB) do { const int l = (L_); int r = (R_); unsigned char* wl = (WSB) + WS_W0 + (size_t)l * WS_WL; bf16_t* wmkv = (bf16_t*)((WSB) + WS_WMKV); \
            if (r < 1792) { transpose_item(PTR(10) + (size_t)l * 1024 * 3584, 1024, 3584, (bf16_t*)(wl + W_IN), 0, PTR(9) + l * 1024, scr, r, lane); break; } r -= 1792; \
            if (r < 512)  { transpose_item(PTR(13) + (size_t)l * 1024 * 1024, 1024, 1024, (bf16_t*)(wl + W_OUT), 0, nullptr, scr, r, lane); break; } r -= 512; \
            if (r < 256)  { transpose_item(PTR(16) + (size_t)l * 1024 * 512, 1024, 512, (bf16_t*)(wl + W_MQ), 0, PTR(14) + l * 1024, scr, r, lane); break; } r -= 256; \
            if (r < 256)  { transpose_item(PTR(17) + (size_t)l * 1024 * 512, 1024, 512, wmkv + (size_t)l * 1024 * 1024, 0, PTR(15) + l * 1024, scr, r, lane); break; } r -= 256; \
            if (r < 256)  { transpose_item(PTR(18) + (size_t)l * 1024 * 512, 1024, 512, wmkv + (size_t)l * 1024 * 1024, 512, PTR(15) + l * 1024, scr, r, lane); break; } r -= 256; \
            if (r < 256)  { transpose_item(PTR(19) + (size_t)l * 512 * 1024, 512, 1024, (bf16_t*)(wl + W_MO), 0, nullptr, scr, r, lane); break; } r -= 256; \
            if (r < 2048) { transpose_item(PTR(21) + (size_t)l * 1024 * 4096, 1024, 4096, (bf16_t*)(wl + W_1), 0, PTR(20) + l * 1024, scr, r, lane); break; } r -= 2048; \
            transpose_item(PTR(22) + (size_t)l * 4096 * 1024, 4096, 1024, (bf16_t*)(wl + W_2), 0, nullptr, scr, r, lane); } while (0)
#define ARGP(i) args.in[i]
        const bool defer = (G == 256);
        for (int it = gw; it < (defer ? 3328 + 512 : 14848); it += NGW) {
            if (defer) { if (it < 3328) CONV_ITEM(ARGP, 0, it, ws); else CONV_ITEM(ARGP, 1, 2560 + (it - 3328), ws); }
            else { if (it < 7424) CONV_ITEM(ARGP, 0, it, ws); else CONV_ITEM(ARGP, 1, it - 7424, ws); } }
#undef ARGP
#define ROW_PTRS(m, S, D, Q, R) do { if ((m) < NPROMPT) { S = args.in[0] + (size_t)(m) * 1024; D = XB + (size_t)(m) * 1024; Q = SSQ + (size_t)(m) * 16; R = (float*)(ws + WS_RSTD) + (m); } \
            else if ((m) < M_ALL) { S = args.in[1] + (size_t)((m) - NPROMPT) * 1024; D = XB + (size_t)(m) * 1024; Q = SSQ + (size_t)(m) * 16; R = (float*)(ws + WS_RSTD) + (m); } \
            else { S = args.in[2] + (size_t)((m) - M_ALL) * 1024; D = MEMB + (size_t)((m) - M_ALL) * 1024; Q = MEMSSQ + (size_t)((m) - M_ALL) * 16; R = (float*)(ws + WS_MEMRSTD) + ((m) - M_ALL); } } while (0)
        for (int m0 = gw; m0 < M_ALL + 512; m0 += 2 * NGW) { const bool hasB = m0 + NGW < M_ALL + 512; const int m1 = hasB ? m0 + NGW : m0;
            const float *sA, *sB; bf16_t *dA, *dB; float *qA, *qB, *rA, *rB;
            ROW_PTRS(m0, sA, dA, qA, rA); ROW_PTRS(m1, sB, dB, qB, rB);
            row_prep2(sA, dA, qA, rA, sB, dB, qB, rB, hasB, lane); }
#undef ROW_PTRS
    }
    grid.sync();
    (void)xcd_barrier_post((unsigned*)(ws + WS_BAR), (volatile LAS unsigned*)(lds + LDS_BARST));
#define GRID_BAR() do { XcdBarrier b_; b_.bar = (unsigned*)(ws + WS_BAR); b_.x = xb_xcc_id(); b_.st = (volatile LAS unsigned*)(lds + LDS_BARST); xcd_barrier(b_); } while (0)

#pragma nounroll
    for (int l = 0; l < 2; ++l) {
#pragma nounroll
        for (int q = 0; q < (l == 0 ? 2 : 1); ++q) {
            WAVE_IDS; unsigned char* w_ = ws; float* o_ = out; int l_ = l; OPQP(unsigned char, w_); OPQP(float, o_); OPQ(l_);
            Gemm g; EpiF32 E;
            if (q == 0) { g = Gemm{(const bf16_t*)(w_ + WS_XB), (const bf16_t*)(w_ + WS_W0 + (size_t)l_ * WS_WL + W_IN), M_ALL, 3584, 1024};
                E = EpiF32{0, (const float*)(w_ + WS_RSTD), (float*)(w_ + WS_PROJ), o_, l_, (bf16_t*)(w_ + WS_VT), (bf16_t*)(w_ + WS_KB)}; }
            else { g = Gemm{(const bf16_t*)(w_ + WS_MEMB), (const bf16_t*)(w_ + WS_WMKV), 512, 2048, 1024};
                E = EpiF32{1, (const float*)(w_ + WS_MEMRSTD), nullptr, o_, l_, (bf16_t*)(w_ + WS_MVT), (bf16_t*)(w_ + WS_MKB)}; }
            StaticOrder S; S.init(g.M, g.N, G, q == 0 ? bid : (bid + 16) % G);
            gemm_phase<EpiF32, StaticOrder, true, true>(lds, g, S, E);
        }
        if (l == 0 && gridDim.x == 256 && blockIdx.x >= 156 && blockIdx.x < 240) {
            WAVE_IDS; unsigned char* w_ = ws; OPQP(unsigned char, w_);
            const unsigned long long* tabc = (const unsigned long long*)w_; LAS float* scr = (LAS float*)(lds + wave * 16384);
#define TABP(i) FPTR(tabc[i])
            for (int j = (bid - 156) * 8 + wave; j < 4096; j += 84 * 8) CONV_ITEM(TABP, 0, 3328 + j, w_);
#undef TABP
        }
        GRID_BAR();
#pragma nounroll
        for (int ph = 0; ph < 3; ++ph) {
            WAVE_IDS; unsigned char* w_ = ws; float* o_ = out; int l_ = l; OPQP(unsigned char, w_); OPQP(float, o_); OPQ(l_);
            const unsigned long long* tab = (const unsigned long long*)w_;
            float* PROJ = (float*)(w_ + WS_PROJ); float* OSB = (float*)(w_ + WS_OSB); bf16_t* MIX = (bf16_t*)(w_ + WS_MIX); float* DS = (float*)(w_ + WS_DS); float* DD = (float*)(w_ + WS_DD);
            if (ph != 1) {
                const int nit = ph == 0 ? 1152 : 1024;
                const float* state_hgrn = GPTR(tab[5]); const float* lb_logits = GPTR(tab[8]); const float* hgain = GPTR(tab[12]) + l_ * 512;
#define HG_DECODE(IT, ROW0, TV, H) do { if ((IT) < 1024) { const int bh_ = (IT) >> 7; H = bh_ & 3; ROW0 = (bh_ >> 2) * 8192 + ((IT) & 127) * 64; TV = 64; } \
                    else { const int si_ = (IT) - 1024; H = si_ & 3; ROW0 = NPROMPT + 16 * (si_ >> 2); TV = 16; } } while (0)
#define HG_MAP(Q) (ph == 0 ? ((Q) < 128 ? 1024 + (Q) : (Q) - 128) : (Q))
                volatile LAS unsigned* LW = (volatile LAS unsigned*)(lds + LDS_BARST);
                unsigned* ctr = (unsigned*)(w_ + WS_CTR) + 2 * l_;
                unsigned nextq = 0; int cur;
                if (ph == 0) { if (tid == 0) LW[4] = atomicAdd(ctr, 1u); __syncthreads(); cur = (int)LW[4]; if (tid == 0) nextq = atomicAdd(ctr, 1u); }
                else cur = bid;
                while (cur < nit) {
                    const int it = HG_MAP(cur); int nxt;
                    if (ph == 0) { __syncthreads(); if (tid == 0) LW[4] = nextq; __syncthreads(); nxt = (int)LW[4]; if (tid == 0 && nxt < nit) nextq = atomicAdd(ctr, 1u); }
                    else nxt = cur + G;
                    int row0, tvalid, h; HG_DECODE(it, row0, tvalid, h);
                    float* dsOut; float* ddOut; const float* s0; const float* Ssrc;
                    if (it < 1024) { const int bh = it >> 7, c = it & 127; dsOut = DS + (size_t)(bh * 128 + c) * 16384; ddOut = DD + (size_t)(bh * 128 + c) * 128; s0 = nullptr; Ssrc = dsOut; }
                    else { const int si = it - 1024, s = si >> 2; s0 = state_hgrn + (size_t)((l_ * 32 + s) * 4 + h) * 16384; Ssrc = s0; dsOut = o_ + O_HS + (size_t)((l_ * 32 + s) * 4 + h) * 16384; ddOut = nullptr; }
                    int t2 = tid; asm volatile("" : "+v"(t2)); const int lane2 = t2 & 63, tg2 = t2 >> 7, k2 = t2 & 127;
                    const int ch = h * 128 + k2;
                    const float lbv = l_ == 0 ? 0.f : __builtin_amdgcn_rcpf(1.f + fexp(lb_logits[ch] - lb_logits[512 + ch]));
                    { float zc[16]; hg_load(PROJ, row0, tvalid, h, tg2, k2, 2048, zc);
                      if (ph == 0) hg_h1(lds, PROJ, zc, row0, tvalid, h, lbv, dsOut, ddOut, s0, t2, lane2, wave);
                      if (ph == 2 || it >= 1024) hg_h3(lds, PROJ, zc, row0, tvalid, h, lbv, Ssrc, it < 1024, hgain, MIX, t2, lane2, wave); }
                    cur = nxt;
                }
#undef HG_DECODE
#undef HG_MAP
                if (ph == 0) { unsigned char* w2 = ws; float* o2 = out; int l2 = l; OPQP(unsigned char, w2); OPQP(float, o2); OPQ(l2);
                    const unsigned long long* tab2 = (const unsigned long long*)w2; unsigned* ctr2 = (unsigned*)(w2 + WS_CTR) + 2 * l2 + 1;
                    unsigned wq = 0; if (lane == 0) wq = atomicAdd(ctr2, 1u); int w = __builtin_amdgcn_readfirstlane(wq);
                    while (w < 4352) { unsigned wn = 0; if (lane == 0) wn = atomicAdd(ctr2, 1u);
                        int lane2 = lane; asm volatile("" : "+v"(lane2));
                        if (w < 256) sb_item<true>(4096 + w, l2, (const float*)(w2 + WS_PROJ), o2 + O_KP + (size_t)l2 * NPROMPT * 512, o2 + O_VP + (size_t)l2 * NPROMPT * 512,
                                                    o2 + O_KS + (size_t)l2 * 262144, o2 + O_VS + (size_t)l2 * 262144, GPTR(tab2[3]), GPTR(tab2[4]), (const bf16_t*)(w2 + WS_VT), (const bf16_t*)(w2 + WS_KB), (float*)(w2 + WS_OSB), lane2);
                        else sb_item<false>(w - 256, l2, (const float*)(w2 + WS_PROJ), o2 + O_KP + (size_t)l2 * NPROMPT * 512, o2 + O_VP + (size_t)l2 * NPROMPT * 512,
                                                    o2 + O_KS + (size_t)l2 * 262144, o2 + O_VS + (size_t)l2 * 262144, GPTR(tab2[3]), GPTR(tab2[4]), (const bf16_t*)(w2 + WS_VT), (const bf16_t*)(w2 + WS_KB), (float*)(w2 + WS_OSB), lane2);
                        w = __builtin_amdgcn_readfirstlane(wn); } }
            } else {
                if (wave < 4) {
                    for (int p = bid * 256 + tid; p < 65536; p += G * 256) { const int e = 2 * p, bh = e >> 14, rem = e & 16383, k = rem & 127, v = rem >> 7;
                        unsigned* dsp = (unsigned*)(DS + (size_t)(bh * 128) * 16384) + (rem >> 1); const float* ddp = DD + (size_t)(bh * 128) * 128 + k;
                        float S0 = 0.f, S1 = 0.f;
                        for (int c = 0; c < 128; c += 16) { unsigned x[16]; f32x2_t d[16];
#pragma unroll
                            for (int u = 0; u < 16; ++u) { x[u] = dsp[(size_t)(c + u) * 16384]; d[u] = *(const f32x2_t*)(ddp + (c + u) * 128); }
#pragma unroll
                            for (int u = 0; u < 16; ++u) { dsp[(size_t)(c + u) * 16384] = pk2(S0, S1);
                                S0 = d[u].x * S0 + __uint_as_float(x[u] << 16); S1 = d[u].y * S1 + __uint_as_float(x[u] & 0xffff0000u); } }
                        float* op = o_ + O_HP + (size_t)l_ * 131072 + (size_t)bh * 16384 + k * 128 + v; op[0] = S0; op[128] = S1; }
                } else {
                    const float* sbg = GPTR(tab[11]) + l_ * 512; const int NW4 = G * 4;
                    const f32x4 ga = *(const f32x4*)(sbg + lane * 8), gb = *(const f32x4*)(sbg + lane * 8 + 4);
                    int m = bid * 4 + (wave - 4); f32x4 a = {0.f, 0.f, 0.f, 0.f}, b = a;
                    if (m < M_ALL) { const f32x4* op = (const f32x4*)(OSB + (size_t)m * 512 + lane * 8); a = op[0]; b = op[1]; }
                    while (m < M_ALL) { const int mn = m + NW4; f32x4 an = a, bn = b;
                        if (mn < M_ALL) { const f32x4* op = (const f32x4*)(OSB + (size_t)mn * 512 + lane * 8); an = op[0]; bn = op[1]; }
                        float ss = ((a[0] * a[0] + a[1] * a[1]) + (a[2] * a[2] + a[3] * a[3])) + ((b[0] * b[0] + b[1] * b[1]) + (b[2] * b[2] + b[3] * b[3]));
                        ss = wave_sum(ss); const float rs = rsqrtf(ss * (1.0f / 512.0f) + 1e-6f);
                        *(u32x4*)(MIX + (size_t)m * 1024 + lane * 8) = (u32x4){pk2(a[0] * rs * ga[0], a[1] * rs * ga[1]), pk2(a[2] * rs * ga[2], a[3] * rs * ga[3]),
                                                                              pk2(b[0] * rs * gb[0], b[1] * rs * gb[1]), pk2(b[2] * rs * gb[2], b[3] * rs * gb[3])};
                        a = an; b = bn; m = mn; } }
            }
            GRID_BAR();
        }
#pragma nounroll
        for (int st = 0; st < 3; ++st) {
            { WAVE_IDS; unsigned char* w_ = ws; int l_ = l; OPQP(unsigned char, w_); OPQ(l_);
              const unsigned long long* tab = (const unsigned long long*)w_; unsigned char* wl = w_ + WS_W0 + (size_t)l_ * WS_WL;
              float* X = (float*)(w_ + WS_X);
              const bf16_t* A = (const bf16_t*)(w_ + (st == 0 ? WS_MIX : (st == 1 ? WS_OM : WS_H))); const bf16_t* Bt = (const bf16_t*)(wl + (st == 0 ? W_OUT : (st == 1 ? W_MO : W_2)));
              const int K = st == 0 ? 1024 : (st == 1 ? 512 : 4096);
              { Gemm g{A, Bt, NPROMPT, 1024, K, 0};
                EpiResid E{(st == 0 && l_ == 0) ? FPTR(tab[0]) : nullptr, nullptr, (st == 2 && l_ == 1) ? X : nullptr, (bf16_t*)(w_ + WS_XB), (float*)(w_ + WS_SSQ)};
                StaticOrder S; S.init(NPROMPT, 1024, G, bid);
                gemm_phase<EpiResid, StaticOrder, true, true>(lds, g, S, E); }
              { Gemm g{A, Bt, M_ALL, 1024, 256, K};
                EpiPart E{(float*)(w_ + WS_PART)};
                SplitOrder S; S.init(2, 1024, K / 256, G, bid, 64);
                gemm_phase<EpiPart, SplitOrder, true, true>(lds, g, S, E); } }
            GRID_BAR();
            { WAVE_IDS; unsigned char* w_ = ws; int l_ = l; OPQP(unsigned char, w_); OPQ(l_);
              const unsigned long long* tab = (const unsigned long long*)w_; const int nS = (st == 0 ? 1024 : (st == 1 ? 512 : 4096)) / 256;
              float* X = (float*)(w_ + WS_X); bf16_t* XB = (bf16_t*)(w_ + WS_XB); float* SSQ = (float*)(w_ + WS_SSQ); const float* PART = (const float*)(w_ + WS_PART);
              const float* bs = (st == 0 && l_ == 0) ? FPTR(tab[1]) : nullptr; const bool lastx = (st == 2 && l_ == 1);
              LAS float* red = (LAS float*)lds;
              for (int mb = bid; mb < 256; mb += G) { const int m = mb * 2 + (wave >> 2), cq = wave & 3, col = cq * 256 + lane * 4;
                  f32x4 v; if (bs) v = *(const f32x4*)(bs + (size_t)m * 1024 + col); else { const u32x2 r = *(const u32x2*)(XB + (size_t)(NPROMPT + m) * 1024 + col); v = (f32x4){__uint_as_float(r.x << 16), __uint_as_float(r.x & 0xffff0000u), __uint_as_float(r.y << 16), __uint_as_float(r.y & 0xffff0000u)}; }
                  f32x4 pp[16];
#pragma unroll
                  for (int ks = 0; ks < 16; ++ks) { const int kc = ks < nS ? ks : 0; pp[ks] = *(const f32x4*)(PART + ((size_t)kc * 512 + m) * 1024 + col); }
#pragma unroll
                  for (int ks = 0; ks < 16; ++ks) { const float on = ks < nS ? 1.f : 0.f; v += pp[ks] * on; }
                  if (lastx) *(f32x4*)(X + (size_t)(NPROMPT + m) * 1024 + col) = v;
                  u32x2 w; w.x = pk2(v[0], v[1]); w.y = pk2(v[2], v[3]); *(u32x2*)(XB + (size_t)(NPROMPT + m) * 1024 + col) = w;
                  float s = wave_sum((v[0] * v[0] + v[1] * v[1]) + (v[2] * v[2] + v[3] * v[3]));
                  if (lane == 0) red[wave] = s;
                  __syncthreads();
                  if (cq == 0 && lane == 0) ((float*)(w_ + WS_RSTD))[NPROMPT + m] = rsqrtf(((red[wave] + red[wave + 1]) + (red[wave + 2] + red[wave + 3])) * (1.0f / 1024.0f) + 1e-6f);
                  __syncthreads(); }
              if (tid < 64) for (int r = bid * 64 + tid; r < NPROMPT; r += G * 64) ((float*)(w_ + WS_RSTD))[r] = row_rstd(SSQ, r); }
            GRID_BAR();
            if (st < 2) {
                WAVE_IDS; unsigned char* w_ = ws; int l_ = l; OPQP(unsigned char, w_); OPQ(l_); unsigned char* wl = w_ + WS_W0 + (size_t)l_ * WS_WL;
                Gemm g; EpiBf16S E;
                if (st == 0) { g = Gemm{(const bf16_t*)(w_ + WS_XB), (const bf16_t*)(wl + W_MQ), M_ALL, 512, 1024}; E = EpiBf16S{(bf16_t*)(w_ + WS_QM), 512, (const float*)(w_ + WS_RSTD), 0.08838834764831845f, 0}; }
                else { g = Gemm{(const bf16_t*)(w_ + WS_XB), (const bf16_t*)(wl + W_1), M_ALL, 4096, 1024}; E = EpiBf16S{(bf16_t*)(w_ + WS_H), 4096, (const float*)(w_ + WS_RSTD), 1.0f, 1}; }
                StaticOrder S; S.init(M_ALL, g.N, G, bid);
                gemm_phase<EpiBf16S, StaticOrder, true, true>(lds, g, S, E);
                if (st == 0 && l_ == 0 && bid >= 132 && G == 256) {
                    const unsigned long long* tabc = (const unsigned long long*)w_; LAS float* scr = (LAS float*)(lds + wave * 16384);
#define TABP(i) FPTR(tabc[i])
                    for (int j = (bid - 132) * 8 + wave; j < 6912; j += 124 * 8) CONV_ITEM(TABP, 1, j < 2560 ? j : j + 512, w_);
#undef TABP
                }
                GRID_BAR();
            }
            if (st == 0) {
                WAVE_IDS; unsigned char* w_ = ws; float* o_ = out; int l_ = l; OPQP(unsigned char, w_); OPQP(float, o_); OPQ(l_);
                const unsigned long long* tab = (const unsigned long long*)w_; const float* cache_mk = GPTR(tab[6]); const float* cache_mv = GPTR(tab[7]);
                const bf16_t* QM = (const bf16_t*)(w_ + WS_QM); bf16_t* OM = (bf16_t*)(w_ + WS_OM);
                for (int it = bid; it < 1152; it += G) {
                    int row0, tvalid, hm; const float* Kg; const float* Vg; const bf16_t* Kb = nullptr; const bf16_t* Vtb = nullptr;
                    if (it < 1024) { const int tt = it >> 2; hm = it & 3; row0 = tt * 64; tvalid = 64; const int b = tt >> 7;
                        Kb = (const bf16_t*)(w_ + WS_MKB) + (size_t)((l_ * 2 + b) * 4 + hm) * 32768; Vtb = (const bf16_t*)(w_ + WS_MVT) + (size_t)((l_ * 2 + b) * 4 + hm) * 32768;
                        Kg = o_ + O_MKP + (size_t)(l_ * 2 + b) * 131072 + hm * 128; Vg = o_ + O_MVP + (size_t)(l_ * 2 + b) * 131072 + hm * 128; }
                    else { const int si = it - 1024, s = si >> 2; hm = si & 3; row0 = NPROMPT + 16 * s; tvalid = 16;
                        Kg = cache_mk + (size_t)(l_ * 32 + s) * 131072 + hm * 128; Vg = cache_mv + (size_t)(l_ * 32 + s) * 131072 + hm * 128; }
                    int t2 = tid; asm volatile("" : "+v"(t2));
                    xattn_item(lds, QM, Kg, Vg, Kb, Vtb, row0, tvalid, hm, OM, t2, t2 & 63, wave);
                }
                GRID_BAR();
            }
        }
    }
    { WAVE_IDS; unsigned char* w_ = ws; float* o_ = out; OPQP(unsigned char, w_); OPQP(float, o_);
      const float* nf = GPTR(((const unsigned long long*)w_)[23]); const float* X = (const float*)(w_ + WS_X);
      for (int m0 = gw; m0 < M_ALL; m0 += 2 * NGW) { const int m1 = (m0 + NGW < M_ALL) ? m0 + NGW : m0;
          const f32x4* xa = (const f32x4*)(X + (size_t)m0 * 1024) + lane; const f32x4* xb = (const f32x4*)(X + (size_t)m1 * 1024) + lane; f32x4 va[4], vb[4]; float sa = 0.f, sb = 0.f;
#pragma unroll
          for (int j = 0; j < 4; ++j) { va[j] = xa[64 * j]; vb[j] = xb[64 * j]; }
#pragma unroll
          for (int j = 0; j < 4; ++j) { sa += (va[j][0] * va[j][0] + va[j][1] * va[j][1]) + (va[j][2] * va[j][2] + va[j][3] * va[j][3]); sb += (vb[j][0] * vb[j][0] + vb[j][1] * vb[j][1]) + (vb[j][2] * vb[j][2] + vb[j][3] * vb[j][3]); }
          sa = wave_sum(sa); sb = wave_sum(sb); const float ra = rsqrtf(sa * (1.0f / 1024.0f) + 1e-6f), rb = rsqrtf(sb * (1.0f / 1024.0f) + 1e-6f);
          f32x4* ya = (f32x4*)(o_ + (m0 < NPROMPT ? O_YP + (size_t)m0 * 1024 : O_YS + (size_t)(m0 - NPROMPT) * 1024)) + lane;
          f32x4* yb = (f32x4*)(o_ + (m1 < NPROMPT ? O_YP + (size_t)m1 * 1024 : O_YS + (size_t)(m1 - NPROMPT) * 1024)) + lane;
#pragma unroll
          for (int j = 0; j < 4; ++j) { const f32x4 g = *((const f32x4*)nf + lane + 64 * j); ya[64 * j] = va[j] * ra * g; if (m1 != m0) yb[64 * j] = vb[j] * rb * g; } } }
}

extern "C" void kernel_launch(void* const* d_in, const int* in_sizes, int n_in, void* d_out, int out_size, void* d_ws, size_t ws_size, hipStream_t stream) {
    static int grid = 0;
    if (grid == 0) {
        int dev = 0, cus = 0, per_cu = 0;
        (void)hipGetDevice(&dev); (void)hipDeviceGetAttribute(&cus, hipDeviceAttributeMultiprocessorCount, dev);
        if (hipFuncSetAttribute((const void*)mega_fwd, hipFuncAttributeMaxDynamicSharedMemorySize, LDS_BYTES) != hipSuccess) fprintf(stderr, "kernel_launch: hipFuncSetAttribute failed\n");
        if (hipOccupancyMaxActiveBlocksPerMultiprocessor(&per_cu, (const void*)mega_fwd, 512, LDS_BYTES) != hipSuccess || per_cu < 1) { fprintf(stderr, "kernel_launch: occupancy query says %d\n", per_cu); per_cu = 1; }
        (void)hipGetLastError();
        if (cus <= 0) cus = 256;
        grid = cus;
    }
    Args a{};
    for (int i = 0; i < 24; ++i) a.in[i] = (const float*)d_in[i];
    a.out = (float*)d_out; a.ws = (unsigned char*)d_ws;
    void* kargs[] = {&a};
    const hipError_t e = hipLaunchCooperativeKernel((const void*)mega_fwd, dim3(grid), dim3(512), kargs, LDS_BYTES, stream);
    if (e != hipSuccess) fprintf(stderr, "kernel_launch: cooperative launch failed: %s (grid %d)\n", hipGetErrorString(e), grid);
}
```

```cpp
#include <hip/hip_runtime.h>
#include <hip/hip_cooperative_groups.h>
#include <cstdio>
#include <cstdint>
namespace cg = cooperative_groups;
namespace pg8 {
#define PG8_LAS __attribute__((address_space(3)))
typedef unsigned short bf16_t;
typedef short bf16x8 __attribute__((ext_vector_type(8)));
typedef float f32x4 __attribute__((ext_vector_type(4)));
typedef unsigned u32x4 __attribute__((ext_vector_type(4)));
constexpr int BM = 256, BK = 64, HALF = 128, HTB = HALF * BK * 2  , STAGE_BYTES = 8 * HTB, NXCD = 8, WGM = 8;

__host__ __device__ __forceinline__ int lds_byte(int r, int c) { const int st = (r >> 4) * 2 + (c >> 5), rr = r & 15, cc = c & 31, ob = rr * 64 + cc * 2; return st * 1024 + (ob ^ (((ob >> 9) & 1) << 5)); }
__host__ __device__ __forceinline__ void stage_rc(int b, int& R, int& C) { const int st = b / 1024, sb = b % 1024, swz = sb ^ (((sb >> 9) & 1) << 5); R = (st >> 1) * 16 + swz / 64; C = (st & 1) * 32 + (swz % 64) / 2; }
__host__ __device__ __forceinline__ int perm32(int rho) { const int n = rho >> 4, i = rho & 15; return 8 * (i >> 2) + 4 * n + (i & 3); }

struct Unit { int pm, pn, ks; };
struct Gemm { const bf16_t* A; const bf16_t* Bt; int M, N, K, ld; };

struct StaticOrder {
    int nM, nN, nwg, G, c;
    __host__ __device__ void init(int M, int N, int G_, int c_) { nM = M / BM; nN = N / BM; nwg = nM * nN; G = G_; c = c_; }
    __host__ __device__ bool next(int i, Unit& u) const {
        const long L = (long)i * G + c; if (L >= nwg) return false;
        int wgid = (int)L; { const int q = nwg / NXCD, r = nwg % NXCD, xcd = wgid % NXCD, off = wgid / NXCD; wgid = (xcd < r ? xcd * (q + 1) : r * (q + 1) + (xcd - r) * q) + off; }
        const int nig = WGM * nN, gid = wgid / nig, fm = gid * WGM, gsz = (nM - fm) < WGM ? (nM - fm) : WGM;
        u.pm = fm + ((wgid % nig) % gsz); u.pn = (wgid % nig) / gsz; u.ks = 0; return true;
    }
    __device__ __forceinline__ void a_ready(const Unit&) const {}
    __device__ __forceinline__ void done(const Unit&) const {}
};
struct SplitOrder {
    int nN, nS, nwg, G, c, pm0;
    __host__ __device__ void init(int nMs, int N, int nS_, int G_, int c_, int pm0_) { nN = N / BM; nS = nS_; nwg = nMs * nN * nS; G = G_; c = c_; pm0 = pm0_; }
    __host__ __device__ bool next(int i, Unit& u) const { const long L = (long)i * G + c; if (L >= nwg) return false; const int t = (int)L / nS; u.ks = (int)L % nS; u.pn = t % nN; u.pm = pm0 + t / nN; return true; }
    __device__ __forceinline__ void a_ready(const Unit&) const {}
    __device__ __forceinline__ void done(const Unit&) const {}
};
__device__ __forceinline__ unsigned cvt_pk_bf16(float lo, float hi) { unsigned r; asm volatile("v_cvt_pk_bf16_f32 %0, %1, %2" : "=v"(r) : "v"(lo), "v"(hi)); return r; }
typedef float f32x2 __attribute__((ext_vector_type(2)));
typedef unsigned u32x2 __attribute__((ext_vector_type(2)));
constexpr int NPROMPT = 16384;
constexpr size_t O_YP = 0, O_YS = 16777216, O_KP = 17301504, O_VP = 34078720, O_HP = 50855936, O_MKP = 51118080, O_MVP = 51642368,
                 O_KS = 52166656, O_VS = 52690944, O_HS = 53215232;
__device__ __forceinline__ float row_rstd(const float* ssq, int row) {
    const f32x4* p = (const f32x4*)(ssq + (size_t)row * 16);
    const f32x4 a = p[0], b = p[1], c = p[2], d = p[3];
    const float s = (((a[0] + a[1]) + (a[2] + a[3])) + ((b[0] + b[1]) + (b[2] + b[3]))) + (((c[0] + c[1]) + (c[2] + c[3])) + ((d[0] + d[1]) + (d[2] + d[3])));
    return rsqrtf(s * (1.0f / 1024.0f) + 1e-6f);
}
struct EpiF32 {
    static constexpr bool PERM = true, AFTER_DRAIN = false;
    int mode; const float* rstd; float* proj; float* outp; int l; bf16_t* vt; bf16_t* kb;
    __device__ __forceinline__ void operator()(const f32x4 (&acc)[2][2][4][2], const Unit& u, int wr, int wc, int fr_, int fq_) const {
        int tq = threadIdx.x; asm volatile("" : "+v"(tq)); const int fr = tq & 15, fq = (tq >> 4) & 3;
        float* base; int pitch, colt, rsub = 0; const int pn = u.pn;
        if (mode == 0) {
            if (pn >= 2 && pn < 6) { const size_t isv = pn >= 4 ? 1 : 0; colt = (pn & 1) * 256; pitch = 512;
                if (u.pm < 64) base = outp + (O_KP + isv * (O_VP - O_KP) + (size_t)l * NPROMPT * 512);
                else { base = outp + (O_KS + isv * (O_VS - O_KS) + (size_t)l * 262144); rsub = NPROMPT; } }
            else { base = proj; pitch = 3584; colt = pn * 256; }
        } else { const size_t sel = (size_t)(pn >> 1); base = outp + (O_MKP + (sel & 1) * (O_MVP - O_MKP) + (sel >> 1) * 262144); pitch = 512; colt = (pn & 1) * 256; }
        const int col0 = colt + wc * 32 + 8 * fq, rowb = u.pm * BM + wr * 64 + fr;
        float rs[2][4];
#pragma unroll
        for (int ai = 0; ai < 2; ++ai)
#pragma unroll
            for (int m = 0; m < 4; ++m) rs[ai][m] = rstd[rowb + ai * HALF + m * 16];
#pragma unroll
        for (int ai = 0; ai < 2; ++ai)
#pragma unroll
            for (int m = 0; m < 4; ++m) { const int row = rowb + ai * HALF + m * 16;
                if (base == proj && mode == 0) {
                    const float sc = rs[ai][m] * (pn < 2 ? 0.125f : 1.0f); bf16_t* bp_ = (bf16_t*)proj + (size_t)row * 3584 + col0;
#pragma unroll
                    for (int bj = 0; bj < 2; ++bj) { const f32x4 v0 = acc[ai][bj][m][0] * sc, v1 = acc[ai][bj][m][1] * sc;
                        u32x4 w; w.x = cvt_pk_bf16(v0[0], v0[1]); w.y = cvt_pk_bf16(v0[2], v0[3]); w.z = cvt_pk_bf16(v1[0], v1[1]); w.w = cvt_pk_bf16(v1[2], v1[3]); *(u32x4*)(bp_ + bj * HALF) = w; }
                } else {
                float* rp = base + (size_t)(row - rsub) * pitch + col0;
#pragma unroll
                for (int bj = 0; bj < 2; ++bj)
#pragma unroll
                    for (int n = 0; n < 2; ++n) *(f32x4*)(rp + bj * HALF + n * 4) = acc[ai][bj][m][n] * rs[ai][m]; } }
        if (mode == 1) {
            const int sel = pn >> 1, lyr = sel >> 1, isv = sel & 1, bb = u.pm;
#pragma unroll
            for (int ai = 0; ai < 2; ++ai)
#pragma unroll
                for (int m = 0; m < 4; ++m) { const int row = rowb + ai * HALF + m * 16, mm = row & 255;
#pragma unroll
                    for (int bj = 0; bj < 2; ++bj) { const f32x4 v0 = acc[ai][bj][m][0] * rs[ai][m], v1 = acc[ai][bj][m][1] * rs[ai][m]; const int c = col0 + bj * HALF, hh = c >> 7, d0 = c & 127;
                        const unsigned p0 = cvt_pk_bf16(v0[0], v0[1]), p1 = cvt_pk_bf16(v0[2], v0[3]), p2 = cvt_pk_bf16(v1[0], v1[1]), p3 = cvt_pk_bf16(v1[2], v1[3]);
                        const size_t hb = (size_t)((lyr * 2 + bb) * 4 + hh) * 32768;
                        if (!isv) { u32x4 w; w.x = p0; w.y = p1; w.z = p2; w.w = p3; *(u32x4*)(kb + hb + (size_t)mm * 128 + d0) = w; }
                        else { bf16_t* q = vt + hb + (size_t)d0 * 256 + mm;
                            q[0] = (bf16_t)(p0 & 0xffffu); q[256] = (bf16_t)(p0 >> 16); q[512] = (bf16_t)(p1 & 0xffffu); q[768] = (bf16_t)(p1 >> 16);
                            q[1024] = (bf16_t)(p2 & 0xffffu); q[1280] = (bf16_t)(p2 >> 16); q[1536] = (bf16_t)(p3 & 0xffffu); q[1792] = (bf16_t)(p3 >> 16); } } }
        }
        if (mode == 0 && pn >= 2 && pn < 4 && u.pm < 64) {
#pragma unroll
            for (int ai = 0; ai < 2; ++ai)
#pragma unroll
                for (int m = 0; m < 4; ++m) { const int row = rowb + ai * HALF + m * 16, t = row & 8191;
#pragma unroll
                    for (int bj = 0; bj < 2; ++bj) { const f32x4 v0 = acc[ai][bj][m][0] * rs[ai][m], v1 = acc[ai][bj][m][1] * rs[ai][m]; const int c = col0 + bj * HALF, hh = c >> 6, d0 = c & 63;
                        u32x4 w; w.x = cvt_pk_bf16(v0[0], v0[1]); w.y = cvt_pk_bf16(v0[2], v0[3]); w.z = cvt_pk_bf16(v1[0], v1[1]); w.w = cvt_pk_bf16(v1[2], v1[3]);
                        *(u32x4*)(kb + ((((size_t)((row >> 13) * 8 + hh) * 256 + (t >> 5)) * 8 + (d0 >> 3)) * 32 + (t & 31)) * 8) = w; } }
        }
        if (mode == 0 && pn >= 4 && pn < 6 && u.pm < 64) {
            const int qi = fr & 3;
#pragma unroll
            for (int ai = 0; ai < 2; ++ai)
#pragma unroll
                for (int m = 0; m < 4; ++m) { const int row = rowb + ai * HALF + m * 16, t0 = (row & 8191) & ~3; const size_t tb = ((size_t)(row >> 13) * 8 * 2048 * 64 + (size_t)(t0 >> 2) * 64) * 4;
#pragma unroll
                    for (int bj = 0; bj < 2; ++bj)
#pragma unroll
                        for (int n = 0; n < 2; ++n) { const f32x4 v = acc[ai][bj][m][n] * rs[ai][m]; const int c = col0 + bj * HALF + n * 4;
                            const unsigned p01 = cvt_pk_bf16(v[0], v[1]), p23 = cvt_pk_bf16(v[2], v[3]);
                            const unsigned snd1 = (qi & 2) ? p01 : p23, kep1 = (qi & 2) ? p23 : p01, rcv1 = (unsigned)__shfl_xor((int)snd1, 2);
                            const unsigned q0 = (qi & 2) ? rcv1 : kep1, q2 = (qi & 2) ? kep1 : rcv1;
                            const unsigned los = (q0 & 0xffffu) | (q2 << 16), his = (q0 >> 16) | (q2 & 0xffff0000u);
                            const unsigned rcv2 = (unsigned)__shfl_xor((int)((qi & 1) ? los : his), 1), mine = (qi & 1) ? his : los;
                            u32x2 w;
                            if (qi & 1) { w.x = (rcv2 & 0xffffu) | (mine << 16); w.y = (rcv2 >> 16) | (mine & 0xffff0000u); }
                            else { w.x = (mine & 0xffffu) | (rcv2 << 16); w.y = (mine >> 16) | (rcv2 & 0xffff0000u); }
                            const int cc = c + (qi & 2) + (qi & 1), hh = cc >> 6, dd = cc & 63;
                            *(u32x2*)(vt + tb + ((size_t)hh * 2048 * 64 + dd) * 4) = w; } }
        }
    }
};
struct EpiResid {
    static constexpr bool PERM = true, AFTER_DRAIN = false;
    const float* bp; const float* bs; float* X; bf16_t* XB; float* ssq;
    __device__ __forceinline__ void operator()(const f32x4 (&acc)[2][2][4][2], const Unit& u, int wr, int wc, int fr_, int fq_) const {
        int tq = threadIdx.x; asm volatile("" : "+v"(tq)); const int fr = tq & 15, fq = (tq >> 4) & 3;
        const int col0 = u.pn * BM + wc * 32 + 8 * fq;
#pragma unroll
        for (int ai = 0; ai < 2; ++ai) {
            f32x4 res[4][2][2];
            if (bp) {
#pragma unroll
                for (int m = 0; m < 4; ++m) { const int row = u.pm * BM + ai * HALF + wr * 64 + m * 16 + fr; const float* br = bp + (size_t)row * 1024 + col0;
#pragma unroll
                    for (int bj = 0; bj < 2; ++bj) { res[m][bj][0] = *(const f32x4*)(br + bj * HALF); res[m][bj][1] = *(const f32x4*)(br + bj * HALF + 4); } }
            } else { u32x4 rb[4][2];
#pragma unroll
                for (int m = 0; m < 4; ++m) { const int row = u.pm * BM + ai * HALF + wr * 64 + m * 16 + fr; const bf16_t* br = XB + (size_t)row * 1024 + col0;
#pragma unroll
                    for (int bj = 0; bj < 2; ++bj) rb[m][bj] = *(const u32x4*)(br + bj * HALF); }
#pragma unroll
                for (int m = 0; m < 4; ++m)
#pragma unroll
                    for (int bj = 0; bj < 2; ++bj) { const u32x4 r = rb[m][bj];
                        res[m][bj][0] = (f32x4){__uint_as_float(r.x << 16), __uint_as_float(r.x & 0xffff0000u), __uint_as_float(r.y << 16), __uint_as_float(r.y & 0xffff0000u)};
                        res[m][bj][1] = (f32x4){__uint_as_float(r.z << 16), __uint_as_float(r.z & 0xffff0000u), __uint_as_float(r.w << 16), __uint_as_float(r.w & 0xffff0000u)}; } }
            asm volatile("" ::: "memory");
#pragma unroll
            for (int m = 0; m < 4; ++m) { const int row = u.pm * BM + ai * HALF + wr * 64 + m * 16 + fr;
                bf16_t* xb = XB + (size_t)row * 1024 + col0; float ss = 0.f;
#pragma unroll
                for (int bj = 0; bj < 2; ++bj) { const f32x4 v0 = acc[ai][bj][m][0] + res[m][bj][0], v1 = acc[ai][bj][m][1] + res[m][bj][1];
                    if (X) { float* xr = X + (size_t)row * 1024 + col0; *(f32x4*)(xr + bj * HALF) = v0; *(f32x4*)(xr + bj * HALF + 4) = v1; }
                    ss += ((v0[0] * v0[0] + v0[1] * v0[1]) + (v0[2] * v0[2] + v0[3] * v0[3])) + ((v1[0] * v1[0] + v1[1] * v1[1]) + (v1[2] * v1[2] + v1[3] * v1[3]));
                    u32x4 w; w.x = cvt_pk_bf16(v0[0], v0[1]); w.y = cvt_pk_bf16(v0[2], v0[3]); w.z = cvt_pk_bf16(v1[0], v1[1]); w.w = cvt_pk_bf16(v1[2], v1[3]); *(u32x4*)(xb + bj * HALF) = w; }
                ss += __shfl_xor(ss, 16); ss += __shfl_xor(ss, 32);
                if (fq == 0) ssq[(size_t)row * 16 + u.pn * 4 + wc] = ss; }
            asm volatile("" ::: "memory"); }
    }
};
struct EpiBf16S {
    static constexpr bool PERM = true, AFTER_DRAIN = false;
    bf16_t* O; int ldc; const float* rstd; float scale; int act;
    __device__ __forceinline__ void operator()(const f32x4 (&acc)[2][2][4][2], const Unit& u, int wr, int wc, int fr_, int fq_) const {
        int tq = threadIdx.x; asm volatile("" : "+v"(tq)); const int fr = tq & 15, fq = (tq >> 4) & 3;
        const int col0 = u.pn * BM + wc * 32 + 8 * fq, rowb = u.pm * BM + wr * 64 + fr;
        float rs[2][4];
#pragma unroll
        for (int ai = 0; ai < 2; ++ai)
#pragma unroll
            for (int m = 0; m < 4; ++m) rs[ai][m] = rstd[rowb + ai * HALF + m * 16];
#pragma unroll
        for (int ai = 0; ai < 2; ++ai)
#pragma unroll
            for (int m = 0; m < 4; ++m) { const int row = rowb + ai * HALF + m * 16; const float r1 = rs[ai][m];
                bf16_t* rowp = O + (size_t)row * ldc + col0;
#pragma unroll
                for (int bj = 0; bj < 2; ++bj) { f32x4 v0 = acc[ai][bj][m][0] * r1, v1 = acc[ai][bj][m][1] * r1;
                    if (act == 1) { v0 = __builtin_elementwise_max(v0, (f32x4){0.f, 0.f, 0.f, 0.f}); v1 = __builtin_elementwise_max(v1, (f32x4){0.f, 0.f, 0.f, 0.f}); v0 = v0 * v0; v1 = v1 * v1; }
                    v0 = v0 * scale; v1 = v1 * scale;
                    u32x4 w; w.x = cvt_pk_bf16(v0[0], v0[1]); w.y = cvt_pk_bf16(v0[2], v0[3]); w.z = cvt_pk_bf16(v1[0], v1[1]); w.w = cvt_pk_bf16(v1[2], v1[3]);
                    *(u32x4*)(rowp + bj * HALF) = w; } }
    }
};
struct EpiPart {
    static constexpr bool PERM = true, AFTER_DRAIN = false;
    float* part;
    __device__ __forceinline__ void operator()(const f32x4 (&acc)[2][2][4][2], const Unit& u, int wr, int wc, int fr_, int fq_) const {
        int tq = threadIdx.x; asm volatile("" : "+v"(tq)); const int fr = tq & 15, fq = (tq >> 4) & 3;
        const int col0 = u.pn * BM + wc * 32 + 8 * fq;
#pragma unroll
        for (int ai = 0; ai < 2; ++ai)
#pragma unroll
            for (int m = 0; m < 4; ++m) { const int row = (u.pm - 64) * BM + ai * HALF + wr * 64 + m * 16 + fr;
                float* rp = part + ((size_t)u.ks * 512 + row) * 1024 + col0;
#pragma unroll
                for (int bj = 0; bj < 2; ++bj)
#pragma unroll
                    for (int n = 0; n < 2; ++n) *(f32x4*)(rp + bj * HALF + n * 4) = acc[ai][bj][m][n];
                asm volatile("" ::: "memory"); }
    }
};
template <class Epi, class Sched, bool ALIGN_EPI = false, bool SP2 = false>
__device__ __forceinline__ void gemm_phase(PG8_LAS unsigned char* lds, const Gemm g, const Sched& S, const Epi& E) {
    int tid_ = threadIdx.x; asm volatile("" : "+v"(tid_));
    const int tid = tid_, wid = __builtin_amdgcn_readfirstlane(tid >> 6), lane = tid & 63, wr = wid >> 2, wc = wid & 3, fr = lane & 15, fq = lane >> 4;
    const int K = g.ld ? g.ld : g.K, nt = g.K / BK;
    unsigned voffA[2], voffB[2];
#pragma unroll
    for (int i = 0; i < 2; ++i) { int R, C; stage_rc(tid * 16 + i * 8192, R, C); const int Rb = Epi::PERM ? ((R & ~31) + perm32(R & 31)) : R;
        voffA[i] = (unsigned)(R * K + C) * 2u; voffB[i] = (unsigned)(Rb * K + C) * 2u; }
    const size_t kstep = (size_t)(BK * 2);
    const size_t hstep = (size_t)HALF * K * 2;
    const size_t tstep = 2 * hstep;
    const unsigned ldsw = (unsigned)wid * 1024u;
    const int aoff = lds_byte(wr * 64 + fr, fq * 8), boff = lds_byte(wc * 32 + fr, fq * 8);
#define PG8_SA(b, h) (((b) * 2 + (h)) * HTB)
#define PG8_SB(b, h) ((4 + (b) * 2 + (h)) * HTB)
#define PG8_STAGE(bufoff, gbase, voff) do { _Pragma("unroll") for (int _i = 0; _i < 2; ++_i) \
        __builtin_amdgcn_global_load_lds((const unsigned*)((const char*)(gbase) + (voff)[_i]), (PG8_LAS unsigned*)(lds + (bufoff) + ldsw + _i * 8192), 16, 0, 0); } while (0)
#define PG8_LDA(dst, b, h) do { _Pragma("unroll") for (int m = 0; m < 4; ++m) _Pragma("unroll") for (int k = 0; k < 2; ++k) dst[m][k] = *(const PG8_LAS bf16x8*)(lds + PG8_SA(b, h) + aoff + m * 2048 + k * 1024); } while (0)
#define PG8_LDB(dst, b, h) do { _Pragma("unroll") for (int n = 0; n < 2; ++n) _Pragma("unroll") for (int k = 0; k < 2; ++k) dst[n][k] = *(const PG8_LAS bf16x8*)(lds + PG8_SB(b, h) + boff + n * 2048 + k * 1024); } while (0)
#define PG8_MMA(ai, bj, At, Bt) do { __builtin_amdgcn_s_setprio(1); _Pragma("unroll") for (int m = 0; m < 4; ++m) _Pragma("unroll") for (int n = 0; n < 2; ++n) _Pragma("unroll") for (int k = 0; k < 2; ++k) \
        acc[ai][bj][m][n] = __builtin_amdgcn_mfma_f32_16x16x32_bf16(Bt[n][k], At[m][k], acc[ai][bj][m][n], 0, 0, 0); __builtin_amdgcn_s_setprio(0); } while (0)
#define PG8_WAIT_V(n) asm volatile("s_waitcnt vmcnt(" #n ")" ::: "memory")
#define PG8_WAIT_L(n) asm volatile("s_waitcnt lgkmcnt(" #n ")" ::: "memory")
#define PG8_BAR __builtin_amdgcn_s_barrier()
#define PG8_SCHED __builtin_amdgcn_sched_barrier(0)
    Unit cur, nxt; int ui = 0;
    if (!S.next(0, cur)) return;
    f32x4 acc[2][2][4][2];
#pragma unroll
    for (int a = 0; a < 2; ++a)
#pragma unroll
        for (int b = 0; b < 2; ++b)
#pragma unroll
            for (int m = 0; m < 4; ++m)
#pragma unroll
                for (int n = 0; n < 2; ++n) acc[a][b][m][n] = (f32x4){0.f, 0.f, 0.f, 0.f};
    bf16x8 At[4][2], B0[2][2], B1[2][2];
    const size_t sstep = (size_t)g.K * 2;
    const char* cA = (const char*)g.A + (size_t)cur.pm * tstep + (size_t)cur.ks * sstep; const char* cB = (const char*)g.Bt + (size_t)cur.pn * tstep + (size_t)cur.ks * sstep;
    S.a_ready(cur);
    if constexpr (SP2) {
        PG8_STAGE(PG8_SB(0, 0), cB, voffB); PG8_STAGE(PG8_SB(0, 1), cB + hstep, voffB); PG8_STAGE(PG8_SA(0, 0), cA, voffA); PG8_STAGE(PG8_SA(0, 1), cA + hstep, voffA);
        if (wr == 1) PG8_BAR;
        PG8_WAIT_V(2); PG8_BAR;
        PG8_STAGE(PG8_SB(1, 0), cB + kstep, voffB); PG8_STAGE(PG8_SA(1, 0), cA + kstep, voffA); PG8_STAGE(PG8_SB(1, 1), cB + hstep + kstep, voffB);
        PG8_WAIT_V(6); PG8_BAR;
    } else {
        PG8_STAGE(PG8_SB(0, 0), cB, voffB); PG8_STAGE(PG8_SA(0, 0), cA, voffA); PG8_STAGE(PG8_SB(0, 1), cB + hstep, voffB); PG8_STAGE(PG8_SA(0, 1), cA + hstep, voffA);
        if (wr == 1) PG8_BAR;
        PG8_WAIT_V(4); PG8_BAR;
        PG8_STAGE(PG8_SB(1, 0), cB + kstep, voffB); PG8_STAGE(PG8_SA(1, 0), cA + kstep, voffA); PG8_STAGE(PG8_SB(1, 1), cB + hstep + kstep, voffB);
        PG8_WAIT_V(6); PG8_BAR;
    }
    for (;;) {
        const bool has_next = S.next(ui + 1, nxt);
        const char* nA = has_next ? (const char*)g.A + (size_t)nxt.pm * tstep + (size_t)nxt.ks * sstep : cA; const char* nB = has_next ? (const char*)g.Bt + (size_t)nxt.pn * tstep + (size_t)nxt.ks * sstep : cB;
        for (int t = 0; t < nt; t += 2) {
            const bool last = (t == nt - 2);
            const char* a1 = cA + (size_t)(t + 1) * kstep;
            const char* a2 = last ? nA : cA + (size_t)(t + 2) * kstep; const char* b2 = last ? nB : cB + (size_t)(t + 2) * kstep;
            const char* a3 = a2 + kstep; const char* b3 = b2 + kstep;
            if (last && has_next) S.a_ready(nxt);
            if constexpr (SP2) {
            PG8_LDB(B0, 0, 0); PG8_LDB(B1, 0, 1); PG8_SCHED; PG8_LDA(At, 0, 0); PG8_STAGE(PG8_SA(1, 1), a1 + hstep, voffA);
            PG8_WAIT_V(8); PG8_WAIT_L(0); PG8_BAR; PG8_MMA(0, 0, At, B0); PG8_MMA(0, 1, At, B1); PG8_BAR; PG8_SCHED;
            PG8_LDA(At, 0, 1); PG8_STAGE(PG8_SB(0, 0), b2, voffB); PG8_STAGE(PG8_SB(0, 1), b2 + hstep, voffB); PG8_STAGE(PG8_SA(0, 0), a2, voffA);
            PG8_WAIT_V(8); PG8_WAIT_L(0); PG8_BAR; PG8_MMA(1, 0, At, B0); PG8_MMA(1, 1, At, B1); PG8_BAR; PG8_SCHED;
            PG8_LDB(B0, 1, 0); PG8_LDB(B1, 1, 1); PG8_SCHED; PG8_LDA(At, 1, 0); PG8_STAGE(PG8_SA(0, 1), a2 + hstep, voffA);
            PG8_WAIT_V(8); PG8_WAIT_L(0); PG8_BAR; PG8_MMA(0, 0, At, B0); PG8_MMA(0, 1, At, B1); PG8_BAR; PG8_SCHED;
            PG8_LDA(At, 1, 1); PG8_STAGE(PG8_SB(1, 0), b3, voffB); PG8_STAGE(PG8_SB(1, 1), b3 + hstep, voffB); PG8_STAGE(PG8_SA(1, 0), a3, voffA);
            PG8_WAIT_V(8); PG8_WAIT_L(0); PG8_BAR; PG8_MMA(1, 0, At, B0); PG8_MMA(1, 1, At, B1); PG8_BAR; PG8_SCHED;
            } else {
            PG8_LDB(B0, 0, 0); PG8_SCHED; PG8_LDA(At, 0, 0); PG8_STAGE(PG8_SA(1, 1), a1 + hstep, voffA);
            PG8_WAIT_L(8); PG8_BAR; PG8_WAIT_L(0); PG8_MMA(0, 0, At, B0); PG8_BAR; PG8_SCHED;
            PG8_LDB(B1, 0, 1); PG8_STAGE(PG8_SB(0, 0), b2, voffB);
            PG8_BAR; PG8_WAIT_L(0); PG8_MMA(0, 1, At, B1); PG8_BAR;
            PG8_LDA(At, 0, 1); PG8_STAGE(PG8_SA(0, 0), a2, voffA);
            PG8_BAR; PG8_WAIT_L(0); PG8_MMA(1, 0, At, B0); PG8_BAR; PG8_SCHED;
            PG8_STAGE(PG8_SB(0, 1), b2 + hstep, voffB);
            PG8_WAIT_V(6); PG8_BAR; PG8_MMA(1, 1, At, B1); PG8_BAR;
            PG8_LDB(B0, 1, 0); PG8_SCHED; PG8_LDA(At, 1, 0); PG8_STAGE(PG8_SA(0, 1), a2 + hstep, voffA);
            PG8_WAIT_L(8); PG8_BAR; PG8_WAIT_L(0); PG8_MMA(0, 0, At, B0); PG8_BAR; PG8_SCHED;
            PG8_LDB(B1, 1, 1); PG8_STAGE(PG8_SB(1, 0), b3, voffB);
            PG8_BAR; PG8_WAIT_L(0); PG8_MMA(0, 1, At, B1); PG8_BAR;
            PG8_LDA(At, 1, 1); PG8_STAGE(PG8_SA(1, 0), a3, voffA);
            PG8_BAR; PG8_WAIT_L(0); PG8_MMA(1, 0, At, B0); PG8_BAR; PG8_SCHED;
            PG8_STAGE(PG8_SB(1, 1), b3 + hstep, voffB);
            PG8_WAIT_V(6); PG8_BAR; PG8_MMA(1, 1, At, B1); PG8_BAR;
            }
        }
        if constexpr (ALIGN_EPI) { if (wr == 0) PG8_BAR; }
        if constexpr (!Epi::AFTER_DRAIN) { E(acc, cur, wr, wc, fr, fq); S.done(cur); }
        if (!has_next) break;
#pragma unroll
        for (int a = 0; a < 2; ++a)
#pragma unroll
            for (int b = 0; b < 2; ++b)
#pragma unroll
                for (int m = 0; m < 4; ++m)
#pragma unroll
                    for (int n = 0; n < 2; ++n) acc[a][b][m][n] = (f32x4){0.f, 0.f, 0.f, 0.f};
        cur = nxt; cA = nA; cB = nB; ++ui;
        if constexpr (ALIGN_EPI) { if (wr == 1) PG8_BAR; }
    }
    PG8_WAIT_V(0);
    if constexpr (!ALIGN_EPI) { if (wr == 0) PG8_BAR; }
    PG8_BAR;
    if constexpr (Epi::AFTER_DRAIN) { E.fused(acc, cur, wr, wc, fr, fq, lds, wid, lane); S.done(cur); }
#undef PG8_SA
#undef PG8_SB
#undef PG8_STAGE
#undef PG8_LDA
#undef PG8_LDB
#undef PG8_MMA
#undef PG8_WAIT_V
#undef PG8_WAIT_L
#undef PG8_BAR
#undef PG8_SCHED
}
}
using namespace pg8;
#define LAS __attribute__((address_space(3)))
typedef LAS unsigned char* ldsp;
typedef float f32x16 __attribute__((ext_vector_type(16)));
#define LDS_WAIT() asm volatile("s_waitcnt lgkmcnt(0)" ::: "memory")

constexpr int M_ALL = 16896;
constexpr int PLD = 3584;
constexpr size_t MiB = 1u << 20;
constexpr size_t WS_W0 = 2 * MiB, WS_WL = 32 * MiB;
constexpr size_t W_IN = 0, W_OUT = 7 * MiB, W_MQ = 9 * MiB, W_MO = 10 * MiB, W_1 = 11 * MiB, W_2 = 19 * MiB;
constexpr size_t WS_WMKV = 66 * MiB;
constexpr size_t WS_XB = 80 * MiB, WS_X = 128 * MiB, WS_SSQ = 196 * MiB, WS_MEMB = 198 * MiB, WS_MEMSSQ = 199 * MiB, WS_RSTD = 199 * MiB + 65536, WS_MEMRSTD = 199 * MiB + 196608;
constexpr size_t WS_PROJ = 256 * MiB, WS_OSB = 512 * MiB, WS_MIX = 560 * MiB, WS_DS = 608 * MiB, WS_DD = 672 * MiB;
constexpr size_t WS_QM = 688 * MiB, WS_OM = 720 * MiB, WS_H = 768 * MiB, WS_PART = 904 * MiB, WS_VT = 940 * MiB, WS_KB = 960 * MiB, WS_MKB = 980 * MiB, WS_MVT = 982 * MiB;
constexpr int LDS_BYTES = 147456;
constexpr size_t WS_BAR = 65536;
constexpr size_t WS_CTR = 65536 + 16384;
constexpr int LDS_BARST = 131072 + 1024;

__device__ __forceinline__ float wave_sum(float v) {
#pragma unroll
    for (int o = 1; o < 64; o <<= 1) v += __shfl_xor(v, o);
    return v;
}
typedef float f32x2_t __attribute__((ext_vector_type(2))); typedef __bf16 bf16x2_t __attribute__((ext_vector_type(2)));
__device__ __forceinline__ unsigned pk2(float lo, float hi) { const f32x2_t v = {lo, hi}; const bf16x2_t b = __builtin_convertvector(v, bf16x2_t); return __builtin_bit_cast(unsigned, b); }
__device__ __forceinline__ unsigned f2bf(float f) { return pk2(f, f) & 0xffffu; }
__device__ __forceinline__ bf16x8 pack8(float a, float b, float c, float d, float e, float f, float g, float h) { return __builtin_bit_cast(bf16x8, (u32x4){pk2(a, b), pk2(c, d), pk2(e, f), pk2(g, h)}); }
__device__ __forceinline__ float fexp(float x) { return __builtin_amdgcn_exp2f(x * 1.4426950408889634f); }
__device__ __forceinline__ float flog(float x) { return __builtin_amdgcn_logf(x) * 0.6931471805599453f; }
__device__ __forceinline__ int crow(int i, int hi) { return (i & 3) + 8 * (i >> 2) + 4 * hi; }
#define MFMA32(a, b, c) __builtin_amdgcn_mfma_f32_32x32x16_bf16((a), (b), (c), 0, 0, 0)
#define MFMA16(a, b, c) __builtin_amdgcn_mfma_f32_16x16x32_bf16((a), (b), (c), 0, 0, 0)

__device__ __forceinline__ void transpose_item(const float* W, int K, int N, bf16_t* WT, int row_off, const float* gain, LAS float* scr, int item, int lane) {
    const int nblk = N / 32, kb = item / nblk, nb = item % nblk, k0 = 64 * kb, n0 = 32 * nb;
    float wv[32], gv[32];
#pragma unroll
    for (int i = 0; i < 32; ++i) { const int kk = 2 * i + (lane >> 5); wv[i] = W[(size_t)(k0 + kk) * N + n0 + (lane & 31)]; gv[i] = gain ? gain[k0 + kk] : 1.f; }
#pragma unroll
    for (int i = 0; i < 32; ++i) { const int kk = 2 * i + (lane >> 5); scr[kk * 33 + (lane & 31)] = wv[i] * gv[i]; }
    LDS_WAIT(); asm volatile("" ::: "memory");
    const int c = lane & 7;
#pragma unroll
    for (int j = 0; j < 4; ++j) { const int n = (lane >> 3) + 8 * j; const LAS float* s = scr + (8 * c) * 33 + n;
        u32x4 o; o.x = pk2(s[0 * 33], s[1 * 33]); o.y = pk2(s[2 * 33], s[3 * 33]); o.z = pk2(s[4 * 33], s[5 * 33]); o.w = pk2(s[6 * 33], s[7 * 33]);
        *(u32x4*)(WT + (size_t)(row_off + n0 + n) * K + k0 + 8 * c) = o; }
    LDS_WAIT(); asm volatile("" ::: "memory");
}
__device__ __forceinline__ void row_prep2(const float* srcA, bf16_t* dstA, float* sqA, float* rsA, const float* srcB, bf16_t* dstB, float* sqB, float* rsB, bool hasB, int lane) {
    const f32x4* xa = (const f32x4*)srcA + lane; const f32x4* xb = (const f32x4*)srcB + lane; f32x4 va[4], vb[4]; float sa = 0.f, sb = 0.f;
#pragma unroll
    for (int j = 0; j < 4; ++j) { va[j] = xa[64 * j]; vb[j] = xb[64 * j]; }
#pragma unroll
    for (int j = 0; j < 4; ++j) { sa += (va[j][0] * va[j][0] + va[j][1] * va[j][1]) + (va[j][2] * va[j][2] + va[j][3] * va[j][3]); sb += (vb[j][0] * vb[j][0] + vb[j][1] * vb[j][1]) + (vb[j][2] * vb[j][2] + vb[j][3] * vb[j][3]); }
    sa = wave_sum(sa); sb = wave_sum(sb);
    u32x2* oa = (u32x2*)dstA + lane; u32x2* ob = (u32x2*)dstB + lane;
#pragma unroll
    for (int j = 0; j < 4; ++j) { u32x2 w; w.x = pk2(va[j][0], va[j][1]); w.y = pk2(va[j][2], va[j][3]); oa[64 * j] = w;
        if (hasB) { u32x2 w2; w2.x = pk2(vb[j][0], vb[j][1]); w2.y = pk2(vb[j][2], vb[j][3]); ob[64 * j] = w2; } }
    if (lane < 16) { sqA[lane] = lane == 0 ? sa : 0.f; if (hasB) sqB[lane] = lane == 0 ? sb : 0.f; }
    if (lane == 0) { *rsA = rsqrtf(sa * (1.0f / 1024.0f) + 1e-6f); if (hasB) *rsB = rsqrtf(sb * (1.0f / 1024.0f) + 1e-6f); }
}
template <bool SAMPLE> __device__ __forceinline__ void sb_item(int item, int layer, const float* PROJ, const float* KP, const float* VP, const float* KS, const float* VS,
                                        const float* CK, const float* CV, const bf16_t* VT, const bf16_t* KB, float* OSB, int lane) {
    const int r32 = lane & 31, hi = lane >> 5;
    int qrow, qpos, ptop, split, h, qmin; bool qvalid; const float *kA, *vA, *kB, *vB;
    const bf16_t* VTh = VT; const bf16_t* KBh = KB;
    if (!SAMPLE) { const int b = item >> 11, rem = item & 2047, qt = rem & 255; h = rem >> 8; VTh = VT + ((size_t)(b * 8 + h) * 2048 * 64 + r32) * 4; KBh = KB + ((size_t)(b * 8 + h) * 256 * 8 * 32 + hi * 32 + r32) * 8;
        qrow = b * 8192 + qt * 32 + r32; qpos = qt * 32 + r32; qvalid = true; ptop = qt * 32; split = 1 << 30; qmin = qt * 32;
        kA = KP + (size_t)(b * 8192) * 512 + h * 64; vA = VP + (size_t)(b * 8192) * 512 + h * 64; kB = kA; vB = vA;
    } else { const int it = item - 4096, s = it >> 3; h = it & 7;
        qrow = NPROMPT + s * 16 + (r32 & 15); qpos = 2048 + (r32 & 15); qvalid = r32 < 16; ptop = 2032; split = 2048; qmin = 2048;
        kA = CK + (size_t)((layer * 32 + s) * 2048) * 512 + h * 64; vA = CV + (size_t)((layer * 32 + s) * 2048) * 512 + h * 64;
        kB = KS + ((long)(s * 16) - 2048) * 512 + h * 64; vB = VS + ((long)(s * 16) - 2048) * 512 + h * 64; }
    bf16x8 qh[4];
    { const bf16_t* qp = (const bf16_t*)PROJ + (size_t)qrow * PLD + h * 64 + 8 * hi;
#pragma unroll
      for (int ds = 0; ds < 4; ++ds) qh[ds] = *(const bf16x8*)(qp + 16 * ds); }
    f32x16 oacc[2];
#pragma unroll
    for (int i = 0; i < 16; ++i) { oacc[0][i] = 0.f; oacc[1][i] = 0.f; }
    float carry = 0.f;
    f32x4 kraw[8]; float vraw[2][2][8]; u32x2 vpk[2][2][2]; bf16x8 kq[4];
#define SB_LOAD_TILE(P0) do { if (SAMPLE) { const int pr_ = (P0) + r32, prc_ = pr_ < 0 ? 0 : pr_; const float* kp_ = (prc_ >= split ? kB : kA) + (long)prc_ * 512 + 8 * hi; \
        _Pragma("unroll") for (int ds = 0; ds < 4; ++ds) { kraw[2 * ds] = *(const f32x4*)(kp_ + 16 * ds); kraw[2 * ds + 1] = *(const f32x4*)(kp_ + 16 * ds + 4); } } \
        else { const int pq_ = (P0) < 0 ? 0 : (P0); _Pragma("unroll") for (int ds = 0; ds < 4; ++ds) kq[ds] = *(const bf16x8*)(KBh + ((size_t)(pq_ >> 5) * 8 + 2 * ds) * 32 * 8); } \
        if (SAMPLE) { _Pragma("unroll") for (int t = 0; t < 2; ++t) _Pragma("unroll") for (int j = 0; j < 8; ++j) { const int pk_ = (P0) + 16 * t + 8 * (j >> 2) + 4 * hi + (j & 3), pkc_ = pk_ < 0 ? 0 : pk_; \
            const float* vp_ = (pkc_ >= split ? vB : vA) + (long)pkc_ * 512 + r32; vraw[t][0][j] = vp_[0]; vraw[t][1][j] = vp_[32]; } } \
        else { const int pc_ = (P0) < 0 ? 0 : (P0); _Pragma("unroll") for (int t = 0; t < 2; ++t) _Pragma("unroll") for (int dt = 0; dt < 2; ++dt) { const bf16_t* vq_ = VTh + ((size_t)((pc_ >> 2) + 4 * t + hi) * 64 + dt * 32) * 4; \
            vpk[t][dt][0] = *(const u32x2*)vq_; vpk[t][dt][1] = *(const u32x2*)(vq_ + 2 * 64 * 4); } } } while (0)
    SB_LOAD_TILE(ptop);
    for (int p0 = ptop; p0 > -32; p0 -= 32) {
        bf16x8 kf[4], va[2][2];
#pragma unroll
        for (int ds = 0; ds < 4; ++ds) { if (SAMPLE) kf[ds] = pack8(kraw[2 * ds][0], kraw[2 * ds][1], kraw[2 * ds][2], kraw[2 * ds][3], kraw[2 * ds + 1][0], kraw[2 * ds + 1][1], kraw[2 * ds + 1][2], kraw[2 * ds + 1][3]); else kf[ds] = kq[ds]; }
#pragma unroll
        for (int t = 0; t < 2; ++t)
#pragma unroll
            for (int dt = 0; dt < 2; ++dt) { if (SAMPLE) va[t][dt] = pack8(vraw[t][dt][0], vraw[t][dt][1], vraw[t][dt][2], vraw[t][dt][3], vraw[t][dt][4], vraw[t][dt][5], vraw[t][dt][6], vraw[t][dt][7]);
                else va[t][dt] = __builtin_bit_cast(bf16x8, (u32x4){vpk[t][dt][0].x, vpk[t][dt][0].y, vpk[t][dt][1].x, vpk[t][dt][1].y}); }
        SB_LOAD_TILE(p0 - 32);
        asm volatile("" ::: "memory");
        f32x16 acc;
#pragma unroll
        for (int i = 0; i < 16; ++i) acc[i] = 0.f;
#pragma unroll
        for (int ds = 0; ds < 4; ++ds) acc = MFMA32(kf[ds], qh[ds], acc);
        float L[16], ls[16];
        if (p0 >= 0 && p0 + 32 <= qmin) {
#pragma unroll
            for (int i = 0; i < 16; ++i) { const float z = acc[i]; const float sp = fmaxf(z, 0.f) + flog(1.f + fexp(-fabsf(z))); L[i] = -sp; ls[i] = z - sp; }
        } else {
#pragma unroll
            for (int i = 0; i < 16; ++i) { const int kpos = p0 + crow(i, hi); const bool valid = (kpos < qpos) && (kpos >= 0); const float z = acc[i];
                const float sp = fmaxf(z, 0.f) + flog(1.f + fexp(-fabsf(z)));
                L[i] = valid ? -sp : 0.f; ls[i] = valid ? (z - sp) : -1e30f; }
        }
        float G[4], PG[4], T[4];
#pragma unroll
        for (int g = 0; g < 4; ++g) { G[g] = (L[4 * g] + L[4 * g + 1]) + (L[4 * g + 2] + L[4 * g + 3]); PG[g] = __shfl_xor(G[g], 32); T[g] = G[g] + PG[g]; }
        float A[4]; A[3] = 0.f; A[2] = T[3]; A[1] = T[3] + T[2]; A[0] = A[1] + T[1];
        float P[16];
#pragma unroll
        for (int g = 0; g < 4; ++g) { const float e3 = carry + A[g] + (hi == 0 ? PG[g] : 0.f), e2 = e3 + L[4 * g + 3], e1 = e2 + L[4 * g + 2], e0 = e1 + L[4 * g + 1];
            P[4 * g + 3] = fexp(ls[4 * g + 3] + e3); P[4 * g + 2] = fexp(ls[4 * g + 2] + e2); P[4 * g + 1] = fexp(ls[4 * g + 1] + e1); P[4 * g] = fexp(ls[4 * g] + e0); }
        carry += (T[0] + T[1]) + (T[2] + T[3]);
#pragma unroll
        for (int t = 0; t < 2; ++t) { const bf16x8 pb = pack8(P[8 * t], P[8 * t + 1], P[8 * t + 2], P[8 * t + 3], P[8 * t + 4], P[8 * t + 5], P[8 * t + 6], P[8 * t + 7]);
            oacc[0] = MFMA32(va[t][0], pb, oacc[0]); oacc[1] = MFMA32(va[t][1], pb, oacc[1]); }
        if (__all(carry < -110.0f)) break;
    }
    if (qvalid) { bf16_t* op = (bf16_t*)OSB + (size_t)qrow * 512 + h * 64 + 4 * hi;
#pragma unroll
        for (int dt = 0; dt < 2; ++dt)
#pragma unroll
            for (int g = 0; g < 4; ++g) *(u32x2*)(op + dt * 32 + 8 * g) = (u32x2){pk2(oacc[dt][4 * g], oacc[dt][4 * g + 1]), pk2(oacc[dt][4 * g + 2], oacc[dt][4 * g + 3])}; }
}

__device__ __forceinline__ void hg_load(const float* PROJ, int row0, int tvalid, int h, int tg, int k, int coff, float (&zr)[16]) {
#pragma unroll
    for (int j = 0; j < 16; ++j) { const int t = 16 * tg + j, tc = t < tvalid ? t : 0; zr[j] = __uint_as_float((unsigned)((const bf16_t*)PROJ)[(size_t)(row0 + tc) * PLD + coff + h * 128 + k] << 16); }
}
__device__ __forceinline__ void hg_prep(const float (&zr)[16], const float (&qr)[16], int tvalid, float lbv, int tg, float (&loc)[16], float (&kk)[16], float (&qv)[16]) {
    float run = 0.f;
#pragma unroll
    for (int j = 0; j < 16; ++j) { const int t = 16 * tg + j; const bool ok = t < tvalid; const float z = ok ? zr[j] : 0.f, q = ok ? qr[j] : 0.f;
        const float ez = fexp(-fabsf(z)), inv = __builtin_amdgcn_rcpf(1.f + ez);
        const float sig = z >= 0.f ? inv : ez * inv, nsig = z >= 0.f ? ez * inv : inv;
        float lf = (lbv > 0.f) ? flog(lbv + (1.f - lbv) * sig) : (fminf(z, 0.f) - flog(1.f + ez));
        if (!ok) lf = 0.f;
        run += lf; loc[j] = run; kk[j] = ok ? (1.f - lbv) * nsig : 0.f; qv[j] = q * 0.08838834764831845f; }
}
__device__ __forceinline__ void hg_h1(ldsp lds, const float* PROJ, const float (&zr)[16], int row0, int tvalid, int h, float lbv, float* dsOut, float* ddOut, const float* s0, int tid, int lane, int wave) {
    const int tg = tid >> 7, k = tid & 127;
    float loc[16], kk[16], qv[16], iv[16];
#pragma unroll
    for (int j = 0; j < 16; ++j) { const int ta = 16 * tg + j, tc = ta < tvalid ? ta : 0; const float x = __uint_as_float((unsigned)((const bf16_t*)PROJ)[(size_t)(row0 + tc) * PLD + 2560 + h * 128 + k] << 16); iv[j] = ta < tvalid ? x : 0.f; }
    hg_prep(zr, zr, tvalid, lbv, tg, loc, kk, qv);
    LAS float* TOT = (LAS float*)lds; LAS float* DK = (LAS float*)(lds + 2048);
    TOT[tg * 128 + k] = loc[15];
    __syncthreads();
    const float t0 = TOT[k], t1 = TOT[128 + k], t2 = TOT[256 + k], t3 = TOT[384 + k];
    const float r1 = t0, r2 = r1 + t1, r3 = r2 + t2, r4 = r3 + t3;
    const float rtg = tg == 0 ? 0.f : (tg == 1 ? r1 : (tg == 2 ? r2 : r3));
    { unsigned w[8];
#pragma unroll
      for (int jj = 0; jj < 8; ++jj) w[jj] = pk2(kk[2 * jj] * fexp(r4 - rtg - loc[2 * jj]), kk[2 * jj + 1] * fexp(r4 - rtg - loc[2 * jj + 1]));
      *(LAS u32x4*)(lds + 4096 + k * 144 + tg * 32) = (u32x4){w[0], w[1], w[2], w[3]}; *(LAS u32x4*)(lds + 4096 + k * 144 + tg * 32 + 16) = (u32x4){w[4], w[5], w[6], w[7]};
#pragma unroll
      for (int jj = 0; jj < 8; ++jj) w[jj] = pk2(iv[2 * jj], iv[2 * jj + 1]);
      *(LAS u32x4*)(lds + 22528 + k * 144 + tg * 32) = (u32x4){w[0], w[1], w[2], w[3]}; *(LAS u32x4*)(lds + 22528 + k * 144 + tg * 32 + 16) = (u32x4){w[4], w[5], w[6], w[7]}; }
    if (tg == 0) { const float dk = fexp(r4); DK[k] = dk; if (ddOut) ddOut[k] = dk; }
    __syncthreads();
    const int r32 = lane & 31, hi = lane >> 5, km = wave & 3, vn0 = (wave >> 2) * 2;
#pragma unroll
    for (int vv = 0; vv < 2; ++vv) { f32x16 acc;
#pragma unroll
        for (int i = 0; i < 16; ++i) acc[i] = 0.f;
#pragma unroll
        for (int ks = 0; ks < 4; ++ks) { const bf16x8 a = *(LAS bf16x8*)(lds + 4096 + (32 * km + r32) * 144 + ks * 32 + hi * 16);
            const bf16x8 b = *(LAS bf16x8*)(lds + 22528 + (32 * (vn0 + vv) + r32) * 144 + ks * 32 + hi * 16); acc = MFMA32(a, b, acc); }
        const int v = 32 * (vn0 + vv) + r32;
#pragma unroll
        for (int i = 0; i < 16; ++i) { if (s0) { const int kr = 32 * km + crow(i, hi); dsOut[kr * 128 + v] = acc[i] + DK[kr] * s0[kr * 128 + v]; } }
        if (!s0) { bf16_t* db = (bf16_t*)dsOut + v * 128 + 32 * km + 4 * hi;
#pragma unroll
            for (int g = 0; g < 4; ++g) *(u32x2*)(db + 8 * g) = (u32x2){pk2(acc[4 * g], acc[4 * g + 1]), pk2(acc[4 * g + 2], acc[4 * g + 3])}; } }
    __syncthreads();
}
__device__ __forceinline__ void hg_h3(ldsp lds, const float* PROJ, const float (&zr)[16], int row0, int tvalid, int h, float lbv, const float* Ssrc, bool sbf, const float* hgain, bf16_t* MIX, int tid, int lane, int wave) {
    constexpr int QE = 2048, KE = 19456, ST = 62976, IV = 97792, PM = 116224, OST = 19456;
    const int tg = tid >> 7, k = tid & 127;
    float loc[16], kk[16], qv[16];
    f32x4 gv[4], gav[4];
    float qr[16]; hg_load(PROJ, row0, tvalid, h, tg, k, 1536, qr);
    hg_prep(zr, qr, tvalid, lbv, tg, loc, kk, qv);
    LAS float* TOT = (LAS float*)lds;
    TOT[tg * 128 + k] = loc[15];
    for (int i = tid; i < 2304; i += 512) ((LAS unsigned*)(lds + PM))[i] = 0u;
    if (sbf) {
#pragma unroll
        for (int jj = 0; jj < 4; ++jj) { const int cidx = tid + 512 * jj, v = cidx >> 4, kc = cidx & 15;
            *(LAS u32x4*)(lds + ST + v * 272 + kc * 16) = *(const u32x4*)((const bf16_t*)Ssrc + v * 128 + kc * 8); }
    } else {
#pragma unroll
        for (int jj = 0; jj < 16; ++jj) { const int kp = 2 * ((tid >> 7) + 4 * jj), v = tid & 127;
            *(LAS unsigned*)(lds + ST + v * 272 + kp * 2) = pk2(Ssrc[kp * 128 + v], Ssrc[(kp + 1) * 128 + v]); } }
    { unsigned w[8];
#pragma unroll
      for (int jj = 0; jj < 8; ++jj) { const int ta = 16 * tg + 2 * jj, t0 = ta < tvalid ? ta : 0, t1 = (ta + 1) < tvalid ? ta + 1 : 0;
          const float x0 = __uint_as_float((unsigned)((const bf16_t*)PROJ)[(size_t)(row0 + t0) * PLD + 2560 + h * 128 + k] << 16), x1 = __uint_as_float((unsigned)((const bf16_t*)PROJ)[(size_t)(row0 + t1) * PLD + 2560 + h * 128 + k] << 16);
          w[jj] = pk2(ta < tvalid ? x0 : 0.f, (ta + 1) < tvalid ? x1 : 0.f); }
      *(LAS u32x4*)(lds + IV + k * 144 + tg * 32) = (u32x4){w[0], w[1], w[2], w[3]}; *(LAS u32x4*)(lds + IV + k * 144 + tg * 32 + 16) = (u32x4){w[4], w[5], w[6], w[7]}; }
    __syncthreads();
    { const int t = tid >> 3, v0 = (tid & 7) * 16; const int tc = t < tvalid ? t : 0; const bf16_t* gp = (const bf16_t*)PROJ + (size_t)(row0 + tc) * PLD + 3072 + h * 128 + v0; const float* hg = hgain + h * 128 + v0;
      const u32x4 g0 = *(const u32x4*)gp, g1 = *(const u32x4*)(gp + 8);
      gv[0] = (f32x4){__uint_as_float(g0.x << 16), __uint_as_float(g0.x & 0xffff0000u), __uint_as_float(g0.y << 16), __uint_as_float(g0.y & 0xffff0000u)};
      gv[1] = (f32x4){__uint_as_float(g0.z << 16), __uint_as_float(g0.z & 0xffff0000u), __uint_as_float(g0.w << 16), __uint_as_float(g0.w & 0xffff0000u)};
      gv[2] = (f32x4){__uint_as_float(g1.x << 16), __uint_as_float(g1.x & 0xffff0000u), __uint_as_float(g1.y << 16), __uint_as_float(g1.y & 0xffff0000u)};
      gv[3] = (f32x4){__uint_as_float(g1.z << 16), __uint_as_float(g1.z & 0xffff0000u), __uint_as_float(g1.w << 16), __uint_as_float(g1.w & 0xffff0000u)};
#pragma unroll
      for (int c = 0; c < 4; ++c) gav[c] = *(const f32x4*)(hg + 4 * c); }
    const float t0 = TOT[k], t1 = TOT[128 + k], t2 = TOT[256 + k];
    const float r1 = t0, r2 = r1 + t1, r3 = r2 + t2;
    const float rtg = tg == 0 ? 0.f : (tg == 1 ? r1 : (tg == 2 ? r2 : r3));
#pragma unroll
    for (int j = 0; j < 16; ++j) *(LAS unsigned short*)(lds + QE + (16 * tg + j) * 272 + k * 2) = (unsigned short)f2bf(qv[j] * fexp(loc[j]));
#pragma unroll
    for (int i = 0; i < 4; ++i) { if (i >= tg) { const float ri = i == 0 ? 0.f : (i == 1 ? r1 : (i == 2 ? r2 : r3)); const int rb = 8 * i * (i + 1);
#pragma unroll
        for (int j = 0; j < 16; ++j) *(LAS unsigned short*)(lds + KE + (rb + 16 * tg + j) * 272 + k * 2) = (unsigned short)f2bf(kk[j] * fexp(fminf(ri - rtg - loc[j], 80.f))); } }
    __syncthreads();
    { const int c16 = lane & 15, q4 = lane >> 4;
      for (int tix = wave; tix < 10; tix += 8) { const int i = tix < 1 ? 0 : (tix < 3 ? 1 : (tix < 6 ? 2 : 3)), j = tix - i * (i + 1) / 2, rb = 8 * i * (i + 1);
          f32x4 acc = {0.f, 0.f, 0.f, 0.f};
#pragma unroll
          for (int ks = 0; ks < 4; ++ks) { const bf16x8 a = *(LAS bf16x8*)(lds + QE + (16 * i + c16) * 272 + ks * 64 + q4 * 16);
              const bf16x8 b = *(LAS bf16x8*)(lds + KE + (rb + 16 * j + c16) * 272 + ks * 64 + q4 * 16); acc = MFMA16(a, b, acc); }
#pragma unroll
          for (int ii = 0; ii < 4; ++ii) { const int tl = 4 * q4 + ii; float pv = acc[ii]; if (i == j && c16 > tl) pv = 0.f;
              *(LAS unsigned short*)(lds + PM + (16 * i + tl) * 144 + (16 * j + c16) * 2) = (unsigned short)f2bf(pv); } } }
    __syncthreads();
#pragma unroll
    for (int j = 0; j < 16; ++j) *(LAS unsigned short*)(lds + QE + (16 * tg + j) * 272 + k * 2) = (unsigned short)f2bf(qv[j] * fexp(rtg + loc[j]));
    __syncthreads();
    { const int r32 = lane & 31, hi = lane >> 5, tm = wave & 1, vn = wave >> 1; f32x16 acc;
#pragma unroll
      for (int i = 0; i < 16; ++i) acc[i] = 0.f;
#pragma unroll
      for (int ks = 0; ks < 8; ++ks) { const bf16x8 a = *(LAS bf16x8*)(lds + QE + (32 * tm + r32) * 272 + ks * 32 + hi * 16);
          const bf16x8 b = *(LAS bf16x8*)(lds + ST + (32 * vn + r32) * 272 + ks * 32 + hi * 16); acc = MFMA32(a, b, acc); }
#pragma unroll
      for (int ks = 0; ks < 4; ++ks) { const bf16x8 a = *(LAS bf16x8*)(lds + PM + (32 * tm + r32) * 144 + ks * 32 + hi * 16);
          const bf16x8 b = *(LAS bf16x8*)(lds + IV + (32 * vn + r32) * 144 + ks * 32 + hi * 16); acc = MFMA32(a, b, acc); }
#pragma unroll
      for (int i = 0; i < 16; ++i) *(LAS float*)(lds + OST + (32 * tm + crow(i, hi)) * 528 + (32 * vn + r32) * 4) = acc[i]; }
    __syncthreads();
    { const int t = tid >> 3, v0 = (tid & 7) * 16; f32x4 o[4]; float ss = 0.f;
#pragma unroll
      for (int c = 0; c < 4; ++c) { o[c] = *(LAS f32x4*)(lds + OST + t * 528 + (v0 + 4 * c) * 4); ss += (o[c][0] * o[c][0] + o[c][1] * o[c][1]) + (o[c][2] * o[c][2] + o[c][3] * o[c][3]); }
      ss += __shfl_xor(ss, 1); ss += __shfl_xor(ss, 2); ss += __shfl_xor(ss, 4);
      const float rs = rsqrtf(ss * (1.0f / 128.0f) + 1e-6f);
      if (t < tvalid) { const size_t row = (size_t)(row0 + t); unsigned w[8];
#pragma unroll
          for (int c = 0; c < 4; ++c) { const f32x4 g = gv[c], ga = gav[c]; f32x4 r;
#pragma unroll
              for (int e = 0; e < 4; ++e) r[e] = o[c][e] * rs * ga[e] * (g[e] * __builtin_amdgcn_rcpf(1.f + fexp(-g[e])));
              w[2 * c] = pk2(r[0], r[1]); w[2 * c + 1] = pk2(r[2], r[3]); }
          bf16_t* mp = MIX + row * 1024 + 512 + h * 128 + v0;
          *(u32x4*)mp = (u32x4){w[0], w[1], w[2], w[3]}; *(u32x4*)(mp + 8) = (u32x4){w[4], w[5], w[6], w[7]}; } }
    __syncthreads();
}

__device__ __forceinline__ void xattn_item(ldsp lds, const bf16_t* QM, const float* Kg, const float* Vg, const bf16_t* Kb, const bf16_t* Vtb, int row0, int tvalid, int hm, bf16_t* OM, int tid, int lane, int wave) {
    constexpr int KM = 0, QS = 69632, PMX = 87040, RMO = 120832, RSO = 121344, VT = 0;
    if (Kb) {
#pragma unroll
        for (int jj = 0; jj < 8; ++jj) { const int cidx = tid + 512 * jj, m = cidx >> 4, dc = cidx & 15; *(LAS u32x4*)(lds + KM + m * 272 + dc * 16) = *(const u32x4*)(Kb + m * 128 + dc * 8); }
    } else {
#pragma unroll
        for (int jj = 0; jj < 8; ++jj) { const int cidx = tid + 512 * jj, m = cidx >> 4, dc = cidx & 15; const float* p = Kg + (size_t)m * 512 + dc * 8;
            const f32x4 a = *(const f32x4*)p, b = *(const f32x4*)(p + 4);
            *(LAS u32x4*)(lds + KM + m * 272 + dc * 16) = (u32x4){pk2(a[0], a[1]), pk2(a[2], a[3]), pk2(b[0], b[1]), pk2(b[2], b[3])}; } }
#pragma unroll
    for (int jj = 0; jj < 2; ++jj) { const int cidx = tid + 512 * jj, t = cidx >> 4, dc = cidx & 15; u32x4 w = {0u, 0u, 0u, 0u};
        if (t < tvalid) w = *(const u32x4*)(QM + (size_t)(row0 + t) * 512 + hm * 128 + dc * 8);
        *(LAS u32x4*)(lds + QS + t * 272 + dc * 16) = w; }
    float vr0[32], vr1[32]; u32x4 vq[8];
    if (Vtb) {
#pragma unroll
        for (int jj = 0; jj < 8; ++jj) { const int cidx = tid + 512 * jj, d = cidx >> 5, mc = cidx & 31; vq[jj] = *(const u32x4*)(Vtb + d * 256 + mc * 8); }
    } else {
#pragma unroll
        for (int jj = 0; jj < 32; ++jj) { const int idx = tid + 512 * jj, d = idx & 127, mp = idx >> 7; vr0[jj] = Vg[(size_t)(2 * mp) * 512 + d]; vr1[jj] = Vg[(size_t)(2 * mp + 1) * 512 + d]; } }
    __syncthreads();
    const int tgp = wave & 3, mh = wave >> 2, c16 = lane & 15, q4 = lane >> 4, tok = 16 * tgp + c16;
    LAS float* RM = (LAS float*)(lds + RMO); LAS float* RS = (LAS float*)(lds + RSO);
    f32x4 sacc[8];
    { bf16x8 bq[4];
#pragma unroll
      for (int ks = 0; ks < 4; ++ks) bq[ks] = *(LAS bf16x8*)(lds + QS + tok * 272 + ks * 64 + q4 * 16);
#pragma unroll
      for (int j = 0; j < 8; ++j) { f32x4 acc = {0.f, 0.f, 0.f, 0.f};
#pragma unroll
          for (int ks = 0; ks < 4; ++ks) { const bf16x8 a = *(LAS bf16x8*)(lds + KM + (128 * mh + 16 * j + c16) * 272 + ks * 64 + q4 * 16); acc = MFMA16(a, bq[ks], acc); }
          sacc[j] = acc; } }
    float mx = -3.0e38f;
#pragma unroll
    for (int j = 0; j < 8; ++j) mx = fmaxf(fmaxf(mx, fmaxf(sacc[j][0], sacc[j][1])), fmaxf(sacc[j][2], sacc[j][3]));
    mx = fmaxf(mx, __shfl_xor(mx, 16)); mx = fmaxf(mx, __shfl_xor(mx, 32));
    if (q4 == 0) RM[mh * 64 + tok] = mx;
    __syncthreads();
    { const float m = fmaxf(RM[tok], RM[64 + tok]); float sum = 0.f;
#pragma unroll
      for (int j = 0; j < 8; ++j) { const float p0 = fexp(sacc[j][0] - m), p1 = fexp(sacc[j][1] - m), p2 = fexp(sacc[j][2] - m), p3 = fexp(sacc[j][3] - m);
          sum += (p0 + p1) + (p2 + p3);
          *(LAS u32x2*)(lds + PMX + tok * 528 + (128 * mh + 16 * j + 4 * q4) * 2) = (u32x2){pk2(p0, p1), pk2(p2, p3)}; }
      sum += __shfl_xor(sum, 16); sum += __shfl_xor(sum, 32);
      if (q4 == 0) RS[mh * 64 + tok] = sum; }
    __syncthreads();
    if (Vtb) {
#pragma unroll
        for (int jj = 0; jj < 8; ++jj) { const int cidx = tid + 512 * jj, d = cidx >> 5, mc = cidx & 31; *(LAS u32x4*)(lds + VT + d * 528 + mc * 16) = vq[jj]; }
    } else {
#pragma unroll
        for (int jj = 0; jj < 32; ++jj) { const int idx = tid + 512 * jj, d = idx & 127, mp = idx >> 7;
            *(LAS unsigned*)(lds + VT + d * 528 + mp * 4) = pk2(vr0[jj], vr1[jj]); } }
    __syncthreads();
    { const int r32 = lane & 31, hi = lane >> 5, tm = wave & 1, dn = wave >> 1; f32x16 acc;
#pragma unroll
      for (int i = 0; i < 16; ++i) acc[i] = 0.f;
#pragma unroll
      for (int ks = 0; ks < 16; ++ks) { const bf16x8 a = *(LAS bf16x8*)(lds + PMX + (32 * tm + r32) * 528 + ks * 32 + hi * 16);
          const bf16x8 b = *(LAS bf16x8*)(lds + VT + (32 * dn + r32) * 528 + ks * 32 + hi * 16); acc = MFMA32(a, b, acc); }
#pragma unroll
      for (int i = 0; i < 16; ++i) { const int tk = 32 * tm + crow(i, hi); const float inv = __builtin_amdgcn_rcpf(RS[tk] + RS[64 + tk]);
          if (tk < tvalid) OM[(size_t)(row0 + tk) * 512 + hm * 128 + 32 * dn + r32] = (bf16_t)f2bf(acc[i] * inv); } }
    __syncthreads();
}
#define XB_TMO      128
#define XB_XCNT(j)  (256  + 64 * (j))
#define XB_XSUB(j)  (1280 + 64 * (j))
#define XB_XGEN(j)  (2304 + 64 * (j))
#define XB_TOP      3328
#define XB_TOPGEN   3392
#define XCD_BAR_WORDS 3456
#define XB_SPIN_CAP (1u << 18)

__device__ __forceinline__ unsigned xb_ld(unsigned* p)              { return __hip_atomic_load(p, __ATOMIC_RELAXED, __HIP_MEMORY_SCOPE_AGENT); }
__device__ __forceinline__ unsigned xb_add(unsigned* p, unsigned v) { return __hip_atomic_fetch_add(p, v, __ATOMIC_RELAXED, __HIP_MEMORY_SCOPE_AGENT); }
__device__ __forceinline__ unsigned xb_xcc_id() { return (unsigned)__builtin_amdgcn_s_getreg((3 << 11) | 20) & 0xFu; }
#define XB_SPIN(cond, bar) do { unsigned _sp = 0; while (cond) { __builtin_amdgcn_s_sleep(1); \
    if ((++_sp & 255u) == 0u) { if (xb_ld(&(bar)[XB_TMO])) break; if (_sp > XB_SPIN_CAP) { atomicAdd(&(bar)[XB_TMO], 1u); break; } } } } while (0)

struct XcdBarrier {
    unsigned* bar; unsigned x;
    volatile LAS unsigned* st;
};

__device__ __forceinline__ XcdBarrier xcd_barrier_post(unsigned* bar, volatile LAS unsigned* st) {
    XcdBarrier b; b.bar = bar; b.x = xb_xcc_id(); b.st = st;
    if (threadIdx.x == 0) (void)xb_add(&bar[XB_XCNT(b.x)], 1u);
    return b;
}
__device__ __forceinline__ void xcd_barrier_complete(unsigned* bar, unsigned x, unsigned& nloc, unsigned& nx) {
    const unsigned G = gridDim.x * gridDim.y * gridDim.z;
    unsigned sum, cnt, mine, sp = 0u;
    for (;;) {
        sum = 0u; cnt = 0u; mine = 0u;
#pragma unroll
        for (unsigned j = 0; j < 16; ++j) { const unsigned c = xb_ld(&bar[XB_XCNT(j)]); sum += c; cnt += (c > 0u) ? 1u : 0u; mine = (j == x) ? c : mine; }
        if (sum == G) break;
        __builtin_amdgcn_s_sleep(1);
        if ((++sp & 255u) == 0u) { if (xb_ld(&bar[XB_TMO])) break; if (sp > XB_SPIN_CAP) { atomicAdd(&bar[XB_TMO], 1u); break; } }
    }
    nloc = mine > 0u ? mine : 1u; nx = cnt > 0u ? cnt : 1u;
}

__device__ __forceinline__ void xcd_barrier(const XcdBarrier& b) {
    asm volatile("s_waitcnt vmcnt(0)" ::: "memory");
    __syncthreads();
    if (threadIdx.x == 0) {
        unsigned* bar = b.bar;
        __builtin_amdgcn_s_waitcnt(0);
        unsigned nloc = b.st[0], nx = b.st[1];
        if (nloc == 0u) { xcd_barrier_complete(bar, b.x, nloc, nx); b.st[0] = nloc; b.st[1] = nx; }
        const unsigned old = xb_add(&bar[XB_XSUB(b.x)], 1u);
        const unsigned gen = old / nloc;
        if (old + 1u == (gen + 1u) * nloc) {
            __builtin_amdgcn_fence(__ATOMIC_RELEASE, "agent");
            asm volatile("s_waitcnt vmcnt(0)" ::: "memory");
            const unsigned og = xb_add(&bar[XB_TOP], 1u);
            const unsigned tg = og / nx;
            if (og + 1u == (tg + 1u) * nx) xb_add(&bar[XB_TOPGEN], 1u);
            else XB_SPIN(xb_ld(&bar[XB_TOPGEN]) == tg, bar);
            __builtin_amdgcn_fence(__ATOMIC_ACQUIRE, "agent");
            xb_add(&bar[XB_XGEN(b.x)], 1u);
            asm volatile("s_waitcnt vmcnt(0)" ::: "memory");
        } else {
            XB_SPIN(xb_ld(&bar[XB_XGEN(b.x)]) == gen, bar);
            __builtin_amdgcn_fence(__ATOMIC_ACQUIRE, "agent");
            asm volatile("s_waitcnt vmcnt(0)" ::: "memory");
        }
    }
    __syncthreads();
}

__device__ __forceinline__ const float* gptr_(unsigned long long v) { return (const float*)(const __attribute__((address_space(1))) float*)v; }
#define GPTR(p) gptr_(p)
#define FPTR(p) ((const float*)(p))
#define OPQ(x) asm volatile("" : "+s"(x))
#define OPQP(T, x) do { unsigned long long xi_ = (unsigned long long)(x); asm volatile("" : "+s"(xi_)); x = (T*)(__attribute__((address_space(1))) T*)xi_; } while (0)
struct Args { const float* in[24]; float* out; unsigned char* ws; };
__global__ void __launch_bounds__(512, 2) mega_fwd(Args args) {
    extern __shared__ __attribute__((aligned(16))) unsigned char lds_raw[];
    cg::grid_group grid = cg::this_grid();
    ldsp lds = (ldsp)lds_raw;
    unsigned char* const ws = args.ws; float* const out = args.out;
#define WAVE_IDS int tid = threadIdx.x; asm volatile("" : "+v"(tid)); const int lane = tid & 63, wave = __builtin_amdgcn_readfirstlane(tid >> 6), G = gridDim.x, bid = blockIdx.x, gw = bid * 8 + wave, NGW = G * 8; (void)lane; (void)gw; (void)NGW

    {
        WAVE_IDS;
        if (bid == 0) for (int i = tid; i < XCD_BAR_WORDS; i += 512) ((unsigned*)(ws + WS_BAR))[i] = 0u;
        if (bid == 0 && tid < 8) ((unsigned*)(ws + WS_CTR))[tid] = 0u;
        if (tid < 2) ((LAS unsigned*)(lds + LDS_BARST))[tid] = 0u;
        if (bid == 0 && tid == 0) { const float** tab = (const float**)ws;
#pragma unroll
            for (int i = 0; i < 24; ++i) tab[i] = args.in[i]; }
        bf16_t* XB = (bf16_t*)(ws + WS_XB); float* SSQ = (float*)(ws + WS_SSQ); bf16_t* MEMB = (bf16_t*)(ws + WS_MEMB); float* MEMSSQ = (float*)(ws + WS_MEMSSQ); bf16_t* WMKV = (bf16_t*)(ws + WS_WMKV);
        LAS float* scr = (LAS float*)(lds + wave * 16384);
#define CONV_ITEM(PTR, L_, R_, WSB) do { const int l = (L_); int r = (R_); unsigned char* wl = (WSB) + WS_W0 + (size_t)l * WS_WL; bf16_t* wmkv = (bf16_t*)((WSB) + WS_WMKV); \
            if (r < 1792) { transpose_item(PTR(10) + (size_t)l * 1024 * 3584, 1024, 3584, (bf16_t*)(wl + W_IN), 0, PTR(9) + l * 1024, scr, r, lane); break; } r -= 1792; \
            if (r < 512)  { transpose_item(PTR(13) + (size_t)l * 1024 * 1024, 1024, 1024, (bf16_t*)(wl + W_OUT), 0, nullptr, scr, r, lane); break; } r -= 512; \
            if (r < 256)  { transpose_item(PTR(16) + (size_t)l * 1024 * 512, 1024, 512, (bf16_t*)(wl + W_MQ), 0, PTR(14) + l * 1024, scr, r, lane); break; } r -= 256; \
            if (r < 256)  { transpose_item(PTR(17) + (size_t)l * 1024 * 512, 1024, 512, wmkv + (size_t)l * 1024 * 1024, 0, PTR(15) + l * 1024, scr, r, lane); break; } r -= 256; \
            if (r < 256)  { transpose_item(PTR(18) + (size_t)l * 1024 * 512, 1024, 512, wmkv + (size_t)l * 1024 * 1024, 512, PTR(15) + l * 1024, scr, r, lane); break; } r -= 256; \
            if (r < 256)  { transpose_item(PTR(19) + (size_t)l * 512 * 1024, 512, 1024, (bf16_t*)(wl + W_MO), 0, nullptr, scr, r, lane); break; } r -= 256; \
            if (r < 2048) { transpose_item(PTR(21) + (size_t)l * 1024 * 4096, 1024, 4096, (bf16_t*)(wl + W_1), 0, PTR(20) + l * 1024, scr, r, lane); break; } r -= 2048; \
            transpose_item(PTR(22) + (size_t)l * 4096 * 1024, 4096, 1024, (bf16_t*)(wl + W_2), 0, nullptr, scr, r, lane); } while (0)
#define ARGP(i) args.in[i]
        const bool defer = (G == 256);
        for (int it = gw; it < (defer ? 3328 + 512 : 14848); it += NGW) {
            if (defer) { if (it < 3328) CONV_ITEM(ARGP, 0, it, ws); else CONV_ITEM(ARGP, 1, 2560 + (it - 3328), ws); }
            else { if (it < 7424) CONV_ITEM(ARGP, 0, it, ws); else CONV_ITEM(ARGP, 1, it - 7424, ws); } }
#undef ARGP
#define ROW_PTRS(m, S, D, Q, R) do { if ((m) < NPROMPT) { S = args.in[0] + (size_t)(m) * 1024; D = XB + (size_t)(m) * 1024; Q = SSQ + (size_t)(m) * 16; R = (float*)(ws + WS_RSTD) + (m); } \
            else if ((m) < M_ALL) { S = args.in[1] + (size_t)((m) - NPROMPT) * 1024; D = XB + (size_t)(m) * 1024; Q = SSQ + (size_t)(m) * 16; R = (float*)(ws + WS_RSTD) + (m); } \
            else { S = args.in[2] + (size_t)((m) - M_ALL) * 1024; D = MEMB + (size_t)((m) - M_ALL) * 1024; Q = MEMSSQ + (size_t)((m) - M_ALL) * 16; R = (float*)(ws + WS_MEMRSTD) + ((m) - M_ALL); } } while (0)
        for (int m0 = gw; m0 < M_ALL + 512; m0 += 2 * NGW) { const bool hasB = m0 + NGW < M_ALL + 512; const int m1 = hasB ? m0 + NGW : m0;
            const float *sA, *sB; bf16_t *dA, *dB; float *qA, *qB, *rA, *rB;
            ROW_PTRS(m0, sA, dA, qA, rA); ROW_PTRS(m1, sB, dB, qB, rB);
            row_prep2(sA, dA, qA, rA, sB, dB, qB, rB, hasB, lane); }
#undef ROW_PTRS
    }
    grid.sync();
    (void)xcd_barrier_post((unsigned*)(ws + WS_BAR), (volatile LAS unsigned*)(lds + LDS_BARST));
#define GRID_BAR() do { XcdBarrier b_; b_.bar = (unsigned*)(ws + WS_BAR); b_.x = xb_xcc_id(); b_.st = (volatile LAS unsigned*)(lds + LDS_BARST); xcd_barrier(b_); } while (0)

#pragma nounroll
    for (int l = 0; l < 2; ++l) {
#pragma nounroll
        for (int q = 0; q < (l == 0 ? 2 : 1); ++q) {
            WAVE_IDS; unsigned char* w_ = ws; float* o_ = out; int l_ = l; OPQP(unsigned char, w_); OPQP(float, o_); OPQ(l_);
            Gemm g; EpiF32 E;
            if (q == 0) { g = Gemm{(const bf16_t*)(w_ + WS_XB), (const bf16_t*)(w_ + WS_W0 + (size_t)l_ * WS_WL + W_IN), M_ALL, 3584, 1024};
                E = EpiF32{0, (const float*)(w_ + WS_RSTD), (float*)(w_ + WS_PROJ), o_, l_, (bf16_t*)(w_ + WS_VT), (bf16_t*)(w_ + WS_KB)}; }
            else { g = Gemm{(const bf16_t*)(w_ + WS_MEMB), (const bf16_t*)(w_ + WS_WMKV), 512, 2048, 1024};
                E = EpiF32{1, (const float*)(w_ + WS_MEMRSTD), nullptr, o_, l_, (bf16_t*)(w_ + WS_MVT), (bf16_t*)(w_ + WS_MKB)}; }
            StaticOrder S; S.init(g.M, g.N, G, q == 0 ? bid : (bid + 16) % G);
            gemm_phase<EpiF32, StaticOrder, true, true>(lds, g, S, E);
        }
        if (l == 0 && gridDim.x == 256 && blockIdx.x >= 156 && blockIdx.x < 240) {
            WAVE_IDS; unsigned char* w_ = ws; OPQP(unsigned char, w_);
            const unsigned long long* tabc = (const unsigned long long*)w_; LAS float* scr = (LAS float*)(lds + wave * 16384);
#define TABP(i) FPTR(tabc[i])
            for (int j = (bid - 156) * 8 + wave; j < 4096; j += 84 * 8) CONV_ITEM(TABP, 0, 3328 + j, w_);
#undef TABP
        }
        GRID_BAR();
#pragma nounroll
        for (int ph = 0; ph < 3; ++ph) {
            WAVE_IDS; unsigned char* w_ = ws; float* o_ = out; int l_ = l; OPQP(unsigned char, w_); OPQP(float, o_); OPQ(l_);
            const unsigned long long* tab = (const unsigned long long*)w_;
            float* PROJ = (float*)(w_ + WS_PROJ); float* OSB = (float*)(w_ + WS_OSB); bf16_t* MIX = (bf16_t*)(w_ + WS_MIX); float* DS = (float*)(w_ + WS_DS); float* DD = (float*)(w_ + WS_DD);
            if (ph != 1) {
                const int nit = ph == 0 ? 1152 : 1024;
                const float* state_hgrn = GPTR(tab[5]); const float* lb_logits = GPTR(tab[8]); const float* hgain = GPTR(tab[12]) + l_ * 512;
#define HG_DECODE(IT, ROW0, TV, H) do { if ((IT) < 1024) { const int bh_ = (IT) >> 7; H = bh_ & 3; ROW0 = (bh_ >> 2) * 8192 + ((IT) & 127) * 64; TV = 64; } \
                    else { const int si_ = (IT) - 1024; H = si_ & 3; ROW0 = NPROMPT + 16 * (si_ >> 2); TV = 16; } } while (0)
#define HG_MAP(Q) (ph == 0 ? ((Q) < 128 ? 1024 + (Q) : (Q) - 128) : (Q))
                volatile LAS unsigned* LW = (volatile LAS unsigned*)(lds + LDS_BARST);
                unsigned* ctr = (unsigned*)(w_ + WS_CTR) + 2 * l_;
                unsigned nextq = 0; int cur;
                if (ph == 0) { if (tid == 0) LW[4] = atomicAdd(ctr, 1u); __syncthreads(); cur = (int)LW[4]; if (tid == 0) nextq = atomicAdd(ctr, 1u); }
                else cur = bid;
                while (cur < nit) {
                    const int it = HG_MAP(cur); int nxt;
                    if (ph == 0) { __syncthreads(); if (tid == 0) LW[4] = nextq; __syncthreads(); nxt = (int)LW[4]; if (tid == 0 && nxt < nit) nextq = atomicAdd(ctr, 1u); }
                    else nxt = cur + G;
                    int row0, tvalid, h; HG_DECODE(it, row0, tvalid, h);
                    float* dsOut; float* ddOut; const float* s0; const float* Ssrc;
                    if (it < 1024) { const int bh = it >> 7, c = it & 127; dsOut = DS + (size_t)(bh * 128 + c) * 16384; ddOut = DD + (size_t)(bh * 128 + c) * 128; s0 = nullptr; Ssrc = dsOut; }
                    else { const int si = it - 1024, s = si >> 2; s0 = state_hgrn + (size_t)((l_ * 32 + s) * 4 + h) * 16384; Ssrc = s0; dsOut = o_ + O_HS + (size_t)((l_ * 32 + s) * 4 + h) * 16384; ddOut = nullptr; }
                    int t2 = tid; asm volatile("" : "+v"(t2)); const int lane2 = t2 & 63, tg2 = t2 >> 7, k2 = t2 & 127;
                    const int ch = h * 128 + k2;
                    const float lbv = l_ == 0 ? 0.f : __builtin_amdgcn_rcpf(1.f + fexp(lb_logits[ch] - lb_logits[512 + ch]));
                    { float zc[16]; hg_load(PROJ, row0, tvalid, h, tg2, k2, 2048, zc);
                      if (ph == 0) hg_h1(lds, PROJ, zc, row0, tvalid, h, lbv, dsOut, ddOut, s0, t2, lane2, wave);
                      if (ph == 2 || it >= 1024) hg_h3(lds, PROJ, zc, row0, tvalid, h, lbv, Ssrc, it < 1024, hgain, MIX, t2, lane2, wave); }
                    cur = nxt;
                }
#undef HG_DECODE
#undef HG_MAP
                if (ph == 0) { unsigned char* w2 = ws; float* o2 = out; int l2 = l; OPQP(unsigned char, w2); OPQP(float, o2); OPQ(l2);
                    const unsigned long long* tab2 = (const unsigned long long*)w2; unsigned* ctr2 = (unsigned*)(w2 + WS_CTR) + 2 * l2 + 1;
                    unsigned wq = 0; if (lane == 0) wq = atomicAdd(ctr2, 1u); int w = __builtin_amdgcn_readfirstlane(wq);
                    while (w < 4352) { unsigned wn = 0; if (lane == 0) wn = atomicAdd(ctr2, 1u);
                        int lane2 = lane; asm volatile("" : "+v"(lane2));
                        if (w < 256) sb_item<true>(4096 + w, l2, (const float*)(w2 + WS_PROJ), o2 + O_KP + (size_t)l2 * NPROMPT * 512, o2 + O_VP + (size_t)l2 * NPROMPT * 512,
                                                    o2 + O_KS + (size_t)l2 * 262144, o2 + O_VS + (size_t)l2 * 262144, GPTR(tab2[3]), GPTR(tab2[4]), (const bf16_t*)(w2 + WS_VT), (const bf16_t*)(w2 + WS_KB), (float*)(w2 + WS_OSB), lane2);
                        else sb_item<false>(w - 256, l2, (const float*)(w2 + WS_PROJ), o2 + O_KP + (size_t)l2 * NPROMPT * 512, o2 + O_VP + (size_t)l2 * NPROMPT * 512,
                                                    o2 + O_KS + (size_t)l2 * 262144, o2 + O_VS + (size_t)l2 * 262144, GPTR(tab2[3]), GPTR(tab2[4]), (const bf16_t*)(w2 + WS_VT), (const bf16_t*)(w2 + WS_KB), (float*)(w2 + WS_OSB), lane2);
                        w = __builtin_amdgcn_readfirstlane(wn); } }
            } else {
                if (wave < 4) {
                    for (int p = bid * 256 + tid; p < 65536; p += G * 256) { const int e = 2 * p, bh = e >> 14, rem = e & 16383, k = rem & 127, v = rem >> 7;
                        unsigned* dsp = (unsigned*)(DS + (size_t)(bh * 128) * 16384) + (rem >> 1); const float* ddp = DD + (size_t)(bh * 128) * 128 + k;
                        float S0 = 0.f, S1 = 0.f;
                        for (int c = 0; c < 128; c += 16) { unsigned x[16]; f32x2_t d[16];
#pragma unroll
                            for (int u = 0; u < 16; ++u) { x[u] = dsp[(size_t)(c + u) * 16384]; d[u] = *(const f32x2_t*)(ddp + (c + u) * 128); }
#pragma unroll
                            for (int u = 0; u < 16; ++u) { dsp[(size_t)(c + u) * 16384] = pk2(S0, S1);
                                S0 = d[u].x * S0 + __uint_as_float(x[u] << 16); S1 = d[u].y * S1 + __uint_as_float(x[u] & 0xffff0000u); } }
                        float* op = o_ + O_HP + (size_t)l_ * 131072 + (size_t)bh * 16384 + k * 128 + v; op[0] = S0; op[128] = S1; }
                } else {
                    const float* sbg = GPTR(tab[11]) + l_ * 512; const int NW4 = G * 4;
                    const f32x4 ga = *(const f32x4*)(sbg + lane * 8), gb = *(const f32x4*)(sbg + lane * 8 + 4);
                    int m = bid * 4 + (wave - 4); u32x4 ra = {0u, 0u, 0u, 0u};
                    if (m < M_ALL) ra = *(const u32x4*)((const bf16_t*)OSB + (size_t)m * 512 + lane * 8);
                    while (m < M_ALL) { const int mn = m + NW4; u32x4 rn = ra;
                        if (mn < M_ALL) rn = *(const u32x4*)((const bf16_t*)OSB + (size_t)mn * 512 + lane * 8);
                        const f32x4 a = {__uint_as_float(ra.x << 16), __uint_as_float(ra.x & 0xffff0000u), __uint_as_float(ra.y << 16), __uint_as_float(ra.y & 0xffff0000u)};
                        const f32x4 b = {__uint_as_float(ra.z << 16), __uint_as_float(ra.z & 0xffff0000u), __uint_as_float(ra.w << 16), __uint_as_float(ra.w & 0xffff0000u)};
                        float ss = ((a[0] * a[0] + a[1] * a[1]) + (a[2] * a[2] + a[3] * a[3])) + ((b[0] * b[0] + b[1] * b[1]) + (b[2] * b[2] + b[3] * b[3]));
                        ss = wave_sum(ss); const float rs = rsqrtf(ss * (1.0f / 512.0f) + 1e-6f);
                        *(u32x4*)(MIX + (size_t)m * 1024 + lane * 8) = (u32x4){pk2(a[0] * rs * ga[0], a[1] * rs * ga[1]), pk2(a[2] * rs * ga[2], a[3] * rs * ga[3]),
                                                                              pk2(b[0] * rs * gb[0], b[1] * rs * gb[1]), pk2(b[2] * rs * gb[2], b[3] * rs * gb[3])};
                        ra = rn; m = mn; } }
            }
            GRID_BAR();
        }
#pragma nounroll
        for (int st = 0; st < 3; ++st) {
            { WAVE_IDS; unsigned char* w_ = ws; int l_ = l; OPQP(unsigned char, w_); OPQ(l_);
              const unsigned long long* tab = (const unsigned long long*)w_; unsigned char* wl = w_ + WS_W0 + (size_t)l_ * WS_WL;
              float* X = (float*)(w_ + WS_X);
              const bf16_t* A = (const bf16_t*)(w_ + (st == 0 ? WS_MIX : (st == 1 ? WS_OM : WS_H))); const bf16_t* Bt = (const bf16_t*)(wl + (st == 0 ? W_OUT : (st == 1 ? W_MO : W_2)));
              const int K = st == 0 ? 1024 : (st == 1 ? 512 : 4096);
              { Gemm g{A, Bt, NPROMPT, 1024, K, 0};
                EpiResid E{(st == 0 && l_ == 0) ? FPTR(tab[0]) : nullptr, nullptr, (st == 2 && l_ == 1) ? X : nullptr, (bf16_t*)(w_ + WS_XB), (float*)(w_ + WS_SSQ)};
                StaticOrder S; S.init(NPROMPT, 1024, G, bid);
                gemm_phase<EpiResid, StaticOrder, true, true>(lds, g, S, E); }
              { Gemm g{A, Bt, M_ALL, 1024, 256, K};
                EpiPart E{(float*)(w_ + WS_PART)};
                SplitOrder S; S.init(2, 1024, K / 256, G, bid, 64);
                gemm_phase<EpiPart, SplitOrder, true, true>(lds, g, S, E); } }
            GRID_BAR();
            { WAVE_IDS; unsigned char* w_ = ws; int l_ = l; OPQP(unsigned char, w_); OPQ(l_);
              const unsigned long long* tab = (const unsigned long long*)w_; const int nS = (st == 0 ? 1024 : (st == 1 ? 512 : 4096)) / 256;
              float* X = (float*)(w_ + WS_X); bf16_t* XB = (bf16_t*)(w_ + WS_XB); float* SSQ = (float*)(w_ + WS_SSQ); const float* PART = (const float*)(w_ + WS_PART);
              const float* bs = (st == 0 && l_ == 0) ? FPTR(tab[1]) : nullptr; const bool lastx = (st == 2 && l_ == 1);
              LAS float* red = (LAS float*)lds;
              for (int mb = bid; mb < 256; mb += G) { const int m = mb * 2 + (wave >> 2), cq = wave & 3, col = cq * 256 + lane * 4;
                  f32x4 v; if (bs) v = *(const f32x4*)(bs + (size_t)m * 1024 + col); else { const u32x2 r = *(const u32x2*)(XB + (size_t)(NPROMPT + m) * 1024 + col); v = (f32x4){__uint_as_float(r.x << 16), __uint_as_float(r.x & 0xffff0000u), __uint_as_float(r.y << 16), __uint_as_float(r.y & 0xffff0000u)}; }
                  f32x4 pp[16];
#pragma unroll
                  for (int ks = 0; ks < 16; ++ks) { const int kc = ks < nS ? ks : 0; pp[ks] = *(const f32x4*)(PART + ((size_t)kc * 512 + m) * 1024 + col); }
#pragma unroll
                  for (int ks = 0; ks < 16; ++ks) { const float on = ks < nS ? 1.f : 0.f; v += pp[ks] * on; }
                  if (lastx) *(f32x4*)(X + (size_t)(NPROMPT + m) * 1024 + col) = v;
                  u32x2 w; w.x = pk2(v[0], v[1]); w.y = pk2(v[2], v[3]); *(u32x2*)(XB + (size_t)(NPROMPT + m) * 1024 + col) = w;
                  float s = wave_sum((v[0] * v[0] + v[1] * v[1]) + (v[2] * v[2] + v[3] * v[3]));
                  if (lane == 0) red[wave] = s;
                  __syncthreads();
                  if (cq == 0 && lane == 0) ((float*)(w_ + WS_RSTD))[NPROMPT + m] = rsqrtf(((red[wave] + red[wave + 1]) + (red[wave + 2] + red[wave + 3])) * (1.0f / 1024.0f) + 1e-6f);
                  __syncthreads(); }
              if (tid < 64) for (int r = bid * 64 + tid; r < NPROMPT; r += G * 64) ((float*)(w_ + WS_RSTD))[r] = row_rstd(SSQ, r); }
            GRID_BAR();
            if (st < 2) {
                WAVE_IDS; unsigned char* w_ = ws; int l_ = l; OPQP(unsigned char, w_); OPQ(l_); unsigned char* wl = w_ + WS_W0 + (size_t)l_ * WS_WL;
                Gemm g; EpiBf16S E;
                if (st == 0) { g = Gemm{(const bf16_t*)(w_ + WS_XB), (const bf16_t*)(wl + W_MQ), M_ALL, 512, 1024}; E = EpiBf16S{(bf16_t*)(w_ + WS_QM), 512, (const float*)(w_ + WS_RSTD), 0.08838834764831845f, 0}; }
                else { g = Gemm{(const bf16_t*)(w_ + WS_XB), (const bf16_t*)(wl + W_1), M_ALL, 4096, 1024}; E = EpiBf16S{(bf16_t*)(w_ + WS_H), 4096, (const float*)(w_ + WS_RSTD), 1.0f, 1}; }
                StaticOrder S; S.init(M_ALL, g.N, G, bid);
                gemm_phase<EpiBf16S, StaticOrder, true, true>(lds, g, S, E);
                if (st == 0 && l_ == 0 && bid >= 132 && G == 256) {
                    const unsigned long long* tabc = (const unsigned long long*)w_; LAS float* scr = (LAS float*)(lds + wave * 16384);
#define TABP(i) FPTR(tabc[i])
                    for (int j = (bid - 132) * 8 + wave; j < 6912; j += 124 * 8) CONV_ITEM(TABP, 1, j < 2560 ? j : j + 512, w_);
#undef TABP
                }
                GRID_BAR();
            }
            if (st == 0) {
                WAVE_IDS; unsigned char* w_ = ws; float* o_ = out; int l_ = l; OPQP(unsigned char, w_); OPQP(float, o_); OPQ(l_);
                const unsigned long long* tab = (const unsigned long long*)w_; const float* cache_mk = GPTR(tab[6]); const float* cache_mv = GPTR(tab[7]);
                const bf16_t* QM = (const bf16_t*)(w_ + WS_QM); bf16_t* OM = (bf16_t*)(w_ + WS_OM);
                for (int it = bid; it < 1152; it += G) {
                    int row0, tvalid, hm; const float* Kg; const float* Vg; const bf16_t* Kb = nullptr; const bf16_t* Vtb = nullptr;
                    if (it < 1024) { const int tt = it >> 2; hm = it & 3; row0 = tt * 64; tvalid = 64; const int b = tt >> 7;
                        Kb = (const bf16_t*)(w_ + WS_MKB) + (size_t)((l_ * 2 + b) * 4 + hm) * 32768; Vtb = (const bf16_t*)(w_ + WS_MVT) + (size_t)((l_ * 2 + b) * 4 + hm) * 32768;
                        Kg = o_ + O_MKP + (size_t)(l_ * 2 + b) * 131072 + hm * 128; Vg = o_ + O_MVP + (size_t)(l_ * 2 + b) * 131072 + hm * 128; }
                    else { const int si = it - 1024, s = si >> 2; hm = si & 3; row0 = NPROMPT + 16 * s; tvalid = 16;
                        Kg = cache_mk + (size_t)(l_ * 32 + s) * 131072 + hm * 128; Vg = cache_mv + (size_t)(l_ * 32 + s) * 131072 + hm * 128; }
                    int t2 = tid; asm volatile("" : "+v"(t2));
                    xattn_item(lds, QM, Kg, Vg, Kb, Vtb, row0, tvalid, hm, OM, t2, t2 & 63, wave);
                }
                GRID_BAR();
            }
        }
    }
    { WAVE_IDS; unsigned char* w_ = ws; float* o_ = out; OPQP(unsigned char, w_); OPQP(float, o_);
      const float* nf = GPTR(((const unsigned long long*)w_)[23]); const float* X = (const float*)(w_ + WS_X);
      for (int m0 = gw; m0 < M_ALL; m0 += 2 * NGW) { const int m1 = (m0 + NGW < M_ALL) ? m0 + NGW : m0;
          const f32x4* xa = (const f32x4*)(X + (size_t)m0 * 1024) + lane; const f32x4* xb = (const f32x4*)(X + (size_t)m1 * 1024) + lane; f32x4 va[4], vb[4]; float sa = 0.f, sb = 0.f;
#pragma unroll
          for (int j = 0; j < 4; ++j) { va[j] = xa[64 * j]; vb[j] = xb[64 * j]; }
#pragma unroll
          for (int j = 0; j < 4; ++j) { sa += (va[j][0] * va[j][0] + va[j][1] * va[j][1]) + (va[j][2] * va[j][2] + va[j][3] * va[j][3]); sb += (vb[j][0] * vb[j][0] + vb[j][1] * vb[j][1]) + (vb[j][2] * vb[j][2] + vb[j][3] * vb[j][3]); }
          sa = wave_sum(sa); sb = wave_sum(sb); const float ra = rsqrtf(sa * (1.0f / 1024.0f) + 1e-6f), rb = rsqrtf(sb * (1.0f / 1024.0f) + 1e-6f);
          f32x4* ya = (f32x4*)(o_ + (m0 < NPROMPT ? O_YP + (size_t)m0 * 1024 : O_YS + (size_t)(m0 - NPROMPT) * 1024)) + lane;
          f32x4* yb = (f32x4*)(o_ + (m1 < NPROMPT ? O_YP + (size_t)m1 * 1024 : O_YS + (size_t)(m1 - NPROMPT) * 1024)) + lane;
#pragma unroll
          for (int j = 0; j < 4; ++j) { const f32x4 g = *((const f32x4*)nf + lane + 64 * j); ya[64 * j] = va[j] * ra * g; if (m1 != m0) yb[64 * j] = vb[j] * rb * g; } } }
}

extern "C" void kernel_launch(void* const* d_in, const int* in_sizes, int n_in, void* d_out, int out_size, void* d_ws, size_t ws_size, hipStream_t stream) {
    static int grid = 0;
    if (grid == 0) {
        int dev = 0, cus = 0, per_cu = 0;
        (void)hipGetDevice(&dev); (void)hipDeviceGetAttribute(&cus, hipDeviceAttributeMultiprocessorCount, dev);
        if (hipFuncSetAttribute((const void*)mega_fwd, hipFuncAttributeMaxDynamicSharedMemorySize, LDS_BYTES) != hipSuccess) fprintf(stderr, "kernel_launch: hipFuncSetAttribute failed\n");
        if (hipOccupancyMaxActiveBlocksPerMultiprocessor(&per_cu, (const void*)mega_fwd, 512, LDS_BYTES) != hipSuccess || per_cu < 1) { fprintf(stderr, "kernel_launch: occupancy query says %d\n", per_cu); per_cu = 1; }
        (void)hipGetLastError();
        if (cus <= 0) cus = 256;
        grid = cus;
    }
    Args a{};
    for (int i = 0; i < 24; ++i) a.in[i] = (const float*)d_in[i];
    a.out = (float*)d_out; a.ws = (unsigned char*)d_ws;
    void* kargs[] = {&a};
    const hipError_t e = hipLaunchCooperativeKernel((const void*)mega_fwd, dim3(grid), dim3(512), kargs, LDS_BYTES, stream);
    if (e != hipSuccess) fprintf(stderr, "kernel_launch: cooperative launch failed: %s (grid %d)\n", hipGetErrorString(e), grid);
}
```

```cpp
#include <hip/hip_runtime.h>
#include <hip/hip_cooperative_groups.h>
#include <cstdio>
#include <cstdint>
namespace cg = cooperative_groups;
namespace pg8 {
#define PG8_LAS __attribute__((address_space(3)))
typedef unsigned short bf16_t;
typedef short bf16x8 __attribute__((ext_vector_type(8)));
typedef float f32x4 __attribute__((ext_vector_type(4)));
typedef unsigned u32x4 __attribute__((ext_vector_type(4)));
constexpr int BM = 256, BK = 64, HALF = 128, HTB = HALF * BK * 2  , STAGE_BYTES = 8 * HTB, NXCD = 8, WGM = 8;

__host__ __device__ __forceinline__ int lds_byte(int r, int c) { const int st = (r >> 4) * 2 + (c >> 5), rr = r & 15, cc = c & 31, ob = rr * 64 + cc * 2; return st * 1024 + (ob ^ (((ob >> 9) & 1) << 5)); }
__host__ __device__ __forceinline__ void stage_rc(int b, int& R, int& C) { const int st = b / 1024, sb = b % 1024, swz = sb ^ (((sb >> 9) & 1) << 5); R = (st >> 1) * 16 + swz / 64; C = (st & 1) * 32 + (swz % 64) / 2; }
__host__ __device__ __forceinline__ int perm32(int rho) { const int n = rho >> 4, i = rho & 15; return 8 * (i >> 2) + 4 * n + (i & 3); }

struct Unit { int pm, pn, ks; };
struct Gemm { const bf16_t* A; const bf16_t* Bt; int M, N, K, ld; };

struct StaticOrder {
    int nM, nN, nwg, G, c;
    __host__ __device__ void init(int M, int N, int G_, int c_) { nM = M / BM; nN = N / BM; nwg = nM * nN; G = G_; c = c_; }
    __host__ __device__ bool next(int i, Unit& u) const {
        const long L = (long)i * G + c; if (L >= nwg) return false;
        int wgid = (int)L; { const int q = nwg / NXCD, r = nwg % NXCD, xcd = wgid % NXCD, off = wgid / NXCD; wgid = (xcd < r ? xcd * (q + 1) : r * (q + 1) + (xcd - r) * q) + off; }
        const int nig = WGM * nN, gid = wgid / nig, fm = gid * WGM, gsz = (nM - fm) < WGM ? (nM - fm) : WGM;
        u.pm = fm + ((wgid % nig) % gsz); u.pn = (wgid % nig) / gsz; u.ks = 0; return true;
    }
    __device__ __forceinline__ void a_ready(const Unit&) const {}
    __device__ __forceinline__ void done(const Unit&) const {}
};
struct SplitOrder {
    int nN, nS, nwg, G, c, pm0;
    __host__ __device__ void init(int nMs, int N, int nS_, int G_, int c_, int pm0_) { nN = N / BM; nS = nS_; nwg = nMs * nN * nS; G = G_; c = c_; pm0 = pm0_; }
    __host__ __device__ bool next(int i, Unit& u) const { const long L = (long)i * G + c; if (L >= nwg) return false; const int t = (int)L / nS; u.ks = (int)L % nS; u.pn = t % nN; u.pm = pm0 + t / nN; return true; }
    __device__ __forceinline__ void a_ready(const Unit&) const {}
    __device__ __forceinline__ void done(const Unit&) const {}
};
__device__ __forceinline__ unsigned cvt_pk_bf16(float lo, float hi) { unsigned r; asm volatile("v_cvt_pk_bf16_f32 %0, %1, %2" : "=v"(r) : "v"(lo), "v"(hi)); return r; }
typedef float f32x2 __attribute__((ext_vector_type(2)));
typedef unsigned u32x2 __attribute__((ext_vector_type(2)));
constexpr int NPROMPT = 16384;
constexpr size_t O_YP = 0, O_YS = 16777216, O_KP = 17301504, O_VP = 34078720, O_HP = 50855936, O_MKP = 51118080, O_MVP = 51642368,
                 O_KS = 52166656, O_VS = 52690944, O_HS = 53215232;
__device__ __forceinline__ float row_rstd(const float* ssq, int row) {
    const f32x4* p = (const f32x4*)(ssq + (size_t)row * 16);
    const f32x4 a = p[0], b = p[1], c = p[2], d = p[3];
    const float s = (((a[0] + a[1]) + (a[2] + a[3])) + ((b[0] + b[1]) + (b[2] + b[3]))) + (((c[0] + c[1]) + (c[2] + c[3])) + ((d[0] + d[1]) + (d[2] + d[3])));
    return rsqrtf(s * (1.0f / 1024.0f) + 1e-6f);
}
struct EpiF32 {
    static constexpr bool PERM = true, AFTER_DRAIN = false;
    int mode; const float* rstd; float* proj; float* outp; int l; bf16_t* vt; bf16_t* kb;
    __device__ __forceinline__ void operator()(const f32x4 (&acc)[2][2][4][2], const Unit& u, int wr, int wc, int fr_, int fq_) const {
        int tq = threadIdx.x; asm volatile("" : "+v"(tq)); const int fr = tq & 15, fq = (tq >> 4) & 3;
        float* base; int pitch, colt, rsub = 0; const int pn = u.pn;
        if (mode == 0) {
            if (pn >= 2 && pn < 6) { const size_t isv = pn >= 4 ? 1 : 0; colt = (pn & 1) * 256; pitch = 512;
                if (u.pm < 64) base = outp + (O_KP + isv * (O_VP - O_KP) + (size_t)l * NPROMPT * 512);
                else { base = outp + (O_KS + isv * (O_VS - O_KS) + (size_t)l * 262144); rsub = NPROMPT; } }
            else { base = proj; pitch = 3584; colt = pn * 256; }
        } else { const size_t sel = (size_t)(pn >> 1); base = outp + (O_MKP + (sel & 1) * (O_MVP - O_MKP) + (sel >> 1) * 262144); pitch = 512; colt = (pn & 1) * 256; }
        const int col0 = colt + wc * 32 + 8 * fq, rowb = u.pm * BM + wr * 64 + fr;
        float rs[2][4];
#pragma unroll
        for (int ai = 0; ai < 2; ++ai)
#pragma unroll
            for (int m = 0; m < 4; ++m) rs[ai][m] = rstd[rowb + ai * HALF + m * 16];
#pragma unroll
        for (int ai = 0; ai < 2; ++ai)
#pragma unroll
            for (int m = 0; m < 4; ++m) { const int row = rowb + ai * HALF + m * 16;
                if (base == proj && mode == 0) {
                    const float sc = rs[ai][m] * (pn < 2 ? 0.125f : 1.0f); bf16_t* bp_ = (bf16_t*)proj + (size_t)row * 3584 + col0;
#pragma unroll
                    for (int bj = 0; bj < 2; ++bj) { const f32x4 v0 = acc[ai][bj][m][0] * sc, v1 = acc[ai][bj][m][1] * sc;
                        u32x4 w; w.x = cvt_pk_bf16(v0[0], v0[1]); w.y = cvt_pk_bf16(v0[2], v0[3]); w.z = cvt_pk_bf16(v1[0], v1[1]); w.w = cvt_pk_bf16(v1[2], v1[3]); *(u32x4*)(bp_ + bj * HALF) = w; }
                } else {
                float* rp = base + (size_t)(row - rsub) * pitch + col0;
#pragma unroll
                for (int bj = 0; bj < 2; ++bj)
#pragma unroll
                    for (int n = 0; n < 2; ++n) *(f32x4*)(rp + bj * HALF + n * 4) = acc[ai][bj][m][n] * rs[ai][m]; } }
        if (mode == 1) {
            const int sel = pn >> 1, lyr = sel >> 1, isv = sel & 1, bb = u.pm;
#pragma unroll
            for (int ai = 0; ai < 2; ++ai)
#pragma unroll
                for (int m = 0; m < 4; ++m) { const int row = rowb + ai * HALF + m * 16, mm = row & 255;
#pragma unroll
                    for (int bj = 0; bj < 2; ++bj) { const f32x4 v0 = acc[ai][bj][m][0] * rs[ai][m], v1 = acc[ai][bj][m][1] * rs[ai][m]; const int c = col0 + bj * HALF, hh = c >> 7, d0 = c & 127;
                        const unsigned p0 = cvt_pk_bf16(v0[0], v0[1]), p1 = cvt_pk_bf16(v0[2], v0[3]), p2 = cvt_pk_bf16(v1[0], v1[1]), p3 = cvt_pk_bf16(v1[2], v1[3]);
                        const size_t hb = (size_t)((lyr * 2 + bb) * 4 + hh) * 32768;
                        if (!isv) { u32x4 w; w.x = p0; w.y = p1; w.z = p2; w.w = p3; *(u32x4*)(kb + hb + (size_t)mm * 128 + d0) = w; }
                        else { bf16_t* q = vt + hb + (size_t)d0 * 256 + mm;
                            q[0] = (bf16_t)(p0 & 0xffffu); q[256] = (bf16_t)(p0 >> 16); q[512] = (bf16_t)(p1 & 0xffffu); q[768] = (bf16_t)(p1 >> 16);
                            q[1024] = (bf16_t)(p2 & 0xffffu); q[1280] = (bf16_t)(p2 >> 16); q[1536] = (bf16_t)(p3 & 0xffffu); q[1792] = (bf16_t)(p3 >> 16); } } }
        }
        if (mode == 0 && pn >= 2 && pn < 4 && u.pm < 64) {
#pragma unroll
            for (int ai = 0; ai < 2; ++ai)
#pragma unroll
                for (int m = 0; m < 4; ++m) { const int row = rowb + ai * HALF + m * 16, t = row & 8191;
#pragma unroll
                    for (int bj = 0; bj < 2; ++bj) { const f32x4 v0 = acc[ai][bj][m][0] * rs[ai][m], v1 = acc[ai][bj][m][1] * rs[ai][m]; const int c = col0 + bj * HALF, hh = c >> 6, d0 = c & 63;
                        u32x4 w; w.x = cvt_pk_bf16(v0[0], v0[1]); w.y = cvt_pk_bf16(v0[2], v0[3]); w.z = cvt_pk_bf16(v1[0], v1[1]); w.w = cvt_pk_bf16(v1[2], v1[3]);
                        *(u32x4*)(kb + ((((size_t)((row >> 13) * 8 + hh) * 256 + (t >> 5)) * 8 + (d0 >> 3)) * 32 + (t & 31)) * 8) = w; } }
        }
        if (mode == 0 && pn >= 4 && pn < 6 && u.pm < 64) {
            const int qi = fr & 3;
#pragma unroll
            for (int ai = 0; ai < 2; ++ai)
#pragma unroll
                for (int m = 0; m < 4; ++m) { const int row = rowb + ai * HALF + m * 16, t0 = (row & 8191) & ~3; const size_t tb = ((size_t)(row >> 13) * 8 * 2048 * 64 + (size_t)(t0 >> 2) * 64) * 4;
#pragma unroll
                    for (int bj = 0; bj < 2; ++bj)
#pragma unroll
                        for (int n = 0; n < 2; ++n) { const f32x4 v = acc[ai][bj][m][n] * rs[ai][m]; const int c = col0 + bj * HALF + n * 4;
                            const unsigned p01 = cvt_pk_bf16(v[0], v[1]), p23 = cvt_pk_bf16(v[2], v[3]);
                            const unsigned snd1 = (qi & 2) ? p01 : p23, kep1 = (qi & 2) ? p23 : p01, rcv1 = (unsigned)__shfl_xor((int)snd1, 2);
                            const unsigned q0 = (qi & 2) ? rcv1 : kep1, q2 = (qi & 2) ? kep1 : rcv1;
                            const unsigned los = (q0 & 0xffffu) | (q2 << 16), his = (q0 >> 16) | (q2 & 0xffff0000u);
                            const unsigned rcv2 = (unsigned)__shfl_xor((int)((qi & 1) ? los : his), 1), mine = (qi & 1) ? his : los;
                            u32x2 w;
                            if (qi & 1) { w.x = (rcv2 & 0xffffu) | (mine << 16); w.y = (rcv2 >> 16) | (mine & 0xffff0000u); }
                            else { w.x = (mine & 0xffffu) | (rcv2 << 16); w.y = (mine >> 16) | (rcv2 & 0xffff0000u); }
                            const int cc = c + (qi & 2) + (qi & 1), hh = cc >> 6, dd = cc & 63;
                            *(u32x2*)(vt + tb + ((size_t)hh * 2048 * 64 + dd) * 4) = w; } }
        }
    }
};
struct EpiResid {
    static constexpr bool PERM = true, AFTER_DRAIN = false;
    const float* bp; const float* bs; float* X; bf16_t* XB; float* ssq;
    __device__ __forceinline__ void operator()(const f32x4 (&acc)[2][2][4][2], const Unit& u, int wr, int wc, int fr_, int fq_) const {
        int tq = threadIdx.x; asm volatile("" : "+v"(tq)); const int fr = tq & 15, fq = (tq >> 4) & 3;
        const int col0 = u.pn * BM + wc * 32 + 8 * fq;
#pragma unroll
        for (int ai = 0; ai < 2; ++ai) {
            f32x4 res[4][2][2];
            if (bp) {
#pragma unroll
                for (int m = 0; m < 4; ++m) { const int row = u.pm * BM + ai * HALF + wr * 64 + m * 16 + fr; const float* br = bp + (size_t)row * 1024 + col0;
#pragma unroll
                    for (int bj = 0; bj < 2; ++bj) { res[m][bj][0] = *(const f32x4*)(br + bj * HALF); res[m][bj][1] = *(const f32x4*)(br + bj * HALF + 4); } }
            } else { u32x4 rb[4][2];
#pragma unroll
                for (int m = 0; m < 4; ++m) { const int row = u.pm * BM + ai * HALF + wr * 64 + m * 16 + fr; const bf16_t* br = XB + (size_t)row * 1024 + col0;
#pragma unroll
                    for (int bj = 0; bj < 2; ++bj) rb[m][bj] = *(const u32x4*)(br + bj * HALF); }
#pragma unroll
                for (int m = 0; m < 4; ++m)
#pragma unroll
                    for (int bj = 0; bj < 2; ++bj) { const u32x4 r = rb[m][bj];
                        res[m][bj][0] = (f32x4){__uint_as_float(r.x << 16), __uint_as_float(r.x & 0xffff0000u), __uint_as_float(r.y << 16), __uint_as_float(r.y & 0xffff0000u)};
                        res[m][bj][1] = (f32x4){__uint_as_float(r.z << 16), __uint_as_float(r.z & 0xffff0000u), __uint_as_float(r.w << 16), __uint_as_float(r.w & 0xffff0000u)}; } }
            asm volatile("" ::: "memory");
#pragma unroll
            for (int m = 0; m < 4; ++m) { const int row = u.pm * BM + ai * HALF + wr * 64 + m * 16 + fr;
                bf16_t* xb = XB + (size_t)row * 1024 + col0; float ss = 0.f;
#pragma unroll
                for (int bj = 0; bj < 2; ++bj) { const f32x4 v0 = acc[ai][bj][m][0] + res[m][bj][0], v1 = acc[ai][bj][m][1] + res[m][bj][1];
                    if (X) { float* xr = X + (size_t)row * 1024 + col0; *(f32x4*)(xr + bj * HALF) = v0; *(f32x4*)(xr + bj * HALF + 4) = v1; }
                    ss += ((v0[0] * v0[0] + v0[1] * v0[1]) + (v0[2] * v0[2] + v0[3] * v0[3])) + ((v1[0] * v1[0] + v1[1] * v1[1]) + (v1[2] * v1[2] + v1[3] * v1[3]));
                    u32x4 w; w.x = cvt_pk_bf16(v0[0], v0[1]); w.y = cvt_pk_bf16(v0[2], v0[3]); w.z = cvt_pk_bf16(v1[0], v1[1]); w.w = cvt_pk_bf16(v1[2], v1[3]); *(u32x4*)(xb + bj * HALF) = w; }
                ss += __shfl_xor(ss, 16); ss += __shfl_xor(ss, 32);
                if (fq == 0) ssq[(size_t)row * 16 + u.pn * 4 + wc] = ss; }
            asm volatile("" ::: "memory"); }
    }
};
struct EpiBf16S {
    static constexpr bool PERM = true, AFTER_DRAIN = false;
    bf16_t* O; int ldc; const float* rstd; float scale; int act;
    __device__ __forceinline__ void operator()(const f32x4 (&acc)[2][2][4][2], const Unit& u, int wr, int wc, int fr_, int fq_) const {
        int tq = threadIdx.x; asm volatile("" : "+v"(tq)); const int fr = tq & 15, fq = (tq >> 4) & 3;
        const int col0 = u.pn * BM + wc * 32 + 8 * fq, rowb = u.pm * BM + wr * 64 + fr;
        float rs[2][4];
#pragma unroll
        for (int ai = 0; ai < 2; ++ai)
#pragma unroll
            for (int m = 0; m < 4; ++m) rs[ai][m] = rstd[rowb + ai * HALF + m * 16];
#pragma unroll
        for (int ai = 0; ai < 2; ++ai)
#pragma unroll
            for (int m = 0; m < 4; ++m) { const int row = rowb + ai * HALF + m * 16; const float r1 = rs[ai][m];
                bf16_t* rowp = O + (size_t)row * ldc + col0;
#pragma unroll
                for (int bj = 0; bj < 2; ++bj) { f32x4 v0 = acc[ai][bj][m][0] * r1, v1 = acc[ai][bj][m][1] * r1;
                    if (act == 1) { v0 = __builtin_elementwise_max(v0, (f32x4){0.f, 0.f, 0.f, 0.f}); v1 = __builtin_elementwise_max(v1, (f32x4){0.f, 0.f, 0.f, 0.f}); v0 = v0 * v0; v1 = v1 * v1; }
                    v0 = v0 * scale; v1 = v1 * scale;
                    u32x4 w; w.x = cvt_pk_bf16(v0[0], v0[1]); w.y = cvt_pk_bf16(v0[2], v0[3]); w.z = cvt_pk_bf16(v1[0], v1[1]); w.w = cvt_pk_bf16(v1[2], v1[3]);
                    *(u32x4*)(rowp + bj * HALF) = w; } }
    }
};
struct EpiPart {
    static constexpr bool PERM = true, AFTER_DRAIN = false;
    float* part;
    __device__ __forceinline__ void operator()(const f32x4 (&acc)[2][2][4][2], const Unit& u, int wr, int wc, int fr_, int fq_) const {
        int tq = threadIdx.x; asm volatile("" : "+v"(tq)); const int fr = tq & 15, fq = (tq >> 4) & 3;
        const int col0 = u.pn * BM + wc * 32 + 8 * fq;
#pragma unroll
        for (int ai = 0; ai < 2; ++ai)
#pragma unroll
            for (int m = 0; m < 4; ++m) { const int row = (u.pm - 64) * BM + ai * HALF + wr * 64 + m * 16 + fr;
                float* rp = part + ((size_t)u.ks * 512 + row) * 1024 + col0;
#pragma unroll
                for (int bj = 0; bj < 2; ++bj)
#pragma unroll
                    for (int n = 0; n < 2; ++n) *(f32x4*)(rp + bj * HALF + n * 4) = acc[ai][bj][m][n];
                asm volatile("" ::: "memory"); }
    }
};
template <class Epi, class Sched, bool ALIGN_EPI = false, bool SP2 = false>
__device__ __forceinline__ void gemm_phase(PG8_LAS unsigned char* lds, const Gemm g, const Sched& S, const Epi& E) {
    int tid_ = threadIdx.x; asm volatile("" : "+v"(tid_));
    const int tid = tid_, wid = __builtin_amdgcn_readfirstlane(tid >> 6), lane = tid & 63, wr = wid >> 2, wc = wid & 3, fr = lane & 15, fq = lane >> 4;
    const int K = g.ld ? g.ld : g.K, nt = g.K / BK;
    unsigned voffA[2], voffB[2];
#pragma unroll
    for (int i = 0; i < 2; ++i) { int R, C; stage_rc(tid * 16 + i * 8192, R, C); const int Rb = Epi::PERM ? ((R & ~31) + perm32(R & 31)) : R;
        voffA[i] = (unsigned)(R * K + C) * 2u; voffB[i] = (unsigned)(Rb * K + C) * 2u; }
    const size_t kstep = (size_t)(BK * 2);
    const size_t hstep = (size_t)HALF * K * 2;
    const size_t tstep = 2 * hstep;
    const unsigned ldsw = (unsigned)wid * 1024u;
    const int aoff = lds_byte(wr * 64 + fr, fq * 8), boff = lds_byte(wc * 32 + fr, fq * 8);
#define PG8_SA(b, h) (((b) * 2 + (h)) * HTB)
#define PG8_SB(b, h) ((4 + (b) * 2 + (h)) * HTB)
#define PG8_STAGE(bufoff, gbase, voff) do { _Pragma("unroll") for (int _i = 0; _i < 2; ++_i) \
        __builtin_amdgcn_global_load_lds((const unsigned*)((const char*)(gbase) + (voff)[_i]), (PG8_LAS unsigned*)(lds + (bufoff) + ldsw + _i * 8192), 16, 0, 0); } while (0)
#define PG8_LDA(dst, b, h) do { _Pragma("unroll") for (int m = 0; m < 4; ++m) _Pragma("unroll") for (int k = 0; k < 2; ++k) dst[m][k] = *(const PG8_LAS bf16x8*)(lds + PG8_SA(b, h) + aoff + m * 2048 + k * 1024); } while (0)
#define PG8_LDB(dst, b, h) do { _Pragma("unroll") for (int n = 0; n < 2; ++n) _Pragma("unroll") for (int k = 0; k < 2; ++k) dst[n][k] = *(const PG8_LAS bf16x8*)(lds + PG8_SB(b, h) + boff + n * 2048 + k * 1024); } while (0)
#define PG8_MMA(ai, bj, At, Bt) do { __builtin_amdgcn_s_setprio(1); _Pragma("unroll") for (int m = 0; m < 4; ++m) _Pragma("unroll") for (int n = 0; n < 2; ++n) _Pragma("unroll") for (int k = 0; k < 2; ++k) \
        acc[ai][bj][m][n] = __builtin_amdgcn_mfma_f32_16x16x32_bf16(Bt[n][k], At[m][k], acc[ai][bj][m][n], 0, 0, 0); __builtin_amdgcn_s_setprio(0); } while (0)
#define PG8_WAIT_V(n) asm volatile("s_waitcnt vmcnt(" #n ")" ::: "memory")
#define PG8_WAIT_L(n) asm volatile("s_waitcnt lgkmcnt(" #n ")" ::: "memory")
#define PG8_BAR __builtin_amdgcn_s_barrier()
#define PG8_SCHED __builtin_amdgcn_sched_barrier(0)
    Unit cur, nxt; int ui = 0;
    if (!S.next(0, cur)) return;
    f32x4 acc[2][2][4][2];
#pragma unroll
    for (int a = 0; a < 2; ++a)
#pragma unroll
        for (int b = 0; b < 2; ++b)
#pragma unroll
            for (int m = 0; m < 4; ++m)
#pragma unroll
                for (int n = 0; n < 2; ++n) acc[a][b][m][n] = (f32x4){0.f, 0.f, 0.f, 0.f};
    bf16x8 At[4][2], B0[2][2], B1[2][2];
    const size_t sstep = (size_t)g.K * 2;
    const char* cA = (const char*)g.A + (size_t)cur.pm * tstep + (size_t)cur.ks * sstep; const char* cB = (const char*)g.Bt + (size_t)cur.pn * tstep + (size_t)cur.ks * sstep;
    S.a_ready(cur);
    if constexpr (SP2) {
        PG8_STAGE(PG8_SB(0, 0), cB, voffB); PG8_STAGE(PG8_SB(0, 1), cB + hstep, voffB); PG8_STAGE(PG8_SA(0, 0), cA, voffA); PG8_STAGE(PG8_SA(0, 1), cA + hstep, voffA);
        if (wr == 1) PG8_BAR;
        PG8_WAIT_V(2); PG8_BAR;
        PG8_STAGE(PG8_SB(1, 0), cB + kstep, voffB); PG8_STAGE(PG8_SA(1, 0), cA + kstep, voffA); PG8_STAGE(PG8_SB(1, 1), cB + hstep + kstep, voffB);
        PG8_WAIT_V(6); PG8_BAR;
    } else {
        PG8_STAGE(PG8_SB(0, 0), cB, voffB); PG8_STAGE(PG8_SA(0, 0), cA, voffA); PG8_STAGE(PG8_SB(0, 1), cB + hstep, voffB); PG8_STAGE(PG8_SA(0, 1), cA + hstep, voffA);
        if (wr == 1) PG8_BAR;
        PG8_WAIT_V(4); PG8_BAR;
        PG8_STAGE(PG8_SB(1, 0), cB + kstep, voffB); PG8_STAGE(PG8_SA(1, 0), cA + kstep, voffA); PG8_STAGE(PG8_SB(1, 1), cB + hstep + kstep, voffB);
        PG8_WAIT_V(6); PG8_BAR;
    }
    for (;;) {
        const bool has_next = S.next(ui + 1, nxt);
        const char* nA = has_next ? (const char*)g.A + (size_t)nxt.pm * tstep + (size_t)nxt.ks * sstep : cA; const char* nB = has_next ? (const char*)g.Bt + (size_t)nxt.pn * tstep + (size_t)nxt.ks * sstep : cB;
        for (int t = 0; t < nt; t += 2) {
            const bool last = (t == nt - 2);
            const char* a1 = cA + (size_t)(t + 1) * kstep;
            const char* a2 = last ? nA : cA + (size_t)(t + 2) * kstep; const char* b2 = last ? nB : cB + (size_t)(t + 2) * kstep;
            const char* a3 = a2 + kstep; const char* b3 = b2 + kstep;
            if (last && has_next) S.a_ready(nxt);
            if constexpr (SP2) {
            PG8_LDB(B0, 0, 0); PG8_LDB(B1, 0, 1); PG8_SCHED; PG8_LDA(At, 0, 0); PG8_STAGE(PG8_SA(1, 1), a1 + hstep, voffA);
            PG8_WAIT_V(8); PG8_WAIT_L(0); PG8_BAR; PG8_MMA(0, 0, At, B0); PG8_MMA(0, 1, At, B1); PG8_BAR; PG8_SCHED;
            PG8_LDA(At, 0, 1); PG8_STAGE(PG8_SB(0, 0), b2, voffB); PG8_STAGE(PG8_SB(0, 1), b2 + hstep, voffB); PG8_STAGE(PG8_SA(0, 0), a2, voffA);
            PG8_WAIT_V(8); PG8_WAIT_L(0); PG8_BAR; PG8_MMA(1, 0, At, B0); PG8_MMA(1, 1, At, B1); PG8_BAR; PG8_SCHED;
            PG8_LDB(B0, 1, 0); PG8_LDB(B1, 1, 1); PG8_SCHED; PG8_LDA(At, 1, 0); PG8_STAGE(PG8_SA(0, 1), a2 + hstep, voffA);
            PG8_WAIT_V(8); PG8_WAIT_L(0); PG8_BAR; PG8_MMA(0, 0, At, B0); PG8_MMA(0, 1, At, B1); PG8_BAR; PG8_SCHED;
            PG8_LDA(At, 1, 1); PG8_STAGE(PG8_SB(1, 0), b3, voffB); PG8_STAGE(PG8_SB(1, 1), b3 + hstep, voffB); PG8_STAGE(PG8_SA(1, 0), a3, voffA);
            PG8_WAIT_V(8); PG8_WAIT_L(0); PG8_BAR; PG8_MMA(1, 0, At, B0); PG8_MMA(1, 1, At, B1); PG8_BAR; PG8_SCHED;
            } else {
            PG8_LDB(B0, 0, 0); PG8_SCHED; PG8_LDA(At, 0, 0); PG8_STAGE(PG8_SA(1, 1), a1 + hstep, voffA);
            PG8_WAIT_L(8); PG8_BAR; PG8_WAIT_L(0); PG8_MMA(0, 0, At, B0); PG8_BAR; PG8_SCHED;
            PG8_LDB(B1, 0, 1); PG8_STAGE(PG8_SB(0, 0), b2, voffB);
            PG8_BAR; PG8_WAIT_L(0); PG8_MMA(0, 1, At, B1); PG8_BAR;
            PG8_LDA(At, 0, 1); PG8_STAGE(PG8_SA(0, 0), a2, voffA);
            PG8_BAR; PG8_WAIT_L(0); PG8_MMA(1, 0, At, B0); PG8_BAR; PG8_SCHED;
            PG8_STAGE(PG8_SB(0, 1), b2 + hstep, voffB);
            PG8_WAIT_V(6); PG8_BAR; PG8_MMA(1, 1, At, B1); PG8_BAR;
            PG8_LDB(B0, 1, 0); PG8_SCHED; PG8_LDA(At, 1, 0); PG8_STAGE(PG8_SA(0, 1), a2 + hstep, voffA);
            PG8_WAIT_L(8); PG8_BAR; PG8_WAIT_L(0); PG8_MMA(0, 0, At, B0); PG8_BAR; PG8_SCHED;
            PG8_LDB(B1, 1, 1); PG8_STAGE(PG8_SB(1, 0), b3, voffB);
            PG8_BAR; PG8_WAIT_L(0); PG8_MMA(0, 1, At, B1); PG8_BAR;
            PG8_LDA(At, 1, 1); PG8_STAGE(PG8_SA(1, 0), a3, voffA);
            PG8_BAR; PG8_WAIT_L(0); PG8_MMA(1, 0, At, B0); PG8_BAR; PG8_SCHED;
            PG8_STAGE(PG8_SB(1, 1), b3 + hstep, voffB);
            PG8_WAIT_V(6); PG8_BAR; PG8_MMA(1, 1, At, B1); PG8_BAR;
            }
        }
        if constexpr (ALIGN_EPI) { if (wr == 0) PG8_BAR; }
        if constexpr (!Epi::AFTER_DRAIN) { E(acc, cur, wr, wc, fr, fq); S.done(cur); }
        if (!has_next) break;
#pragma unroll
        for (int a = 0; a < 2; ++a)
#pragma unroll
            for (int b = 0; b < 2; ++b)
#pragma unroll
                for (int m = 0; m < 4; ++m)
#pragma unroll
                    for (int n = 0; n < 2; ++n) acc[a][b][m][n] = (f32x4){0.f, 0.f, 0.f, 0.f};
        cur = nxt; cA = nA; cB = nB; ++ui;
        if constexpr (ALIGN_EPI) { if (wr == 1) PG8_BAR; }
    }
    PG8_WAIT_V(0);
    if constexpr (!ALIGN_EPI) { if (wr == 0) PG8_BAR; }
    PG8_BAR;
    if constexpr (Epi::AFTER_DRAIN) { E.fused(acc, cur, wr, wc, fr, fq, lds, wid, lane); S.done(cur); }
#undef PG8_SA
#undef PG8_SB
#undef PG8_STAGE
#undef PG8_LDA
#undef PG8_LDB
#undef PG8_MMA
#undef PG8_WAIT_V
#undef PG8_WAIT_L
#undef PG8_BAR
#undef PG8_SCHED
}
}
using namespace pg8;
#define LAS __attribute__((address_space(3)))
typedef LAS unsigned char* ldsp;
typedef float f32x16 __attribute__((ext_vector_type(16)));
#define LDS_WAIT() asm volatile("s_waitcnt lgkmcnt(0)" ::: "memory")

constexpr int M_ALL = 16896;
constexpr int PLD = 3584;
constexpr size_t MiB = 1u << 20;
constexpr size_t WS_W0 = 2 * MiB, WS_WL = 32 * MiB;
constexpr size_t W_IN = 0, W_OUT = 7 * MiB, W_MQ = 9 * MiB, W_MO = 10 * MiB, W_1 = 11 * MiB, W_2 = 19 * MiB;
constexpr size_t WS_WMKV = 66 * MiB;
constexpr size_t WS_XB = 80 * MiB, WS_X = 128 * MiB, WS_SSQ = 196 * MiB, WS_MEMB = 198 * MiB, WS_MEMSSQ = 199 * MiB, WS_RSTD = 199 * MiB + 65536, WS_MEMRSTD = 199 * MiB + 196608;
constexpr size_t WS_PROJ = 256 * MiB, WS_OSB = 512 * MiB, WS_MIX = 560 * MiB, WS_DS = 608 * MiB, WS_DD = 672 * MiB;
constexpr size_t WS_QM = 688 * MiB, WS_OM = 720 * MiB, WS_H = 768 * MiB, WS_PART = 904 * MiB, WS_VT = 940 * MiB, WS_KB = 960 * MiB, WS_MKB = 980 * MiB, WS_MVT = 982 * MiB;
constexpr int LDS_BYTES = 147456;
constexpr size_t WS_BAR = 65536;
constexpr size_t WS_CTR = 65536 + 16384;
constexpr int LDS_BARST = 131072 + 1024;

__device__ __forceinline__ float wave_sum(float v) {
#pragma unroll
    for (int o = 1; o < 64; o <<= 1) v += __shfl_xor(v, o);
    return v;
}
typedef float f32x2_t __attribute__((ext_vector_type(2))); typedef __bf16 bf16x2_t __attribute__((ext_vector_type(2)));
__device__ __forceinline__ unsigned pk2(float lo, float hi) { const f32x2_t v = {lo, hi}; const bf16x2_t b = __builtin_convertvector(v, bf16x2_t); return __builtin_bit_cast(unsigned, b); }
__device__ __forceinline__ unsigned f2bf(float f) { return pk2(f, f) & 0xffffu; }
__device__ __forceinline__ bf16x8 pack8(float a, float b, float c, float d, float e, float f, float g, float h) { return __builtin_bit_cast(bf16x8, (u32x4){pk2(a, b), pk2(c, d), pk2(e, f), pk2(g, h)}); }
__device__ __forceinline__ float fexp(float x) { return __builtin_amdgcn_exp2f(x * 1.4426950408889634f); }
__device__ __forceinline__ float flog(float x) { return __builtin_amdgcn_logf(x) * 0.6931471805599453f; }
__device__ __forceinline__ int crow(int i, int hi) { return (i & 3) + 8 * (i >> 2) + 4 * hi; }
#define MFMA32(a, b, c) __builtin_amdgcn_mfma_f32_32x32x16_bf16((a), (b), (c), 0, 0, 0)
#define MFMA16(a, b, c) __builtin_amdgcn_mfma_f32_16x16x32_bf16((a), (b), (c), 0, 0, 0)

__device__ __forceinline__ void transpose_item(const float* W, int K, int N, bf16_t* WT, int row_off, const float* gain, LAS float* scr, int item, int lane) {
    const int nblk = N / 32, kb = item / nblk, nb = item % nblk, k0 = 64 * kb, n0 = 32 * nb;
    float wv[32], gv[32];
#pragma unroll
    for (int i = 0; i < 32; ++i) { const int kk = 2 * i + (lane >> 5); wv[i] = W[(size_t)(k0 + kk) * N + n0 + (lane & 31)]; gv[i] = gain ? gain[k0 + kk] : 1.f; }
#pragma unroll
    for (int i = 0; i < 32; ++i) { const int kk = 2 * i + (lane >> 5); scr[kk * 33 + (lane & 31)] = wv[i] * gv[i]; }
    LDS_WAIT(); asm volatile("" ::: "memory");
    const int c = lane & 7;
#pragma unroll
    for (int j = 0; j < 4; ++j) { const int n = (lane >> 3) + 8 * j; const LAS float* s = scr + (8 * c) * 33 + n;
        u32x4 o; o.x = pk2(s[0 * 33], s[1 * 33]); o.y = pk2(s[2 * 33], s[3 * 33]); o.z = pk2(s[4 * 33], s[5 * 33]); o.w = pk2(s[6 * 33], s[7 * 33]);
        *(u32x4*)(WT + (size_t)(row_off + n0 + n) * K + k0 + 8 * c) = o; }
    LDS_WAIT(); asm volatile("" ::: "memory");
}
__device__ __forceinline__ void row_prep2(const float* srcA, bf16_t* dstA, float* sqA, float* rsA, const float* srcB, bf16_t* dstB, float* sqB, float* rsB, bool hasB, int lane) {
    const f32x4* xa = (const f32x4*)srcA + lane; const f32x4* xb = (const f32x4*)srcB + lane; f32x4 va[4], vb[4]; float sa = 0.f, sb = 0.f;
#pragma unroll
    for (int j = 0; j < 4; ++j) { va[j] = xa[64 * j]; vb[j] = xb[64 * j]; }
#pragma unroll
    for (int j = 0; j < 4; ++j) { sa += (va[j][0] * va[j][0] + va[j][1] * va[j][1]) + (va[j][2] * va[j][2] + va[j][3] * va[j][3]); sb += (vb[j][0] * vb[j][0] + vb[j][1] * vb[j][1]) + (vb[j][2] * vb[j][2] + vb[j][3] * vb[j][3]); }
    sa = wave_sum(sa); sb = wave_sum(sb);
    u32x2* oa = (u32x2*)dstA + lane; u32x2* ob = (u32x2*)dstB + lane;
#pragma unroll
    for (int j = 0; j < 4; ++j) { u32x2 w; w.x = pk2(va[j][0], va[j][1]); w.y = pk2(va[j][2], va[j][3]); oa[64 * j] = w;
        if (hasB) { u32x2 w2; w2.x = pk2(vb[j][0], vb[j][1]); w2.y = pk2(vb[j][2], vb[j][3]); ob[64 * j] = w2; } }
    if (lane < 16) { sqA[lane] = lane == 0 ? sa : 0.f; if (hasB) sqB[lane] = lane == 0 ? sb : 0.f; }
    if (lane == 0) { *rsA = rsqrtf(sa * (1.0f / 1024.0f) + 1e-6f); if (hasB) *rsB = rsqrtf(sb * (1.0f / 1024.0f) + 1e-6f); }
}
template <bool SAMPLE> __device__ __forceinline__ void sb_item(int item, int layer, const float* PROJ, const float* KP, const float* VP, const float* KS, const float* VS,
                                        const float* CK, const float* CV, const bf16_t* VT, const bf16_t* KB, float* OSB, int lane) {
    const int r32 = lane & 31, hi = lane >> 5;
    int qrow, qpos, ptop, split, h, qmin; bool qvalid; const float *kA, *vA, *kB, *vB;
    const bf16_t* VTh = VT; const bf16_t* KBh = KB;
    if (!SAMPLE) { const int b = item >> 11, rem = item & 2047, qt = rem & 255; h = rem >> 8; VTh = VT + ((size_t)(b * 8 + h) * 2048 * 64 + r32) * 4; KBh = KB + ((size_t)(b * 8 + h) * 256 * 8 * 32 + hi * 32 + r32) * 8;
        qrow = b * 8192 + qt * 32 + r32; qpos = qt * 32 + r32; qvalid = true; ptop = qt * 32; split = 1 << 30; qmin = qt * 32;
        kA = KP + (size_t)(b * 8192) * 512 + h * 64; vA = VP + (size_t)(b * 8192) * 512 + h * 64; kB = kA; vB = vA;
    } else { const int it = item - 4096, s = it >> 3; h = it & 7;
        qrow = NPROMPT + s * 16 + (r32 & 15); qpos = 2048 + (r32 & 15); qvalid = r32 < 16; ptop = 2032; split = 2048; qmin = 2048;
        kA = CK + (size_t)((layer * 32 + s) * 2048) * 512 + h * 64; vA = CV + (size_t)((layer * 32 + s) * 2048) * 512 + h * 64;
        kB = KS + ((long)(s * 16) - 2048) * 512 + h * 64; vB = VS + ((long)(s * 16) - 2048) * 512 + h * 64; }
    bf16x8 qh[4];
    { const bf16_t* qp = (const bf16_t*)PROJ + (size_t)qrow * PLD + h * 64 + 8 * hi;
#pragma unroll
      for (int ds = 0; ds < 4; ++ds) qh[ds] = *(const bf16x8*)(qp + 16 * ds); }
    f32x16 oacc[2];
#pragma unroll
    for (int i = 0; i < 16; ++i) { oacc[0][i] = 0.f; oacc[1][i] = 0.f; }
    float carry = 0.f;
    f32x4 kraw[8]; float vraw[2][2][8]; u32x2 vpk[2][2][2]; bf16x8 kq[4];
#define SB_LOAD_TILE(P0) do { if (SAMPLE) { const int pr_ = (P0) + r32, prc_ = pr_ < 0 ? 0 : pr_; const float* kp_ = (prc_ >= split ? kB : kA) + (long)prc_ * 512 + 8 * hi; \
        _Pragma("unroll") for (int ds = 0; ds < 4; ++ds) { kraw[2 * ds] = *(const f32x4*)(kp_ + 16 * ds); kraw[2 * ds + 1] = *(const f32x4*)(kp_ + 16 * ds + 4); } } \
        else { const int pq_ = (P0) < 0 ? 0 : (P0); _Pragma("unroll") for (int ds = 0; ds < 4; ++ds) kq[ds] = *(const bf16x8*)(KBh + ((size_t)(pq_ >> 5) * 8 + 2 * ds) * 32 * 8); } \
        if (SAMPLE) { _Pragma("unroll") for (int t = 0; t < 2; ++t) _Pragma("unroll") for (int j = 0; j < 8; ++j) { const int pk_ = (P0) + 16 * t + 8 * (j >> 2) + 4 * hi + (j & 3), pkc_ = pk_ < 0 ? 0 : pk_; \
            const float* vp_ = (pkc_ >= split ? vB : vA) + (long)pkc_ * 512 + r32; vraw[t][0][j] = vp_[0]; vraw[t][1][j] = vp_[32]; } } \
        else { const int pc_ = (P0) < 0 ? 0 : (P0); _Pragma("unroll") for (int t = 0; t < 2; ++t) _Pragma("unroll") for (int dt = 0; dt < 2; ++dt) { const bf16_t* vq_ = VTh + ((size_t)((pc_ >> 2) + 4 * t + hi) * 64 + dt * 32) * 4; \
            vpk[t][dt][0] = *(const u32x2*)vq_; vpk[t][dt][1] = *(const u32x2*)(vq_ + 2 * 64 * 4); } } } while (0)
    SB_LOAD_TILE(ptop);
    for (int p0 = ptop; p0 > -32; p0 -= 32) {
        bf16x8 kf[4], va[2][2];
#pragma unroll
        for (int ds = 0; ds < 4; ++ds) { if (SAMPLE) kf[ds] = pack8(kraw[2 * ds][0], kraw[2 * ds][1], kraw[2 * ds][2], kraw[2 * ds][3], kraw[2 * ds + 1][0], kraw[2 * ds + 1][1], kraw[2 * ds + 1][2], kraw[2 * ds + 1][3]); else kf[ds] = kq[ds]; }
#pragma unroll
        for (int t = 0; t < 2; ++t)
#pragma unroll
            for (int dt = 0; dt < 2; ++dt) { if (SAMPLE) va[t][dt] = pack8(vraw[t][dt][0], vraw[t][dt][1], vraw[t][dt][2], vraw[t][dt][3], vraw[t][dt][4], vraw[t][dt][5], vraw[t][dt][6], vraw[t][dt][7]);
                else va[t][dt] = __builtin_bit_cast(bf16x8, (u32x4){vpk[t][dt][0].x, vpk[t][dt][0].y, vpk[t][dt][1].x, vpk[t][dt][1].y}); }
        SB_LOAD_TILE(p0 - 32);
        asm volatile("" ::: "memory");
        f32x16 acc;
#pragma unroll
        for (int i = 0; i < 16; ++i) acc[i] = 0.f;
#pragma unroll
        for (int ds = 0; ds < 4; ++ds) acc = MFMA32(kf[ds], qh[ds], acc);
        float L[16], ls[16];
        if (p0 >= 0 && p0 + 32 <= qmin) {
#pragma unroll
            for (int i = 0; i < 16; ++i) { const float z = acc[i]; const float sp = fmaxf(z, 0.f) + flog(1.f + fexp(-fabsf(z))); L[i] = -sp; ls[i] = z - sp; }
        } else {
#pragma unroll
            for (int i = 0; i < 16; ++i) { const int kpos = p0 + crow(i, hi); const bool valid = (kpos < qpos) && (kpos >= 0); const float z = acc[i];
                const float sp = fmaxf(z, 0.f) + flog(1.f + fexp(-fabsf(z)));
                L[i] = valid ? -sp : 0.f; ls[i] = valid ? (z - sp) : -1e30f; }
        }
        float G[4], PG[4], T[4];
#pragma unroll
        for (int g = 0; g < 4; ++g) { G[g] = (L[4 * g] + L[4 * g + 1]) + (L[4 * g + 2] + L[4 * g + 3]); PG[g] = __shfl_xor(G[g], 32); T[g] = G[g] + PG[g]; }
        float A[4]; A[3] = 0.f; A[2] = T[3]; A[1] = T[3] + T[2]; A[0] = A[1] + T[1];
        float P[16];
#pragma unroll
        for (int g = 0; g < 4; ++g) { const float e3 = carry + A[g] + (hi == 0 ? PG[g] : 0.f), e2 = e3 + L[4 * g + 3], e1 = e2 + L[4 * g + 2], e0 = e1 + L[4 * g + 1];
            P[4 * g + 3] = fexp(ls[4 * g + 3] + e3); P[4 * g + 2] = fexp(ls[4 * g + 2] + e2); P[4 * g + 1] = fexp(ls[4 * g + 1] + e1); P[4 * g] = fexp(ls[4 * g] + e0); }
        carry += (T[0] + T[1]) + (T[2] + T[3]);
#pragma unroll
        for (int t = 0; t < 2; ++t) { const bf16x8 pb = pack8(P[8 * t], P[8 * t + 1], P[8 * t + 2], P[8 * t + 3], P[8 * t + 4], P[8 * t + 5], P[8 * t + 6], P[8 * t + 7]);
            oacc[0] = MFMA32(va[t][0], pb, oacc[0]); oacc[1] = MFMA32(va[t][1], pb, oacc[1]); }
        if (__all(carry < -110.0f)) break;
    }
    if (qvalid) { bf16_t* op = (bf16_t*)OSB + (size_t)qrow * 512 + h * 64 + 4 * hi;
#pragma unroll
        for (int dt = 0; dt < 2; ++dt)
#pragma unroll
            for (int g = 0; g < 4; ++g) *(u32x2*)(op + dt * 32 + 8 * g) = (u32x2){pk2(oacc[dt][4 * g], oacc[dt][4 * g + 1]), pk2(oacc[dt][4 * g + 2], oacc[dt][4 * g + 3])}; }
}

__device__ __forceinline__ void hg_load(const float* PROJ, int row0, int tvalid, int h, int tg, int k, int coff, float (&zr)[16]) {
#pragma unroll
    for (int j = 0; j < 16; ++j) { const int t = 16 * tg + j, tc = t < tvalid ? t : 0; zr[j] = __uint_as_float((unsigned)((const bf16_t*)PROJ)[(size_t)(row0 + tc) * PLD + coff + h * 128 + k] << 16); }
}
__device__ __forceinline__ void hg_prep(const float (&zr)[16], const float (&qr)[16], int tvalid, float lbv, int tg, float (&loc)[16], float (&kk)[16], float (&qv)[16]) {
    float run = 0.f;
#pragma unroll
    for (int j = 0; j < 16; ++j) { const int t = 16 * tg + j; const bool ok = t < tvalid; const float z = ok ? zr[j] : 0.f, q = ok ? qr[j] : 0.f;
        const float ez = fexp(-fabsf(z)), inv = __builtin_amdgcn_rcpf(1.f + ez);
        const float sig = z >= 0.f ? inv : ez * inv, nsig = z >= 0.f ? ez * inv : inv;
        float lf = (lbv > 0.f) ? flog(lbv + (1.f - lbv) * sig) : (fminf(z, 0.f) - flog(1.f + ez));
        if (!ok) lf = 0.f;
        run += lf; loc[j] = run; kk[j] = ok ? (1.f - lbv) * nsig : 0.f; qv[j] = q * 0.08838834764831845f; }
}
__device__ __forceinline__ void hg_h1(ldsp lds, const float* PROJ, const float (&zr)[16], int row0, int tvalid, int h, float lbv, float* dsOut, float* ddOut, const float* s0, int tid, int lane, int wave) {
    const int tg = tid >> 7, k = tid & 127;
    float loc[16], kk[16], qv[16], iv[16];
#pragma unroll
    for (int j = 0; j < 16; ++j) { const int ta = 16 * tg + j, tc = ta < tvalid ? ta : 0; const float x = __uint_as_float((unsigned)((const bf16_t*)PROJ)[(size_t)(row0 + tc) * PLD + 2560 + h * 128 + k] << 16); iv[j] = ta < tvalid ? x : 0.f; }
    hg_prep(zr, zr, tvalid, lbv, tg, loc, kk, qv);
    LAS float* TOT = (LAS float*)lds; LAS float* DK = (LAS float*)(lds + 2048);
    TOT[tg * 128 + k] = loc[15];
    __syncthreads();
    const float t0 = TOT[k], t1 = TOT[128 + k], t2 = TOT[256 + k], t3 = TOT[384 + k];
    const float r1 = t0, r2 = r1 + t1, r3 = r2 + t2, r4 = r3 + t3;
    const float rtg = tg == 0 ? 0.f : (tg == 1 ? r1 : (tg == 2 ? r2 : r3));
    { unsigned w[8];
#pragma unroll
      for (int jj = 0; jj < 8; ++jj) w[jj] = pk2(kk[2 * jj] * fexp(r4 - rtg - loc[2 * jj]), kk[2 * jj + 1] * fexp(r4 - rtg - loc[2 * jj + 1]));
      *(LAS u32x4*)(lds + 4096 + k * 144 + tg * 32) = (u32x4){w[0], w[1], w[2], w[3]}; *(LAS u32x4*)(lds + 4096 + k * 144 + tg * 32 + 16) = (u32x4){w[4], w[5], w[6], w[7]};
#pragma unroll
      for (int jj = 0; jj < 8; ++jj) w[jj] = pk2(iv[2 * jj], iv[2 * jj + 1]);
      *(LAS u32x4*)(lds + 22528 + k * 144 + tg * 32) = (u32x4){w[0], w[1], w[2], w[3]}; *(LAS u32x4*)(lds + 22528 + k * 144 + tg * 32 + 16) = (u32x4){w[4], w[5], w[6], w[7]}; }
    if (tg == 0) { const float dk = fexp(r4); DK[k] = dk; if (ddOut) ddOut[k] = dk; }
    __syncthreads();
    const int r32 = lane & 31, hi = lane >> 5, km = wave & 3, vn0 = (wave >> 2) * 2;
#pragma unroll
    for (int vv = 0; vv < 2; ++vv) { f32x16 acc;
#pragma unroll
        for (int i = 0; i < 16; ++i) acc[i] = 0.f;
#pragma unroll
        for (int ks = 0; ks < 4; ++ks) { const bf16x8 a = *(LAS bf16x8*)(lds + 4096 + (32 * km + r32) * 144 + ks * 32 + hi * 16);
            const bf16x8 b = *(LAS bf16x8*)(lds + 22528 + (32 * (vn0 + vv) + r32) * 144 + ks * 32 + hi * 16); acc = MFMA32(a, b, acc); }
        const int v = 32 * (vn0 + vv) + r32;
#pragma unroll
        for (int i = 0; i < 16; ++i) { if (s0) { const int kr = 32 * km + crow(i, hi); dsOut[kr * 128 + v] = acc[i] + DK[kr] * s0[kr * 128 + v]; } }
        if (!s0) { bf16_t* db = (bf16_t*)dsOut + v * 128 + 32 * km + 4 * hi;
#pragma unroll
            for (int g = 0; g < 4; ++g) *(u32x2*)(db + 8 * g) = (u32x2){pk2(acc[4 * g], acc[4 * g + 1]), pk2(acc[4 * g + 2], acc[4 * g + 3])}; } }
    __syncthreads();
}
__device__ __forceinline__ void hg_h3(ldsp lds, const float* PROJ, const float (&zr)[16], int row0, int tvalid, int h, float lbv, const float* Ssrc, bool sbf, const float* hgain, bf16_t* MIX, int tid, int lane, int wave) {
    constexpr int QE = 2048, KE = 19456, ST = 62976, IV = 97792, PM = 116224, OST = 19456;
    const int tg = tid >> 7, k = tid & 127;
    float loc[16], kk[16], qv[16];
    f32x4 gv[4], gav[4];
    float qr[16]; hg_load(PROJ, row0, tvalid, h, tg, k, 1536, qr);
    hg_prep(zr, qr, tvalid, lbv, tg, loc, kk, qv);
    LAS float* TOT = (LAS float*)lds;
    TOT[tg * 128 + k] = loc[15];
    for (int i = tid; i < 2304; i += 512) ((LAS unsigned*)(lds + PM))[i] = 0u;
    if (sbf) {
#pragma unroll
        for (int jj = 0; jj < 4; ++jj) { const int cidx = tid + 512 * jj, v = cidx >> 4, kc = cidx & 15;
            *(LAS u32x4*)(lds + ST + v * 272 + kc * 16) = *(const u32x4*)((const bf16_t*)Ssrc + v * 128 + kc * 8); }
    } else {
#pragma unroll
        for (int jj = 0; jj < 16; ++jj) { const int kp = 2 * ((tid >> 7) + 4 * jj), v = tid & 127;
            *(LAS unsigned*)(lds + ST + v * 272 + kp * 2) = pk2(Ssrc[kp * 128 + v], Ssrc[(kp + 1) * 128 + v]); } }
    { unsigned w[8];
#pragma unroll
      for (int jj = 0; jj < 8; ++jj) { const int ta = 16 * tg + 2 * jj, t0 = ta < tvalid ? ta : 0, t1 = (ta + 1) < tvalid ? ta + 1 : 0;
          const float x0 = __uint_as_float((unsigned)((const bf16_t*)PROJ)[(size_t)(row0 + t0) * PLD + 2560 + h * 128 + k] << 16), x1 = __uint_as_float((unsigned)((const bf16_t*)PROJ)[(size_t)(row0 + t1) * PLD + 2560 + h * 128 + k] << 16);
          w[jj] = pk2(ta < tvalid ? x0 : 0.f, (ta + 1) < tvalid ? x1 : 0.f); }
      *(LAS u32x4*)(lds + IV + k * 144 + tg * 32) = (u32x4){w[0], w[1], w[2], w[3]}; *(LAS u32x4*)(lds + IV + k * 144 + tg * 32 + 16) = (u32x4){w[4], w[5], w[6], w[7]}; }
    __syncthreads();
    { const int t = tid >> 3, v0 = (tid & 7) * 16; const int tc = t < tvalid ? t : 0; const bf16_t* gp = (const bf16_t*)PROJ + (size_t)(row0 + tc) * PLD + 3072 + h * 128 + v0; const float* hg = hgain + h * 128 + v0;
      const u32x4 g0 = *(const u32x4*)gp, g1 = *(const u32x4*)(gp + 8);
      gv[0] = (f32x4){__uint_as_float(g0.x << 16), __uint_as_float(g0.x & 0xffff0000u), __uint_as_float(g0.y << 16), __uint_as_float(g0.y & 0xffff0000u)};
      gv[1] = (f32x4){__uint_as_float(g0.z << 16), __uint_as_float(g0.z & 0xffff0000u), __uint_as_float(g0.w << 16), __uint_as_float(g0.w & 0xffff0000u)};
      gv[2] = (f32x4){__uint_as_float(g1.x << 16), __uint_as_float(g1.x & 0xffff0000u), __uint_as_float(g1.y << 16), __uint_as_float(g1.y & 0xffff0000u)};
      gv[3] = (f32x4){__uint_as_float(g1.z << 16), __uint_as_float(g1.z & 0xffff0000u), __uint_as_float(g1.w << 16), __uint_as_float(g1.w & 0xffff0000u)};
#pragma unroll
      for (int c = 0; c < 4; ++c) gav[c] = *(const f32x4*)(hg + 4 * c); }
    const float t0 = TOT[k], t1 = TOT[128 + k], t2 = TOT[256 + k];
    const float r1 = t0, r2 = r1 + t1, r3 = r2 + t2;
    const float rtg = tg == 0 ? 0.f : (tg == 1 ? r1 : (tg == 2 ? r2 : r3));
#pragma unroll
    for (int j = 0; j < 16; ++j) *(LAS unsigned short*)(lds + QE + (16 * tg + j) * 272 + k * 2) = (unsigned short)f2bf(qv[j] * fexp(loc[j]));
#pragma unroll
    for (int i = 0; i < 4; ++i) { if (i >= tg) { const float ri = i == 0 ? 0.f : (i == 1 ? r1 : (i == 2 ? r2 : r3)); const int rb = 8 * i * (i + 1);
#pragma unroll
        for (int j = 0; j < 16; ++j) *(LAS unsigned short*)(lds + KE + (rb + 16 * tg + j) * 272 + k * 2) = (unsigned short)f2bf(kk[j] * fexp(fminf(ri - rtg - loc[j], 80.f))); } }
    __syncthreads();
    { const int c16 = lane & 15, q4 = lane >> 4;
      for (int tix = wave; tix < 10; tix += 8) { const int i = tix < 1 ? 0 : (tix < 3 ? 1 : (tix < 6 ? 2 : 3)), j = tix - i * (i + 1) / 2, rb = 8 * i * (i + 1);
          f32x4 acc = {0.f, 0.f, 0.f, 0.f};
#pragma unroll
          for (int ks = 0; ks < 4; ++ks) { const bf16x8 a = *(LAS bf16x8*)(lds + QE + (16 * i + c16) * 272 + ks * 64 + q4 * 16);
              const bf16x8 b = *(LAS bf16x8*)(lds + KE + (rb + 16 * j + c16) * 272 + ks * 64 + q4 * 16); acc = MFMA16(a, b, acc); }
#pragma unroll
          for (int ii = 0; ii < 4; ++ii) { const int tl = 4 * q4 + ii; float pv = acc[ii]; if (i == j && c16 > tl) pv = 0.f;
              *(LAS unsigned short*)(lds + PM + (16 * i + tl) * 144 + (16 * j + c16) * 2) = (unsigned short)f2bf(pv); } } }
    __syncthreads();
#pragma unroll
    for (int j = 0; j < 16; ++j) *(LAS unsigned short*)(lds + QE + (16 * tg + j) * 272 + k * 2) = (unsigned short)f2bf(qv[j] * fexp(rtg + loc[j]));
    __syncthreads();
    { const int r32 = lane & 31, hi = lane >> 5, tm = wave & 1, vn = wave >> 1; f32x16 acc;
#pragma unroll
      for (int i = 0; i < 16; ++i) acc[i] = 0.f;
#pragma unroll
      for (int ks = 0; ks < 8; ++ks) { const bf16x8 a = *(LAS bf16x8*)(lds + QE + (32 * tm + r32) * 272 + ks * 32 + hi * 16);
          const bf16x8 b = *(LAS bf16x8*)(lds + ST + (32 * vn + r32) * 272 + ks * 32 + hi * 16); acc = MFMA32(a, b, acc); }
#pragma unroll
      for (int ks = 0; ks < 4; ++ks) { const bf16x8 a = *(LAS bf16x8*)(lds + PM + (32 * tm + r32) * 144 + ks * 32 + hi * 16);
          const bf16x8 b = *(LAS bf16x8*)(lds + IV + (32 * vn + r32) * 144 + ks * 32 + hi * 16); acc = MFMA32(a, b, acc); }
#pragma unroll
      for (int i = 0; i < 16; ++i) *(LAS float*)(lds + OST + (32 * tm + crow(i, hi)) * 528 + (32 * vn + r32) * 4) = acc[i]; }
    __syncthreads();
    { const int t = tid >> 3, v0 = (tid & 7) * 16; f32x4 o[4]; float ss = 0.f;
#pragma unroll
      for (int c = 0; c < 4; ++c) { o[c] = *(LAS f32x4*)(lds + OST + t * 528 + (v0 + 4 * c) * 4); ss += (o[c][0] * o[c][0] + o[c][1] * o[c][1]) + (o[c][2] * o[c][2] + o[c][3] * o[c][3]); }
      ss += __shfl_xor(ss, 1); ss += __shfl_xor(ss, 2); ss += __shfl_xor(ss, 4);
      const float rs = rsqrtf(ss * (1.0f / 128.0f) + 1e-6f);
      if (t < tvalid) { const size_t row = (size_t)(row0 + t); unsigned w[8];
#pragma unroll
          for (int c = 0; c < 4; ++c) { const f32x4 g = gv[c], ga = gav[c]; f32x4 r;
#pragma unroll
              for (int e = 0; e < 4; ++e) r[e] = o[c][e] * rs * ga[e] * (g[e] * __builtin_amdgcn_rcpf(1.f + fexp(-g[e])));
              w[2 * c] = pk2(r[0], r[1]); w[2 * c + 1] = pk2(r[2], r[3]); }
          bf16_t* mp = MIX + row * 1024 + 512 + h * 128 + v0;
          *(u32x4*)mp = (u32x4){w[0], w[1], w[2], w[3]}; *(u32x4*)(mp + 8) = (u32x4){w[4], w[5], w[6], w[7]}; } }
    __syncthreads();
}

__device__ __forceinline__ void xattn_item(ldsp lds, const bf16_t* QM, const float* Kg, const float* Vg, const bf16_t* Kb, const bf16_t* Vtb, int row0, int tvalid, int hm, bf16_t* OM, int tid, int lane, int wave) {
    constexpr int KM = 0, QS = 69632, PMX = 87040, RMO = 120832, RSO = 121344, VT = 0;
    if (Kb) {
#pragma unroll
        for (int jj = 0; jj < 8; ++jj) { const int cidx = tid + 512 * jj, m = cidx >> 4, dc = cidx & 15; *(LAS u32x4*)(lds + KM + m * 272 + dc * 16) = *(const u32x4*)(Kb + m * 128 + dc * 8); }
    } else {
#pragma unroll
        for (int jj = 0; jj < 8; ++jj) { const int cidx = tid + 512 * jj, m = cidx >> 4, dc = cidx & 15; const float* p = Kg + (size_t)m * 512 + dc * 8;
            const f32x4 a = *(const f32x4*)p, b = *(const f32x4*)(p + 4);
            *(LAS u32x4*)(lds + KM + m * 272 + dc * 16) = (u32x4){pk2(a[0], a[1]), pk2(a[2], a[3]), pk2(b[0], b[1]), pk2(b[2], b[3])}; } }
#pragma unroll
    for (int jj = 0; jj < 2; ++jj) { const int cidx = tid + 512 * jj, t = cidx >> 4, dc = cidx & 15; u32x4 w = {0u, 0u, 0u, 0u};
        if (t < tvalid) w = *(const u32x4*)(QM + (size_t)(row0 + t) * 512 + hm * 128 + dc * 8);
        *(LAS u32x4*)(lds + QS + t * 272 + dc * 16) = w; }
    float vr0[32], vr1[32]; u32x4 vq[8];
    if (Vtb) {
#pragma unroll
        for (int jj = 0; jj < 8; ++jj) { const int cidx = tid + 512 * jj, d = cidx >> 5, mc = cidx & 31; vq[jj] = *(const u32x4*)(Vtb + d * 256 + mc * 8); }
    } else {
#pragma unroll
        for (int jj = 0; jj < 32; ++jj) { const int idx = tid + 512 * jj, d = idx & 127, mp = idx >> 7; vr0[jj] = Vg[(size_t)(2 * mp) * 512 + d]; vr1[jj] = Vg[(size_t)(2 * mp + 1) * 512 + d]; } }
    __syncthreads();
    const int tgp = wave & 3, mh = wave >> 2, c16 = lane & 15, q4 = lane >> 4, tok = 16 * tgp + c16;
    LAS float* RM = (LAS float*)(lds + RMO); LAS float* RS = (LAS float*)(lds + RSO);
    f32x4 sacc[8];
    { bf16x8 bq[4];
#pragma unroll
      for (int ks = 0; ks < 4; ++ks) bq[ks] = *(LAS bf16x8*)(lds + QS + tok * 272 + ks * 64 + q4 * 16);
#pragma unroll
      for (int j = 0; j < 8; ++j) { f32x4 acc = {0.f, 0.f, 0.f, 0.f};
#pragma unroll
          for (int ks = 0; ks < 4; ++ks) { const bf16x8 a = *(LAS bf16x8*)(lds + KM + (128 * mh + 16 * j + c16) * 272 + ks * 64 + q4 * 16); acc = MFMA16(a, bq[ks], acc); }
          sacc[j] = acc; } }
    float mx = -3.0e38f;
#pragma unroll
    for (int j = 0; j < 8; ++j) mx = fmaxf(fmaxf(mx, fmaxf(sacc[j][0], sacc[j][1])), fmaxf(sacc[j][2], sacc[j][3]));
    mx = fmaxf(mx, __shfl_xor(mx, 16)); mx = fmaxf(mx, __shfl_xor(mx, 32));
    if (q4 == 0) RM[mh * 64 + tok] = mx;
    __syncthreads();
    { const float m = fmaxf(RM[tok], RM[64 + tok]); float sum = 0.f;
#pragma unroll
      for (int j = 0; j < 8; ++j) { const float p0 = fexp(sacc[j][0] - m), p1 = fexp(sacc[j][1] - m), p2 = fexp(sacc[j][2] - m), p3 = fexp(sacc[j][3] - m);
          sum += (p0 + p1) + (p2 + p3);
          *(LAS u32x2*)(lds + PMX + tok * 528 + (128 * mh + 16 * j + 4 * q4) * 2) = (u32x2){pk2(p0, p1), pk2(p2, p3)}; }
      sum += __shfl_xor(sum, 16); sum += __shfl_xor(sum, 32);
      if (q4 == 0) RS[mh * 64 + tok] = sum; }
    __syncthreads();
    if (Vtb) {
#pragma unroll
        for (int jj = 0; jj < 8; ++jj) { const int cidx = tid + 512 * jj, d = cidx >> 5, mc = cidx & 31; *(LAS u32x4*)(lds + VT + d * 528 + mc * 16) = vq[jj]; }
    } else {
#pragma unroll
        for (int jj = 0; jj < 32; ++jj) { const int idx = tid + 512 * jj, d = idx & 127, mp = idx >> 7;
            *(LAS unsigned*)(lds + VT + d * 528 + mp * 4) = pk2(vr0[jj], vr1[jj]); } }
    __syncthreads();
    { const int r32 = lane & 31, hi = lane >> 5, tm = wave & 1, dn = wave >> 1; f32x16 acc;
#pragma unroll
      for (int i = 0; i < 16; ++i) acc[i] = 0.f;
#pragma unroll
      for (int ks = 0; ks < 16; ++ks) { const bf16x8 a = *(LAS bf16x8*)(lds + PMX + (32 * tm + r32) * 528 + ks * 32 + hi * 16);
          const bf16x8 b = *(LAS bf16x8*)(lds + VT + (32 * dn + r32) * 528 + ks * 32 + hi * 16); acc = MFMA32(a, b, acc); }
#pragma unroll
      for (int i = 0; i < 16; ++i) { const int tk = 32 * tm + crow(i, hi); const float inv = __builtin_amdgcn_rcpf(RS[tk] + RS[64 + tk]);
          if (tk < tvalid) OM[(size_t)(row0 + tk) * 512 + hm * 128 + 32 * dn + r32] = (bf16_t)f2bf(acc[i] * inv); } }
    __syncthreads();
}
#define XB_TMO      128
#define XB_XCNT(j)  (256  + 64 * (j))
#define XB_XSUB(j)  (1280 + 64 * (j))
#define XB_XGEN(j)  (2304 + 64 * (j))
#define XB_TOP      3328
#define XB_TOPGEN   3392
#define XCD_BAR_WORDS 3456
#define XB_SPIN_CAP (1u << 18)

__device__ __forceinline__ unsigned xb_ld(unsigned* p)              { return __hip_atomic_load(p, __ATOMIC_RELAXED, __HIP_MEMORY_SCOPE_AGENT); }
__device__ __forceinline__ unsigned xb_add(unsigned* p, unsigned v) { return __hip_atomic_fetch_add(p, v, __ATOMIC_RELAXED, __HIP_MEMORY_SCOPE_AGENT); }
__device__ __forceinline__ unsigned xb_xcc_id() { return (unsigned)__builtin_amdgcn_s_getreg((3 << 11) | 20) & 0xFu; }
#define XB_SPIN(cond, bar) do { unsigned _sp = 0; while (cond) { __builtin_amdgcn_s_sleep(1); \
    if ((++_sp & 255u) == 0u) { if (xb_ld(&(bar)[XB_TMO])) break; if (_sp > XB_SPIN_CAP) { atomicAdd(&(bar)[XB_TMO], 1u); break; } } } } while (0)

struct XcdBarrier {
    unsigned* bar; unsigned x;
    volatile LAS unsigned* st;
};

__device__ __forceinline__ XcdBarrier xcd_barrier_post(unsigned* bar, volatile LAS unsigned* st) {
    XcdBarrier b; b.bar = bar; b.x = xb_xcc_id(); b.st = st;
    if (threadIdx.x == 0) (void)xb_add(&bar[XB_XCNT(b.x)], 1u);
    return b;
}
__device__ __forceinline__ void xcd_barrier_complete(unsigned* bar, unsigned x, unsigned& nloc, unsigned& nx) {
    const unsigned G = gridDim.x * gridDim.y * gridDim.z;
    unsigned sum, cnt, mine, sp = 0u;
    for (;;) {
        sum = 0u; cnt = 0u; mine = 0u;
#pragma unroll
        for (unsigned j = 0; j < 16; ++j) { const unsigned c = xb_ld(&bar[XB_XCNT(j)]); sum += c; cnt += (c > 0u) ? 1u : 0u; mine = (j == x) ? c : mine; }
        if (sum == G) break;
        __builtin_amdgcn_s_sleep(1);
        if ((++sp & 255u) == 0u) { if (xb_ld(&bar[XB_TMO])) break; if (sp > XB_SPIN_CAP) { atomicAdd(&bar[XB_TMO], 1u); break; } }
    }
    nloc = mine > 0u ? mine : 1u; nx = cnt > 0u ? cnt : 1u;
}

__device__ __forceinline__ void xcd_barrier(const XcdBarrier& b) {
    asm volatile("s_waitcnt vmcnt(0)" ::: "memory");
    __syncthreads();
    if (threadIdx.x == 0) {
        unsigned* bar = b.bar;
        __builtin_amdgcn_s_waitcnt(0);
        unsigned nloc = b.st[0], nx = b.st[1];
        if (nloc == 0u) { xcd_barrier_complete(bar, b.x, nloc, nx); b.st[0] = nloc; b.st[1] = nx; }
        const unsigned old = xb_add(&bar[XB_XSUB(b.x)], 1u);
        const unsigned gen = old / nloc;
        if (old + 1u == (gen + 1u) * nloc) {
            __builtin_amdgcn_fence(__ATOMIC_RELEASE, "agent");
            asm volatile("s_waitcnt vmcnt(0)" ::: "memory");
            const unsigned og = xb_add(&bar[XB_TOP], 1u);
            const unsigned tg = og / nx;
            if (og + 1u == (tg + 1u) * nx) xb_add(&bar[XB_TOPGEN], 1u);
            else XB_SPIN(xb_ld(&bar[XB_TOPGEN]) == tg, bar);
            __builtin_amdgcn_fence(__ATOMIC_ACQUIRE, "agent");
            xb_add(&bar[XB_XGEN(b.x)], 1u);
            asm volatile("s_waitcnt vmcnt(0)" ::: "memory");
        } else {
            XB_SPIN(xb_ld(&bar[XB_XGEN(b.x)]) == gen, bar);
            __builtin_amdgcn_fence(__ATOMIC_ACQUIRE, "agent");
            asm volatile("s_waitcnt vmcnt(0)" ::: "memory");
        }
    }
    __syncthreads();
}

__device__ __forceinline__ const float* gptr_(unsigned long long v) { return (const float*)(const __attribute__((address_space(1))) float*)v; }
#define GPTR(p) gptr_(p)
#define FPTR(p) ((const float*)(p))
#define OPQ(x) asm volatile("" : "+s"(x))
#define OPQP(T, x) do { unsigned long long xi_ = (unsigned long long)(x); asm volatile("" : "+s"(xi_)); x = (T*)(__attribute__((address_space(1))) T*)xi_; } while (0)
struct Args { const float* in[24]; float* out; unsigned char* ws; };
__global__ void __launch_bounds__(512, 2) mega_fwd(Args args) {
    extern __shared__ __attribute__((aligned(16))) unsigned char lds_raw[];
    cg::grid_group grid = cg::this_grid();
    ldsp lds = (ldsp)lds_raw;
    unsigned char* const ws = args.ws; float* const out = args.out;
#define WAVE_IDS int tid = threadIdx.x; asm volatile("" : "+v"(tid)); const int lane = tid & 63, wave = __builtin_amdgcn_readfirstlane(tid >> 6), G = gridDim.x, bid = blockIdx.x, gw = bid * 8 + wave, NGW = G * 8; (void)lane; (void)gw; (void)NGW

    {
        WAVE_IDS;
        if (tid < 2) ((LAS unsigned*)(lds + LDS_BARST))[tid] = 0u;
        __syncthreads();
        (void)xcd_barrier_post((unsigned*)(ws + WS_BAR), (volatile LAS unsigned*)(lds + LDS_BARST));
        if (bid == 0 && tid == 0) { const float** tab = (const float**)ws;
#pragma unroll
            for (int i = 0; i < 24; ++i) tab[i] = args.in[i]; }
        bf16_t* XB = (bf16_t*)(ws + WS_XB); float* SSQ = (float*)(ws + WS_SSQ); bf16_t* MEMB = (bf16_t*)(ws + WS_MEMB); float* MEMSSQ = (float*)(ws + WS_MEMSSQ); bf16_t* WMKV = (bf16_t*)(ws + WS_WMKV);
        LAS float* scr = (LAS float*)(lds + wave * 16384);
#define CONV_ITEM(PTR, L_, R_, WSB) do { const int l = (L_); int r = (R_); unsigned char* wl = (WSB) + WS_W0 + (size_t)l * WS_WL; bf16_t* wmkv = (bf16_t*)((WSB) + WS_WMKV); \
            if (r < 1792) { transpose_item(PTR(10) + (size_t)l * 1024 * 3584, 1024, 3584, (bf16_t*)(wl + W_IN), 0, PTR(9) + l * 1024, scr, r, lane); break; } r -= 1792; \
            if (r < 512)  { transpose_item(PTR(13) + (size_t)l * 1024 * 1024, 1024, 1024, (bf16_t*)(wl + W_OUT), 0, nullptr, scr, r, lane); break; } r -= 512; \
            if (r < 256)  { transpose_item(PTR(16) + (size_t)l * 1024 * 512, 1024, 512, (bf16_t*)(wl + W_MQ), 0, PTR(14) + l * 1024, scr, r, lane); break; } r -= 256; \
            if (r < 256)  { transpose_item(PTR(17) + (size_t)l * 1024 * 512, 1024, 512, wmkv + (size_t)l * 1024 * 1024, 0, PTR(15) + l * 1024, scr, r, lane); break; } r -= 256; \
            if (r < 256)  { transpose_item(PTR(18) + (size_t)l * 1024 * 512, 1024, 512, wmkv + (size_t)l * 1024 * 1024, 512, PTR(15) + l * 1024, scr, r, lane); break; } r -= 256; \
            if (r < 256)  { transpose_item(PTR(19) + (size_t)l * 512 * 1024, 512, 1024, (bf16_t*)(wl + W_MO), 0, nullptr, scr, r, lane); break; } r -= 256; \
            if (r < 2048) { transpose_item(PTR(21) + (size_t)l * 1024 * 4096, 1024, 4096, (bf16_t*)(wl + W_1), 0, PTR(20) + l * 1024, scr, r, lane); break; } r -= 2048; \
            transpose_item(PTR(22) + (size_t)l * 4096 * 1024, 4096, 1024, (bf16_t*)(wl + W_2), 0, nullptr, scr, r, lane); } while (0)
#define ARGP(i) args.in[i]
        const bool defer = (G == 256);
        for (int it = gw; it < (defer ? 3328 + 512 : 14848); it += NGW) {
            if (defer) { if (it < 3328) CONV_ITEM(ARGP, 0, it, ws); else CONV_ITEM(ARGP, 1, 2560 + (it - 3328), ws); }
            else { if (it < 7424) CONV_ITEM(ARGP, 0, it, ws); else CONV_ITEM(ARGP, 1, it - 7424, ws); } }
#undef ARGP
#define ROW_PTRS(m, S, D, Q, R) do { if ((m) < NPROMPT) { S = args.in[0] + (size_t)(m) * 1024; D = XB + (size_t)(m) * 1024; Q = SSQ + (size_t)(m) * 16; R = (float*)(ws + WS_RSTD) + (m); } \
            else if ((m) < M_ALL) { S = args.in[1] + (size_t)((m) - NPROMPT) * 1024; D = XB + (size_t)(m) * 1024; Q = SSQ + (size_t)(m) * 16; R = (float*)(ws + WS_RSTD) + (m); } \
            else { S = args.in[2] + (size_t)((m) - M_ALL) * 1024; D = MEMB + (size_t)((m) - M_ALL) * 1024; Q = MEMSSQ + (size_t)((m) - M_ALL) * 16; R = (float*)(ws + WS_MEMRSTD) + ((m) - M_ALL); } } while (0)
        for (int m0 = gw; m0 < M_ALL + 512; m0 += 2 * NGW) { const bool hasB = m0 + NGW < M_ALL + 512; const int m1 = hasB ? m0 + NGW : m0;
            const float *sA, *sB; bf16_t *dA, *dB; float *qA, *qB, *rA, *rB;
            ROW_PTRS(m0, sA, dA, qA, rA); ROW_PTRS(m1, sB, dB, qB, rB);
            row_prep2(sA, dA, qA, rA, sB, dB, qB, rB, hasB, lane); }
#undef ROW_PTRS
    }
#define GRID_BAR_FIRST 1
#define GRID_BAR() do { XcdBarrier b_; b_.bar = (unsigned*)(ws + WS_BAR); b_.x = xb_xcc_id(); b_.st = (volatile LAS unsigned*)(lds + LDS_BARST); xcd_barrier(b_); } while (0)
    if (ws == nullptr) grid.sync();
    GRID_BAR();

#pragma nounroll
    for (int l = 0; l < 2; ++l) {
#pragma nounroll
        for (int q = 0; q < (l == 0 ? 2 : 1); ++q) {
            WAVE_IDS; unsigned char* w_ = ws; float* o_ = out; int l_ = l; OPQP(unsigned char, w_); OPQP(float, o_); OPQ(l_);
            Gemm g; EpiF32 E;
            if (q == 0) { g = Gemm{(const bf16_t*)(w_ + WS_XB), (const bf16_t*)(w_ + WS_W0 + (size_t)l_ * WS_WL + W_IN), M_ALL, 3584, 1024};
                E = EpiF32{0, (const float*)(w_ + WS_RSTD), (float*)(w_ + WS_PROJ), o_, l_, (bf16_t*)(w_ + WS_VT), (bf16_t*)(w_ + WS_KB)}; }
            else { g = Gemm{(const bf16_t*)(w_ + WS_MEMB), (const bf16_t*)(w_ + WS_WMKV), 512, 2048, 1024};
                E = EpiF32{1, (const float*)(w_ + WS_MEMRSTD), nullptr, o_, l_, (bf16_t*)(w_ + WS_MVT), (bf16_t*)(w_ + WS_MKB)}; }
            StaticOrder S; S.init(g.M, g.N, G, q == 0 ? bid : (bid + 16) % G);
            gemm_phase<EpiF32, StaticOrder, true, true>(lds, g, S, E);
        }
        if (l == 0 && gridDim.x == 256 && blockIdx.x >= 156 && blockIdx.x < 240) {
            WAVE_IDS; unsigned char* w_ = ws; OPQP(unsigned char, w_);
            const unsigned long long* tabc = (const unsigned long long*)w_; LAS float* scr = (LAS float*)(lds + wave * 16384);
#define TABP(i) FPTR(tabc[i])
            for (int j = (bid - 156) * 8 + wave; j < 4096; j += 84 * 8) CONV_ITEM(TABP, 0, 3328 + j, w_);
#undef TABP
        }
        GRID_BAR();
#pragma nounroll
        for (int ph = 0; ph < 3; ++ph) {
            WAVE_IDS; unsigned char* w_ = ws; float* o_ = out; int l_ = l; OPQP(unsigned char, w_); OPQP(float, o_); OPQ(l_);
            const unsigned long long* tab = (const unsigned long long*)w_;
            float* PROJ = (float*)(w_ + WS_PROJ); float* OSB = (float*)(w_ + WS_OSB); bf16_t* MIX = (bf16_t*)(w_ + WS_MIX); float* DS = (float*)(w_ + WS_DS); float* DD = (float*)(w_ + WS_DD);
            if (ph != 1) {
                const int nit = ph == 0 ? 1152 : 1024;
                const float* state_hgrn = GPTR(tab[5]); const float* lb_logits = GPTR(tab[8]); const float* hgain = GPTR(tab[12]) + l_ * 512;
#define HG_DECODE(IT, ROW0, TV, H) do { if ((IT) < 1024) { const int bh_ = (IT) >> 7; H = bh_ & 3; ROW0 = (bh_ >> 2) * 8192 + ((IT) & 127) * 64; TV = 64; } \
                    else { const int si_ = (IT) - 1024; H = si_ & 3; ROW0 = NPROMPT + 16 * (si_ >> 2); TV = 16; } } while (0)
#define HG_MAP(Q) (ph == 0 ? ((Q) < 128 ? 1024 + (Q) : (Q) - 128) : (Q))
                volatile LAS unsigned* LW = (volatile LAS unsigned*)(lds + LDS_BARST);
                unsigned* ctr = (unsigned*)(w_ + WS_CTR) + 2 * l_;
                unsigned nextq = 0; int cur;
                if (ph == 0) { if (tid == 0) LW[4] = atomicAdd(ctr, 1u); __syncthreads(); cur = (int)LW[4]; if (tid == 0) nextq = atomicAdd(ctr, 1u); }
                else cur = bid;
                while (cur < nit) {
                    const int it = HG_MAP(cur); int nxt;
                    if (ph == 0) { __syncthreads(); if (tid == 0) LW[4] = nextq; __syncthreads(); nxt = (int)LW[4]; if (tid == 0 && nxt < nit) nextq = atomicAdd(ctr, 1u); }
                    else nxt = cur + G;
                    int row0, tvalid, h; HG_DECODE(it, row0, tvalid, h);
                    float* dsOut; float* ddOut; const float* s0; const float* Ssrc;
                    if (it < 1024) { const int bh = it >> 7, c = it & 127; dsOut = DS + (size_t)(bh * 128 + c) * 16384; ddOut = DD + (size_t)(bh * 128 + c) * 128; s0 = nullptr; Ssrc = dsOut; }
                    else { const int si = it - 1024, s = si >> 2; s0 = state_hgrn + (size_t)((l_ * 32 + s) * 4 + h) * 16384; Ssrc = s0; dsOut = o_ + O_HS + (size_t)((l_ * 32 + s) * 4 + h) * 16384; ddOut = nullptr; }
                    int t2 = tid; asm volatile("" : "+v"(t2)); const int lane2 = t2 & 63, tg2 = t2 >> 7, k2 = t2 & 127;
                    const int ch = h * 128 + k2;
                    const float lbv = l_ == 0 ? 0.f : __builtin_amdgcn_rcpf(1.f + fexp(lb_logits[ch] - lb_logits[512 + ch]));
                    { float zc[16]; hg_load(PROJ, row0, tvalid, h, tg2, k2, 2048, zc);
                      if (ph == 0) hg_h1(lds, PROJ, zc, row0, tvalid, h, lbv, dsOut, ddOut, s0, t2, lane2, wave);
                      if (ph == 2 || it >= 1024) hg_h3(lds, PROJ, zc, row0, tvalid, h, lbv, Ssrc, it < 1024, hgain, MIX, t2, lane2, wave); }
                    cur = nxt;
                }
#undef HG_DECODE
#undef HG_MAP
                if (ph == 0) { unsigned char* w2 = ws; float* o2 = out; int l2 = l; OPQP(unsigned char, w2); OPQP(float, o2); OPQ(l2);
                    const unsigned long long* tab2 = (const unsigned long long*)w2; unsigned* ctr2 = (unsigned*)(w2 + WS_CTR) + 2 * l2 + 1;
                    unsigned wq = 0; if (lane == 0) wq = atomicAdd(ctr2, 1u); int w = __builtin_amdgcn_readfirstlane(wq);
                    while (w < 4352) { unsigned wn = 0; if (lane == 0) wn = atomicAdd(ctr2, 1u);
                        int lane2 = lane; asm volatile("" : "+v"(lane2));
                        if (w < 256) sb_item<true>(4096 + w, l2, (const float*)(w2 + WS_PROJ), o2 + O_KP + (size_t)l2 * NPROMPT * 512, o2 + O_VP + (size_t)l2 * NPROMPT * 512,
                                                    o2 + O_KS + (size_t)l2 * 262144, o2 + O_VS + (size_t)l2 * 262144, GPTR(tab2[3]), GPTR(tab2[4]), (const bf16_t*)(w2 + WS_VT), (const bf16_t*)(w2 + WS_KB), (float*)(w2 + WS_OSB), lane2);
                        else sb_item<false>(w - 256, l2, (const float*)(w2 + WS_PROJ), o2 + O_KP + (size_t)l2 * NPROMPT * 512, o2 + O_VP + (size_t)l2 * NPROMPT * 512,
                                                    o2 + O_KS + (size_t)l2 * 262144, o2 + O_VS + (size_t)l2 * 262144, GPTR(tab2[3]), GPTR(tab2[4]), (const bf16_t*)(w2 + WS_VT), (const bf16_t*)(w2 + WS_KB), (float*)(w2 + WS_OSB), lane2);
                        w = __builtin_amdgcn_readfirstlane(wn); } }
            } else {
                if (wave < 4) {
                    for (int p = bid * 256 + tid; p < 65536; p += G * 256) { const int e = 2 * p, bh = e >> 14, rem = e & 16383, k = rem & 127, v = rem >> 7;
                        unsigned* dsp = (unsigned*)(DS + (size_t)(bh * 128) * 16384) + (rem >> 1); const float* ddp = DD + (size_t)(bh * 128) * 128 + k;
                        float S0 = 0.f, S1 = 0.f;
                        for (int c = 0; c < 128; c += 16) { unsigned x[16]; f32x2_t d[16];
#pragma unroll
                            for (int u = 0; u < 16; ++u) { x[u] = dsp[(size_t)(c + u) * 16384]; d[u] = *(const f32x2_t*)(ddp + (c + u) * 128); }
#pragma unroll
                            for (int u = 0; u < 16; ++u) { dsp[(size_t)(c + u) * 16384] = pk2(S0, S1);
                                S0 = d[u].x * S0 + __uint_as_float(x[u] << 16); S1 = d[u].y * S1 + __uint_as_float(x[u] & 0xffff0000u); } }
                        float* op = o_ + O_HP + (size_t)l_ * 131072 + (size_t)bh * 16384 + k * 128 + v; op[0] = S0; op[128] = S1; }
                } else {
                    const float* sbg = GPTR(tab[11]) + l_ * 512; const int NW4 = G * 4;
                    const f32x4 ga = *(const f32x4*)(sbg + lane * 8), gb = *(const f32x4*)(sbg + lane * 8 + 4);
                    int m = bid * 4 + (wave - 4); u32x4 ra = {0u, 0u, 0u, 0u};
                    if (m < M_ALL) ra = *(const u32x4*)((const bf16_t*)OSB + (size_t)m * 512 + lane * 8);
                    while (m < M_ALL) { const int mn = m + NW4; u32x4 rn = ra;
                        if (mn < M_ALL) rn = *(const u32x4*)((const bf16_t*)OSB + (size_t)mn * 512 + lane * 8);
                        const f32x4 a = {__uint_as_float(ra.x << 16), __uint_as_float(ra.x & 0xffff0000u), __uint_as_float(ra.y << 16), __uint_as_float(ra.y & 0xffff0000u)};
                        const f32x4 b = {__uint_as_float(ra.z << 16), __uint_as_float(ra.z & 0xffff0000u), __uint_as_float(ra.w << 16), __uint_as_float(ra.w & 0xffff0000u)};
                        float ss = ((a[0] * a[0] + a[1] * a[1]) + (a[2] * a[2] + a[3] * a[3])) + ((b[0] * b[0] + b[1] * b[1]) + (b[2] * b[2] + b[3] * b[3]));
                        ss = wave_sum(ss); const float rs = rsqrtf(ss * (1.0f / 512.0f) + 1e-6f);
                        *(u32x4*)(MIX + (size_t)m * 1024 + lane * 8) = (u32x4){pk2(a[0] * rs * ga[0], a[1] * rs * ga[1]), pk2(a[2] * rs * ga[2], a[3] * rs * ga[3]),
                                                                              pk2(b[0] * rs * gb[0], b[1] * rs * gb[1]), pk2(b[2] * rs * gb[2], b[3] * rs * gb[3])};
                        ra = rn; m = mn; } }
            }
            GRID_BAR();
        }
#pragma nounroll
        for (int st = 0; st < 3; ++st) {
            { WAVE_IDS; unsigned char* w_ = ws; int l_ = l; OPQP(unsigned char, w_); OPQ(l_);
              const unsigned long long* tab = (const unsigned long long*)w_; unsigned char* wl = w_ + WS_W0 + (size_t)l_ * WS_WL;
              float* X = (float*)(w_ + WS_X);
              const bf16_t* A = (const bf16_t*)(w_ + (st == 0 ? WS_MIX : (st == 1 ? WS_OM : WS_H))); const bf16_t* Bt = (const bf16_t*)(wl + (st == 0 ? W_OUT : (st == 1 ? W_MO : W_2)));
              const int K = st == 0 ? 1024 : (st == 1 ? 512 : 4096);
              { Gemm g{A, Bt, NPROMPT, 1024, K, 0};
                EpiResid E{(st == 0 && l_ == 0) ? FPTR(tab[0]) : nullptr, nullptr, (st == 2 && l_ == 1) ? X : nullptr, (bf16_t*)(w_ + WS_XB), (float*)(w_ + WS_SSQ)};
                StaticOrder S; S.init(NPROMPT, 1024, G, bid);
                gemm_phase<EpiResid, StaticOrder, true, true>(lds, g, S, E); }
              { Gemm g{A, Bt, M_ALL, 1024, 256, K};
                EpiPart E{(float*)(w_ + WS_PART)};
                SplitOrder S; S.init(2, 1024, K / 256, G, bid, 64);
                gemm_phase<EpiPart, SplitOrder, true, true>(lds, g, S, E); } }
            GRID_BAR();
            { WAVE_IDS; unsigned char* w_ = ws; int l_ = l; OPQP(unsigned char, w_); OPQ(l_);
              const unsigned long long* tab = (const unsigned long long*)w_; const int nS = (st == 0 ? 1024 : (st == 1 ? 512 : 4096)) / 256;
              float* X = (float*)(w_ + WS_X); bf16_t* XB = (bf16_t*)(w_ + WS_XB); float* SSQ = (float*)(w_ + WS_SSQ); const float* PART = (const float*)(w_ + WS_PART);
              const float* bs = (st == 0 && l_ == 0) ? FPTR(tab[1]) : nullptr; const bool lastx = (st == 2 && l_ == 1);
              LAS float* red = (LAS float*)lds;
              for (int mb = bid; mb < 256; mb += G) { const int m = mb * 2 + (wave >> 2), cq = wave & 3, col = cq * 256 + lane * 4;
                  f32x4 v; if (bs) v = *(const f32x4*)(bs + (size_t)m * 1024 + col); else { const u32x2 r = *(const u32x2*)(XB + (size_t)(NPROMPT + m) * 1024 + col); v = (f32x4){__uint_as_float(r.x << 16), __uint_as_float(r.x & 0xffff0000u), __uint_as_float(r.y << 16), __uint_as_float(r.y & 0xffff0000u)}; }
                  f32x4 pp[16];
#pragma unroll
                  for (int ks = 0; ks < 16; ++ks) { const int kc = ks < nS ? ks : 0; pp[ks] = *(const f32x4*)(PART + ((size_t)kc * 512 + m) * 1024 + col); }
#pragma unroll
                  for (int ks = 0; ks < 16; ++ks) { const float on = ks < nS ? 1.f : 0.f; v += pp[ks] * on; }
                  if (lastx) *(f32x4*)(X + (size_t)(NPROMPT + m) * 1024 + col) = v;
                  u32x2 w; w.x = pk2(v[0], v[1]); w.y = pk2(v[2], v[3]); *(u32x2*)(XB + (size_t)(NPROMPT + m) * 1024 + col) = w;
                  float s = wave_sum((v[0] * v[0] + v[1] * v[1]) + (v[2] * v[2] + v[3] * v[3]));
                  if (lane == 0) red[wave] = s;
                  __syncthreads();
                  if (cq == 0 && lane == 0) ((float*)(w_ + WS_RSTD))[NPROMPT + m] = rsqrtf(((red[wave] + red[wave + 1]) + (red[wave + 2] + red[wave + 3])) * (1.0f / 1024.0f) + 1e-6f);
                  __syncthreads(); }
              if (tid < 64) for (int r = bid * 64 + tid; r < NPROMPT; r += G * 64) ((float*)(w_ + WS_RSTD))[r] = row_rstd(SSQ, r); }
            GRID_BAR();
            if (st < 2) {
                WAVE_IDS; unsigned char* w_ = ws; int l_ = l; OPQP(unsigned char, w_); OPQ(l_); unsigned char* wl = w_ + WS_W0 + (size_t)l_ * WS_WL;
                Gemm g; EpiBf16S E;
                if (st == 0) { g = Gemm{(const bf16_t*)(w_ + WS_XB), (const bf16_t*)(wl + W_MQ), M_ALL, 512, 1024}; E = EpiBf16S{(bf16_t*)(w_ + WS_QM), 512, (const float*)(w_ + WS_RSTD), 0.08838834764831845f, 0}; }
                else { g = Gemm{(const bf16_t*)(w_ + WS_XB), (const bf16_t*)(wl + W_1), M_ALL, 4096, 1024}; E = EpiBf16S{(bf16_t*)(w_ + WS_H), 4096, (const float*)(w_ + WS_RSTD), 1.0f, 1}; }
                StaticOrder S; S.init(M_ALL, g.N, G, bid);
                gemm_phase<EpiBf16S, StaticOrder, true, true>(lds, g, S, E);
                if (st == 0 && l_ == 0 && bid >= 132 && G == 256) {
                    const unsigned long long* tabc = (const unsigned long long*)w_; LAS float* scr = (LAS float*)(lds + wave * 16384);
#define TABP(i) FPTR(tabc[i])
                    for (int j = (bid - 132) * 8 + wave; j < 6912; j += 124 * 8) CONV_ITEM(TABP, 1, j < 2560 ? j : j + 512, w_);
#undef TABP
                }
                GRID_BAR();
            }
            if (st == 0) {
                WAVE_IDS; unsigned char* w_ = ws; float* o_ = out; int l_ = l; OPQP(unsigned char, w_); OPQP(float, o_); OPQ(l_);
                const unsigned long long* tab = (const unsigned long long*)w_; const float* cache_mk = GPTR(tab[6]); const float* cache_mv = GPTR(tab[7]);
                const bf16_t* QM = (const bf16_t*)(w_ + WS_QM); bf16_t* OM = (bf16_t*)(w_ + WS_OM);
                for (int it = bid; it < 1152; it += G) {
                    int row0, tvalid, hm; const float* Kg; const float* Vg; const bf16_t* Kb = nullptr; const bf16_t* Vtb = nullptr;
                    if (it < 1024) { const int tt = it >> 2; hm = it & 3; row0 = tt * 64; tvalid = 64; const int b = tt >> 7;
                        Kb = (const bf16_t*)(w_ + WS_MKB) + (size_t)((l_ * 2 + b) * 4 + hm) * 32768; Vtb = (const bf16_t*)(w_ + WS_MVT) + (size_t)((l_ * 2 + b) * 4 + hm) * 32768;
                        Kg = o_ + O_MKP + (size_t)(l_ * 2 + b) * 131072 + hm * 128; Vg = o_ + O_MVP + (size_t)(l_ * 2 + b) * 131072 + hm * 128; }
                    else { const int si = it - 1024, s = si >> 2; hm = si & 3; row0 = NPROMPT + 16 * s; tvalid = 16;
                        Kg = cache_mk + (size_t)(l_ * 32 + s) * 131072 + hm * 128; Vg = cache_mv + (size_t)(l_ * 32 + s) * 131072 + hm * 128; }
                    int t2 = tid; asm volatile("" : "+v"(t2));
                    xattn_item(lds, QM, Kg, Vg, Kb, Vtb, row0, tvalid, hm, OM, t2, t2 & 63, wave);
                }
                GRID_BAR();
            }
        }
    }
    { WAVE_IDS; unsigned char* w_ = ws; float* o_ = out; OPQP(unsigned char, w_); OPQP(float, o_);
      const float* nf = GPTR(((const unsigned long long*)w_)[23]); const float* X = (const float*)(w_ + WS_X);
      for (int m0 = gw; m0 < M_ALL; m0 += 2 * NGW) { const int m1 = (m0 + NGW < M_ALL) ? m0 + NGW : m0;
          const f32x4* xa = (const f32x4*)(X + (size_t)m0 * 1024) + lane; const f32x4* xb = (const f32x4*)(X + (size_t)m1 * 1024) + lane; f32x4 va[4], vb[4]; float sa = 0.f, sb = 0.f;
#pragma unroll
          for (int j = 0; j < 4; ++j) { va[j] = xa[64 * j]; vb[j] = xb[64 * j]; }
#pragma unroll
          for (int j = 0; j < 4; ++j) { sa += (va[j][0] * va[j][0] + va[j][1] * va[j][1]) + (va[j][2] * va[j][2] + va[j][3] * va[j][3]); sb += (vb[j][0] * vb[j][0] + vb[j][1] * vb[j][1]) + (vb[j][2] * vb[j][2] + vb[j][3] * vb[j][3]); }
          sa = wave_sum(sa); sb = wave_sum(sb); const float ra = rsqrtf(sa * (1.0f / 1024.0f) + 1e-6f), rb = rsqrtf(sb * (1.0f / 1024.0f) + 1e-6f);
          f32x4* ya = (f32x4*)(o_ + (m0 < NPROMPT ? O_YP + (size_t)m0 * 1024 : O_YS + (size_t)(m0 - NPROMPT) * 1024)) + lane;
          f32x4* yb = (f32x4*)(o_ + (m1 < NPROMPT ? O_YP + (size_t)m1 * 1024 : O_YS + (size_t)(m1 - NPROMPT) * 1024)) + lane;
#pragma unroll
          for (int j = 0; j < 4; ++j) { const f32x4 g = *((const f32x4*)nf + lane + 64 * j); ya[64 * j] = va[j] * ra * g; if (m1 != m0) yb[64 * j] = vb[j] * rb * g; } } }
}

extern "C" void kernel_launch(void* const* d_in, const int* in_sizes, int n_in, void* d_out, int out_size, void* d_ws, size_t ws_size, hipStream_t stream) {
    static int grid = 0;
    if (grid == 0) {
        int dev = 0, cus = 0, per_cu = 0;
        (void)hipGetDevice(&dev); (void)hipDeviceGetAttribute(&cus, hipDeviceAttributeMultiprocessorCount, dev);
        if (hipFuncSetAttribute((const void*)mega_fwd, hipFuncAttributeMaxDynamicSharedMemorySize, LDS_BYTES) != hipSuccess) fprintf(stderr, "kernel_launch: hipFuncSetAttribute failed\n");
        if (hipOccupancyMaxActiveBlocksPerMultiprocessor(&per_cu, (const void*)mega_fwd, 512, LDS_BYTES) != hipSuccess || per_cu < 1) { fprintf(stderr, "kernel_launch: occupancy query says %d\n", per_cu); per_cu = 1; }
        (void)hipGetLastError();
        if (cus <= 0) cus = 256;
        grid = cus;
    }
    if (hipMemsetAsync((char*)d_ws + WS_BAR, 0, 32768, stream) != hipSuccess) fprintf(stderr, "kernel_launch: hipMemsetAsync of the barrier words failed\n");
    Args a{};
    for (int i = 0; i < 24; ++i) a.in[i] = (const float*)d_in[i];
    a.out = (float*)d_out; a.ws = (unsigned char*)d_ws;
    void* kargs[] = {&a};
    const hipError_t e = hipLaunchCooperativeKernel((const void*)mega_fwd, dim3(grid), dim3(512), kargs, LDS_BYTES, stream);
    if (e != hipSuccess) fprintf(stderr, "kernel_launch: cooperative launch failed: %s (grid %d)\n", hipGetErrorString(e), grid);
}
```
